# Optimizing an MI355X kernel written in HIP

```python
import jax, jax.numpy as jnp
from jax import lax
import numpy as np

D_MODEL = 1024
BATCH = 4
SEQ = 4096
DEPTH = 4

GRID_W = 64
CTX_LEN = 256
MLA_HEADS = 4
MLA_Q_RANK = 256
MLA_KV_RANK = 128
MLA_NOPE = 128
MLA_ROPE = 64
MLA_V = 128
MLA_SCALE = (MLA_NOPE + MLA_ROPE) ** -0.5
Q_BLOCK = 128
ROPE_BASE = 10000.0
ML_HEADS = 4
ML_DH = 64
ML_W = ML_HEADS * ML_DH
ML_CHUNK = 128
LRU_W = 256
LRU_BLOCKS = 4
LRU_BD = LRU_W // LRU_BLOCKS
CONV_W = 4
CONV_LEFT = 2
LRU_C = 8.0
D_FF = 4 * D_MODEL
EPS = 1e-6
MLA_IN = MLA_Q_RANK + MLA_KV_RANK + MLA_ROPE
ML_IN = 4 * ML_W + 4 * ML_HEADS
LRU_IN = 2 * LRU_W
D_IN = MLA_IN + ML_IN + LRU_IN
MIX_W = MLA_HEADS * MLA_V + ML_W + LRU_W

kernel_name = "hymba_style_mla_mlstm_rglru_diffusion_trunk"


def rms_norm(x, gain=None):
    xf = x.astype(jnp.float32)
    y = xf * lax.rsqrt(jnp.mean(xf * xf, axis=-1, keepdims=True) + EPS)
    if gain is not None:
        y = y * gain.astype(jnp.float32)
    return y.astype(x.dtype)


def modulate(x, shift, scale):
    return x * (1.0 + scale) + shift


def axial_rope_tables(T):
    rows_n = T // GRID_W
    row = jnp.repeat(jnp.arange(rows_n), GRID_W).astype(jnp.float32)
    col = jnp.tile(jnp.arange(GRID_W), rows_n).astype(jnp.float32)
    half = MLA_ROPE // 2
    freqs = 1.0 / (ROPE_BASE ** (jnp.arange(0, half, 2, dtype=jnp.float32) / half))
    ang = jnp.concatenate([row[:, None] * freqs, col[:, None] * freqs], axis=-1)
    return jnp.cos(ang), jnp.sin(ang)


def apply_rope(x, cos, sin):
    x1, x2 = jnp.split(x.astype(jnp.float32), 2, axis=-1)
    return jnp.concatenate([x1 * cos - x2 * sin, x1 * sin + x2 * cos], axis=-1).astype(x.dtype)


def merge_heads(y):
    B, H, T, d = y.shape
    return y.transpose(0, 2, 1, 3).reshape(B, T, H * d)


def mla_qkv(a, g_q, w_uq, g_kv, w_ukv, rope):
    B, T, _ = a.shape
    c_q, c_kv, k_rope = jnp.split(a, [MLA_Q_RANK, MLA_Q_RANK + MLA_KV_RANK], axis=-1)
    q = (rms_norm(c_q, g_q) @ w_uq).reshape(B, T, MLA_HEADS, MLA_NOPE + MLA_ROPE).transpose(0, 2, 1, 3)
    kv = (rms_norm(c_kv, g_kv) @ w_ukv).reshape(B, T, MLA_HEADS, MLA_NOPE + MLA_V).transpose(0, 2, 1, 3)
    q_nope, q_rope = jnp.split(q, [MLA_NOPE], axis=-1)
    k_nope, v = jnp.split(kv, [MLA_NOPE], axis=-1)
    if rope is not None:
        q_rope = apply_rope(q_rope, *rope)
        k_rope = apply_rope(k_rope, *rope)
    k_rope = jnp.broadcast_to(k_rope[:, None], (B, MLA_HEADS, T, MLA_ROPE))
    q = jnp.concatenate([q_nope, q_rope], axis=-1)
    k = jnp.concatenate([k_nope, k_rope], axis=-1)
    return q, k, v


def attend(q, k, v):
    s = jnp.einsum("bhqd,bhkd->bhqk", q, k).astype(jnp.float32) * MLA_SCALE
    p = jax.nn.softmax(s, axis=-1).astype(v.dtype)
    return jnp.einsum("bhqk,bhkd->bhqd", p, v)


def blocked_attention(q, k, v):
    B, H, T, dk = q.shape
    nb = T // Q_BLOCK
    qb = jnp.moveaxis(q.reshape(B, H, nb, Q_BLOCK, dk), 2, 0)
    ob = lax.map(lambda qi: attend(qi, k, v), qb)
    return jnp.moveaxis(ob, 0, 2).reshape(B, H, T, v.shape[-1])


def mla_mixer(al, ac, rope, g_q, w_uq, g_kv, w_ukv, with_ctx_out):
    ql, kl, vl = mla_qkv(al, g_q, w_uq, g_kv, w_ukv, rope)
    qc, kc, vc = mla_qkv(ac, g_q, w_uq, g_kv, w_ukv, None)
    k_all = jnp.concatenate([kc, kl], axis=2)
    v_all = jnp.concatenate([vc, vl], axis=2)
    y_l = merge_heads(blocked_attention(ql, k_all, v_all))
    y_c = merge_heads(attend(qc, kc, vc)) if with_ctx_out else None
    return y_l, y_c


def mlstm_zero_state(B):
    return (jnp.zeros((B, ML_HEADS, ML_DH, ML_DH), jnp.float32),
            jnp.zeros((B, ML_HEADS, ML_DH), jnp.float32),
            jnp.zeros((B, ML_HEADS), jnp.float32))


def mlstm_scan(q, k, v, i_pre, f_pre, state):
    B, H, T, dh = q.shape
    nc = T // ML_CHUNK

    def chunks(a):
        return jnp.moveaxis(a.reshape(a.shape[:2] + (nc, ML_CHUNK) + a.shape[3:]), 2, 0)

    xs = (chunks(q), chunks(k), chunks(v), chunks(i_pre), chunks(jax.nn.log_sigmoid(f_pre)))
    lower = jnp.tril(jnp.ones((ML_CHUNK, ML_CHUNK), dtype=bool))

    def step(carry, chunk):
        C, n, m = carry
        qc, kc, vc, ic, lfc = chunk
        b = jnp.cumsum(lfc, axis=-1)
        d = jnp.where(lower, b[..., :, None] - b[..., None, :] + ic[..., None, :], -jnp.inf)
        inter = b + m[..., None]
        m_row = jnp.maximum(inter, jnp.max(d, axis=-1))
        w_intra = jnp.exp(d - m_row[..., None])
        w_inter = jnp.exp(inter - m_row)
        s = jnp.einsum("bhtd,bhsd->bhts", qc, kc) * w_intra
        num = jnp.einsum("bhts,bhsd->bhtd", s, vc) + w_inter[..., None] * jnp.einsum("bhtk,bhkv->bhtv", qc, C)
        den = jnp.sum(s, axis=-1) + w_inter * jnp.einsum("bhtk,bhk->bht", qc, n)
        h = num / jnp.maximum(jnp.abs(den), jnp.exp(-m_row))[..., None]
        b_last = b[..., -1]
        g = b_last[..., None] - b + ic
        m_new = jnp.maximum(b_last + m, jnp.max(g, axis=-1))
        w_old = jnp.exp(b_last + m - m_new)
        w_s = jnp.exp(g - m_new[..., None])
        C_new = w_old[..., None, None] * C + jnp.einsum("bhs,bhsk,bhsv->bhkv", w_s, kc, vc)
        n_new = w_old[..., None] * n + jnp.einsum("bhs,bhsk->bhk", w_s, kc)
        return (C_new, n_new, m_new), h

    state, hs = lax.scan(step, state, xs)
    h = jnp.moveaxis(hs, 0, 2).reshape(B, H, T, dh)
    return h, state


def mlstm_bidir(q, k, v, gf, gb, s_f, s_b):
    flip = lambda t: jnp.flip(t, axis=2)
    h_f, s_f = mlstm_scan(q, k, v, gf[0], gf[1], s_f)
    h_b, s_b = mlstm_scan(flip(q), flip(k), flip(v), flip(gb[0]), flip(gb[1]), s_b)
    return h_f + flip(h_b), s_f, s_b


def mlstm_mixer(zl, zc, gate_bias, with_ctx_out):
    def prep(z):
        Bz, T, _ = z.shape
        q, k, v, o, g = jnp.split(z, [ML_W, 2 * ML_W, 3 * ML_W, 4 * ML_W], axis=-1)
        heads = lambda t: t.reshape(Bz, T, ML_HEADS, ML_DH).transpose(0, 2, 1, 3).astype(jnp.float32)
        g = (g + gate_bias).astype(jnp.float32).transpose(0, 2, 1)
        i_f, f_f, i_b, f_b = jnp.split(g, 4, axis=1)
        return (heads(q) * ML_DH ** -0.5, heads(k), heads(v)), o, (i_f, f_f), (i_b, f_b)

    def finish(h, o):
        Bz, _, T, _ = h.shape
        h = rms_norm(h).transpose(0, 2, 1, 3).reshape(Bz, T, ML_W)
        return (jax.nn.sigmoid(o.astype(jnp.float32)) * h).astype(o.dtype)

    qkv_c, o_c, gf_c, gb_c = prep(zc)
    qkv_l, o_l, gf_l, gb_l = prep(zl)
    zero = mlstm_zero_state(zl.shape[0])
    h_c, s_f, s_b = mlstm_bidir(*qkv_c, gf_c, gb_c, zero, zero)
    h_l, _, _ = mlstm_bidir(*qkv_l, gf_l, gb_l, s_f, s_b)
    return finish(h_l, o_l), (finish(h_c, o_c) if with_ctx_out else None)


def dwconv_centred(x, w, b):
    T = x.shape[1]
    xp = jnp.pad(x, ((0, 0), (CONV_LEFT, CONV_W - 1 - CONV_LEFT), (0, 0)))
    return b + sum(xp[:, j:j + T] * w[j] for j in range(CONV_W))


def block_diag(x, w, b):
    B, T, _ = x.shape
    y = jnp.einsum("btgi,gio->btgo", x.reshape(B, T, LRU_BLOCKS, LRU_BD), w)
    return y.reshape(B, T, LRU_W) + b


def linear_scan(a, b, h0):
    b = b.at[:, 0].add(a[:, 0] * h0)
    comb = lambda l, r: (l[0] * r[0], r[0] * l[1] + r[1])
    _, h = lax.associative_scan(comb, (a, b), axis=1)
    return h


def rglru_mixer(rl, rc, conv_w, conv_b, w_a, b_a, w_x, b_x, lam, with_ctx_out):
    def branch(z):
        xb, gb = jnp.split(z, 2, axis=-1)
        return dwconv_centred(xb, conv_w, conv_b).astype(jnp.float32), jax.nn.gelu(gb)

    xs_c, gate_c = branch(rc)
    xs_l, gate_l = branch(rl)

    def gates(xs, d):
        r = jax.nn.sigmoid(block_diag(xs, w_a[d], b_a[d]))
        i = jax.nn.sigmoid(block_diag(xs, w_x[d], b_x[d]))
        log_a = -LRU_C * r * jax.nn.softplus(-lam[d].astype(jnp.float32))
        return jnp.exp(log_a), jnp.sqrt(-jnp.expm1(2.0 * log_a)) * (i * xs)

    def direction(d, rev):
        flip = (lambda t: jnp.flip(t, axis=1)) if rev else (lambda t: t)
        a_c, u_c = gates(flip(xs_c), d)
        h_c = linear_scan(a_c, u_c, jnp.zeros_like(u_c[:, 0]))
        a_l, u_l = gates(flip(xs_l), d)
        h_l = linear_scan(a_l, u_l, h_c[:, -1])
        return flip(h_l), flip(h_c)

    hf_l, hf_c = direction(0, False)
    hb_l, hb_c = direction(1, True)
    y_l = (gate_l * (hf_l + hb_l)).astype(rl.dtype)
    y_c = (gate_c * (hf_c + hb_c)).astype(rc.dtype) if with_ctx_out else None
    return y_l, y_c


def token_mixing(ul, uc, rope, w_in, w_out, g_q, w_uq, g_kv, w_ukv, ml_gate_bias,
                 conv_w, conv_b, w_a, b_a, w_x, b_x, lam, with_ctx_out):
    split_at = [MLA_IN, MLA_IN + ML_IN]
    al, ml_, rl = jnp.split(ul @ w_in, split_at, axis=-1)
    ac, mc, rc = jnp.split(uc @ w_in, split_at, axis=-1)
    ya_l, ya_c = mla_mixer(al, ac, rope, g_q, w_uq, g_kv, w_ukv, with_ctx_out)
    yb_l, yb_c = mlstm_mixer(ml_, mc, ml_gate_bias, with_ctx_out)
    yc_l, yc_c = rglru_mixer(rl, rc, conv_w, conv_b, w_a, b_a, w_x, b_x, lam, with_ctx_out)
    y_l = jnp.concatenate([ya_l, yb_l, yc_l], axis=-1) @ w_out
    y_c = (jnp.concatenate([ya_c, yb_c, yc_c], axis=-1) @ w_out) if with_ctx_out else None
    return y_l, y_c


def squared_relu_mlp(u, w1, w2):
    return jnp.square(jax.nn.relu(u @ w1)) @ w2


def setup_inputs(seed: int = 0) -> dict:
    key = jax.random.key(seed)
    ks = jax.random.split(key, 24)
    L = DEPTH
    nrm = lambda k, shape, s: jax.random.normal(k, shape, jnp.float32) * s
    gk = jax.random.split(ks[11], 4)
    f_bias = jnp.linspace(3.0, 6.0, ML_HEADS, dtype=jnp.float32)
    ml_gate_bias = jnp.concatenate([
        nrm(gk[0], (L, ML_HEADS), 0.1),
        f_bias + nrm(gk[1], (L, ML_HEADS), 0.1),
        nrm(gk[2], (L, ML_HEADS), 0.1),
        f_bias + nrm(gk[3], (L, ML_HEADS), 0.1)], axis=-1)
    a0 = jax.random.uniform(ks[18], (L, 2, LRU_W), jnp.float32, minval=0.9, maxval=0.999)
    return {
        "x": nrm(ks[0], (BATCH, SEQ, D_MODEL), 1.0),
        "c": nrm(ks[1], (BATCH, D_MODEL), 1.0),
        "ctx": nrm(ks[2], (BATCH, CTX_LEN, D_MODEL), 1.0),
        "c_ctx": nrm(ks[3], (D_MODEL,), 1.0),
        "w_mod": nrm(ks[4], (L, D_MODEL, 6 * D_MODEL), 0.5 * D_MODEL ** -0.5),
        "b_mod": nrm(ks[5], (L, 6 * D_MODEL), 0.02),
        "w_in": nrm(ks[6], (L, D_MODEL, D_IN), D_MODEL ** -0.5),
        "mla_g_q": 1.0 + nrm(ks[7], (L, MLA_Q_RANK), 0.1),
        "mla_w_uq": nrm(ks[8], (L, MLA_Q_RANK, MLA_HEADS * (MLA_NOPE + MLA_ROPE)), MLA_Q_RANK ** -0.5),
        "mla_g_kv": 1.0 + nrm(ks[9], (L, MLA_KV_RANK), 0.1),
        "mla_w_ukv": nrm(ks[10], (L, MLA_KV_RANK, MLA_HEADS * (MLA_NOPE + MLA_V)), MLA_KV_RANK ** -0.5),
        "ml_gate_bias": ml_gate_bias,
        "lru_conv_w": nrm(ks[12], (L, CONV_W, LRU_W), CONV_W ** -0.5),
        "lru_conv_b": nrm(ks[13], (L, LRU_W), 0.02),
        "lru_w_a": nrm(ks[14], (L, 2, LRU_BLOCKS, LRU_BD, LRU_BD), LRU_BD ** -0.5),
        "lru_b_a": nrm(ks[15], (L, 2, LRU_W), 0.02),
        "lru_w_x": nrm(ks[16], (L, 2, LRU_BLOCKS, LRU_BD, LRU_BD), LRU_BD ** -0.5),
        "lru_b_x": nrm(ks[17], (L, 2, LRU_W), 0.02),
        "lru_lam": jnp.log(a0) - jnp.log1p(-a0),
        "w_out": nrm(ks[19], (L, MIX_W, D_MODEL), MIX_W ** -0.5),
        "w_ff1": nrm(ks[20], (L, D_MODEL, D_FF), D_MODEL ** -0.5),
        "w_ff2": nrm(ks[21], (L, D_FF, D_MODEL), D_FF ** -0.5),
        "final_g": 1.0 + nrm(ks[22], (D_MODEL,), 0.1),
    }


def reference(x, c, ctx, c_ctx, w_mod, b_mod, w_in, mla_g_q, mla_w_uq, mla_g_kv, mla_w_ukv,
              ml_gate_bias, lru_conv_w, lru_conv_b, lru_w_a, lru_b_a, lru_w_x, lru_b_x, lru_lam,
              w_out, w_ff1, w_ff2, final_g):
    rope = axial_rope_tables(x.shape[1])
    xl, xc = x, ctx
    for l in range(DEPTH):
        with_ctx_out = l < DEPTH - 1
        mod_l = (jax.nn.silu(c) @ w_mod[l] + b_mod[l])[:, None, :]
        mod_c = jax.nn.silu(c_ctx) @ w_mod[l] + b_mod[l]
        sh1l, sc1l, g1l, sh2l, sc2l, g2l = jnp.split(mod_l, 6, axis=-1)
        sh1c, sc1c, g1c, sh2c, sc2c, g2c = jnp.split(mod_c, 6, axis=-1)
        ul = modulate(rms_norm(xl), sh1l, sc1l)
        uc = modulate(rms_norm(xc), sh1c, sc1c)
        yl, yc = token_mixing(ul, uc, rope, w_in[l], w_out[l], mla_g_q[l], mla_w_uq[l], mla_g_kv[l],
                              mla_w_ukv[l], ml_gate_bias[l], lru_conv_w[l], lru_conv_b[l], lru_w_a[l],
                              lru_b_a[l], lru_w_x[l], lru_b_x[l], lru_lam[l], with_ctx_out)
        xl = xl + g1l * yl
        xl = xl + g2l * squared_relu_mlp(modulate(rms_norm(xl), sh2l, sc2l), w_ff1[l], w_ff2[l])
        if with_ctx_out:
            xc = xc + g1c * yc
            xc = xc + g2c * squared_relu_mlp(modulate(rms_norm(xc), sh2c, sc2c), w_ff1[l], w_ff2[l])
    return rms_norm(xl, final_g)
```

```cpp
#include <hip/hip_runtime.h>
#include <hip/hip_cooperative_groups.h>
#include <cstdio>
namespace cg = cooperative_groups;

#define DI __device__ __forceinline__
typedef unsigned short bf16_t;
typedef __attribute__((ext_vector_type(8))) short bf16x8;
typedef __attribute__((ext_vector_type(16))) float f32x16;
typedef __attribute__((ext_vector_type(4))) unsigned u32x4;
typedef __bf16 bf16v2_t __attribute__((ext_vector_type(2)));
typedef float f32v2_t __attribute__((ext_vector_type(2)));

#define NB 4
#define TL 4096
#define TC 256
#define TP 4352
#define NTOK 17408
#define DM 1024
#define DFF 4096
#define ZW 2048
#define NLAYER 4
#define EPSF 1e-6f
#define ZQ 0
#define ZKV 256
#define ZKR 384
#define ZG 448
#define ZMQ 512
#define ZMK 768
#define ZMV 1024
#define ZMO 1280
#define ZLX 1536
#define ZLG 1792
#define LDT 72
#define CREC 4224
#define QSCALE (0.07216878364870322f * 1.4426950408889634f)

struct Params {
  const float *x, *c, *ctx, *c_ctx, *w_mod, *b_mod, *w_in, *g_q, *w_uq, *g_kv, *w_ukv, *gate_bias;
  const float *conv_w, *conv_b, *w_a, *b_a, *w_x, *b_x, *lam, *w_out, *w_ff1, *w_ff2, *final_g;
  float* out;
  bf16_t *Wb_in, *Wb_uq, *Wb_ukv, *Wb_out, *Wb_ff1, *Wb_ff2, *Wb_lru;
  float* MOD;
  float* X;
  bf16_t* U;
  bf16_t* Z;
  bf16_t* Qb;
  bf16_t* Kb;
  bf16_t* Vt;
  bf16_t* H;
  float* ZGt;
  bf16_t* AU;
  float* AGG;
  float* CST;
  float* XS;
  unsigned* CTR;
  unsigned* BAR;
};

typedef const __attribute__((address_space(4))) Params CParamsT;
typedef CParamsT& CPARAMS;
__device__ __forceinline__ CParamsT* kparams() {
  CParamsT* q = (CParamsT*)__builtin_amdgcn_kernarg_segment_ptr();
  asm volatile("" : "+s"(q));
  return q;
}

DI int tfull_() { int t = threadIdx.x; asm volatile("" : "+v"(t)); return t; }
DI int tidx_() { return tfull_() & 255; }
DI int hidx_() { return tfull_() >> 8; }
DI int rbidx_() { int t = blockIdx.x; asm volatile("" : "+s"(t)); return t; }
DI int bidx_() { return rbidx_() * 2 + hidx_(); }
#define VGRID ((int)gridDim.x * 2)
DI unsigned pack2(float a, float b) {
  f32v2_t v = {a, b};
  bf16v2_t r = __builtin_convertvector(v, bf16v2_t);
  return __builtin_bit_cast(unsigned, r);
}
DI bf16_t f2bf(float a) { return (bf16_t)(pack2(a, 0.f) & 0xffffu); }
DI float bf2f(bf16_t v) { return __uint_as_float(((unsigned)v) << 16); }
DI float bflo(unsigned u) { return __uint_as_float(u << 16); }
DI float bfhi(unsigned u) { return __uint_as_float(u & 0xffff0000u); }
DI f32x16 mfma(bf16x8 a, bf16x8 b, f32x16 c) { return __builtin_amdgcn_mfma_f32_32x32x16_bf16(a, b, c, 0, 0, 0); }
DI f32x16 zero16() { f32x16 z;
#pragma unroll
  for (int i = 0; i < 16; ++i) z[i] = 0.f; return z; }
DI float ex2(float x) { return __builtin_amdgcn_exp2f(x); }
DI float fexp(float x) { return __builtin_amdgcn_exp2f(x * 1.4426950408889634f); }
DI float sigmoidf_(float x) { return 1.f / (1.f + fexp(-x)); }
DI float xhalf(float v) { return __shfl_xor(v, 32, 64); }
DI bf16x8 ldfrag(const bf16_t* p) { return *(const bf16x8*)p; }
DI bf16x8 pack8(float a0, float a1, float a2, float a3, float a4, float a5, float a6, float a7) {
  uint4 u; u.x = pack2(a0, a1); u.y = pack2(a2, a3); u.z = pack2(a4, a5); u.w = pack2(a6, a7);
  return __builtin_bit_cast(bf16x8, u);
}
DI int crow(int i, int hh) { return (i & 3) + 8 * (i >> 2) + 4 * hh; }
DI int permk(int t) { return (t & ~12) | ((t & 4) << 1) | ((t & 8) >> 1); }

#define XB_TMO      128
#define XB_XCNT(j)  (256  + 64 * (j))
#define XB_XSUB(j)  (1280 + 64 * (j))
#define XB_XGEN(j)  (2304 + 64 * (j))
#define XB_TOP      3328
#define XB_TOPGEN   3392
#define XCD_BAR_WORDS 3456
#define XB_SPIN_CAP (1u << 18)
#define LAS __attribute__((address_space(3)))

__device__ __forceinline__ unsigned xb_ld(unsigned* p)              { return __hip_atomic_load(p, __ATOMIC_RELAXED, __HIP_MEMORY_SCOPE_AGENT); }
__device__ __forceinline__ unsigned xb_add(unsigned* p, unsigned v) { return __hip_atomic_fetch_add(p, v, __ATOMIC_RELAXED, __HIP_MEMORY_SCOPE_AGENT); }
__device__ __forceinline__ unsigned xb_xcc_id() { return (unsigned)__builtin_amdgcn_s_getreg((3 << 11) | 20) & 0xFu; }
#define XB_SPIN(cond, bar) do { unsigned _sp = 0; while (cond) { __builtin_amdgcn_s_sleep(1); \
    if ((++_sp & 255u) == 0u) { if (xb_ld(&(bar)[XB_TMO])) break; if (_sp > XB_SPIN_CAP) { atomicAdd(&(bar)[XB_TMO], 1u); break; } } } } while (0)

struct XcdBarrier {
    unsigned* bar; unsigned x;
    volatile LAS unsigned* st;
};

__device__ __forceinline__ XcdBarrier xcd_barrier_post(unsigned* bar, volatile LAS unsigned* st) {
    XcdBarrier b; b.bar = bar; b.x = xb_xcc_id(); b.st = st;
    if (threadIdx.x == 0) (void)xb_add(&bar[XB_XCNT(b.x)], 1u);
    return b;
}
__device__ __forceinline__ void xcd_barrier_complete(unsigned* bar, unsigned x, unsigned& nloc, unsigned& nx) {
    const unsigned G = gridDim.x * gridDim.y * gridDim.z;
    unsigned sum, cnt, mine, sp = 0u;
    for (;;) {
        sum = 0u; cnt = 0u; mine = 0u;
#pragma unroll
        for (unsigned j = 0; j < 16; ++j) { const unsigned c = xb_ld(&bar[XB_XCNT(j)]); sum += c; cnt += (c > 0u) ? 1u : 0u; mine = (j == x) ? c : mine; }
        if (sum == G) break;
        __builtin_amdgcn_s_sleep(1);
        if ((++sp & 255u) == 0u) { if (xb_ld(&bar[XB_TMO])) break; if (sp > XB_SPIN_CAP) { atomicAdd(&bar[XB_TMO], 1u); break; } }
    }
    nloc = mine > 0u ? mine : 1u; nx = cnt > 0u ? cnt : 1u;
}

__device__ __forceinline__ void xcd_barrier(const XcdBarrier& b) {
    asm volatile("s_waitcnt vmcnt(0)" ::: "memory");
    __syncthreads();
    if (threadIdx.x == 0) {
        unsigned* bar = b.bar;
        __builtin_amdgcn_s_waitcnt(0);
        unsigned nloc = b.st[0], nx = b.st[1];
        if (nloc == 0u) { xcd_barrier_complete(bar, b.x, nloc, nx); b.st[0] = nloc; b.st[1] = nx; }
        const unsigned old = xb_add(&bar[XB_XSUB(b.x)], 1u);
        const unsigned gen = old / nloc;
        if (old + 1u == (gen + 1u) * nloc) {
            __builtin_amdgcn_fence(__ATOMIC_RELEASE, "agent");
            asm volatile("s_waitcnt vmcnt(0)" ::: "memory");
            const unsigned og = xb_add(&bar[XB_TOP], 1u);
            const unsigned tg = og / nx;
            if (og + 1u == (tg + 1u) * nx) xb_add(&bar[XB_TOPGEN], 1u);
            else XB_SPIN(xb_ld(&bar[XB_TOPGEN]) == tg, bar);
            __builtin_amdgcn_fence(__ATOMIC_ACQUIRE, "agent");
            xb_add(&bar[XB_XGEN(b.x)], 1u);
            asm volatile("s_waitcnt vmcnt(0)" ::: "memory");
        } else {
            XB_SPIN(xb_ld(&bar[XB_XGEN(b.x)]) == gen, bar);
            __builtin_amdgcn_fence(__ATOMIC_ACQUIRE, "agent");
            asm volatile("s_waitcnt vmcnt(0)" ::: "memory");
        }
    }
    __syncthreads();
}


template <class Epi>
DI void gemm128(const bf16_t* __restrict__ A, int lda, const bf16_t* __restrict__ B, int ldb, int K, bf16_t* sm, Epi&& epi) {
  const int tid = tidx_(), lane = tid & 63, w = tid >> 6, wp = w >> 1, wq = w & 1, l32 = lane & 31, hh = lane >> 5;
  bf16_t* sA = sm;
  bf16_t* sB = sm + 2 * 128 * LDT;
  f32x16 acc[2][2];
#pragma unroll
  for (int i = 0; i < 2; ++i)
#pragma unroll
    for (int j = 0; j < 2; ++j) acc[i][j] = zero16();
  const int lrow = tid >> 3, kc = (tid & 7) * 8;
  const bf16_t* gA = A + (size_t)lrow * lda + kc;
  const bf16_t* gB = B + (size_t)lrow * ldb + kc;
  u32x4 ra[4], rb[4];
#pragma unroll
  for (int i = 0; i < 4; ++i) {
    ra[i] = *(const u32x4*)(gA + (size_t)(32 * i) * lda);
    rb[i] = *(const u32x4*)(gB + (size_t)(32 * i) * ldb);
  }
#pragma unroll
  for (int i = 0; i < 4; ++i) {
    *(u32x4*)(sA + (lrow + 32 * i) * LDT + kc) = ra[i];
    *(u32x4*)(sB + (lrow + 32 * i) * LDT + kc) = rb[i];
  }
  __syncthreads();
  const int KT = K >> 6;
#pragma unroll 1
  for (int kt = 0; kt < KT; ++kt) {
    const int cur = kt & 1;
    if (kt + 1 < KT) {
#pragma unroll
      for (int i = 0; i < 4; ++i) {
        ra[i] = *(const u32x4*)(gA + (size_t)(32 * i) * lda + (kt + 1) * 64);
        rb[i] = *(const u32x4*)(gB + (size_t)(32 * i) * ldb + (kt + 1) * 64);
      }
    }
    const bf16_t* cA = sA + cur * 128 * LDT + (64 * wp + l32) * LDT + 8 * hh;
    const bf16_t* cB = sB + cur * 128 * LDT + (64 * wq + l32) * LDT + 8 * hh;
#pragma unroll
    for (int ks = 0; ks < 4; ++ks) {
      bf16x8 a0 = ldfrag(cA + ks * 16), a1 = ldfrag(cA + 32 * LDT + ks * 16);
      bf16x8 b0 = ldfrag(cB + ks * 16), b1 = ldfrag(cB + 32 * LDT + ks * 16);
      acc[0][0] = mfma(a0, b0, acc[0][0]);
      acc[0][1] = mfma(a0, b1, acc[0][1]);
      acc[1][0] = mfma(a1, b0, acc[1][0]);
      acc[1][1] = mfma(a1, b1, acc[1][1]);
    }
    if (kt + 1 < KT) {
      const int nx = cur ^ 1;
#pragma unroll
      for (int i = 0; i < 4; ++i) {
        *(u32x4*)(sA + nx * 128 * LDT + (lrow + 32 * i) * LDT + kc) = ra[i];
        *(u32x4*)(sB + nx * 128 * LDT + (lrow + 32 * i) * LDT + kc) = rb[i];
      }
    }
    __syncthreads();
  }
  epi(acc);
}

template <class CM>
DI void transpose_tile(const float* __restrict__ src, int ld_src, int k0, int n0, bf16_t* __restrict__ dst, int ld_dst,
                       const float* __restrict__ sc, float* smf, CM cm) {
  const int tid = tidx_();
  __syncthreads();
  {
    const int nl = tid & 63, kp = tid >> 6;
    const int sn = cm(n0 + nl);
#pragma unroll
    for (int kk = 0; kk < 16; ++kk) {
      const int k = kp * 16 + kk;
      float v = 0.f;
      if (sn >= 0) {
        v = src[(size_t)(k0 + k) * ld_src + sn];
        if (sc) v *= sc[k0 + k];
      }
      smf[nl * 65 + k] = v;
    }
  }
  __syncthreads();
  {
    const int nl = tid >> 2, ks = (tid & 3) * 16;
    const float* r = smf + nl * 65 + ks;
    uint4 u0, u1;
    u0.x = pack2(r[0], r[1]); u0.y = pack2(r[2], r[3]); u0.z = pack2(r[4], r[5]); u0.w = pack2(r[6], r[7]);
    u1.x = pack2(r[8], r[9]); u1.y = pack2(r[10], r[11]); u1.z = pack2(r[12], r[13]); u1.w = pack2(r[14], r[15]);
    bf16_t* d = dst + (size_t)(n0 + nl) * ld_dst + k0 + ks;
    *(uint4*)d = u0;
    *(uint4*)(d + 8) = u1;
  }
}

DI int mod_stream(int row) { const int b = row / TP; return (row - b * TP) < TC ? 4 : b; }

DI void phase_mod(CPARAMS p, unsigned char* smem) {
  float* cs = (float*)smem;
  float* red = cs + 5 * 1024;
  const int tid = tidx_();
  if (bidx_() == 0 && tid < 16) p.CTR[tid] = 0u;
  if (rbidx_() == 0) for (int i = tfull_(); i < XCD_BAR_WORDS; i += 512) p.BAR[i] = 0u;
  bool loaded = false;
  for (int item = bidx_(); item < NLAYER * 96; item += VGRID) {
    if (!loaded) {
      for (int i = tid; i < 5 * 1024; i += 256) {
        const float v = i < 4096 ? p.c[i] : p.c_ctx[i - 4096];
        cs[i] = v * sigmoidf_(v);
      }
      loaded = true;
    }
    __syncthreads();
    const int l = item / 96, cch = item % 96;
    const int col = cch * 64 + (tid & 63), part = tid >> 6;
    const float* wm = p.w_mod + (size_t)l * DM * 6144 + col;
    float a0 = 0.f, a1 = 0.f, a2 = 0.f, a3 = 0.f, a4 = 0.f;
#pragma unroll 16
    for (int k = part * 256; k < part * 256 + 256; ++k) {
      const float wv = wm[(size_t)k * 6144];
      a0 += cs[k] * wv; a1 += cs[1024 + k] * wv; a2 += cs[2048 + k] * wv; a3 += cs[3072 + k] * wv; a4 += cs[4096 + k] * wv;
    }
    float* rr = red + part * 320 + (tid & 63);
    rr[0] = a0; rr[64] = a1; rr[128] = a2; rr[192] = a3; rr[256] = a4;
    __syncthreads();
    for (int i = tid; i < 320; i += 256) {
      const int s = i >> 6, cl = i & 63;
      const float v = red[i] + red[320 + i] + red[640 + i] + red[960 + i] + p.b_mod[l * 6144 + cch * 64 + cl];
      p.MOD[((size_t)l * 5 + s) * 6144 + cch * 64 + cl] = v;
    }
  }
}

#define WC_IN 512
#define WC_UQ 48
#define WC_UKV 32
#define WC_OUT 256
#define WC_FF1 1024
#define WC_FF2 1024
#define WC_LRU 16
#define WC_TOTAL (WC_IN + WC_UQ + WC_UKV + WC_OUT + WC_FF1 + WC_FF2 + WC_LRU)
DI void wconv_item(CPARAMS p, int l, int it, float* smf) {
  if (it < WC_IN) {
    const int nt = it >> 4, kt = it & 15;
    transpose_tile(p.w_in + (size_t)l * DM * 2000, 2000, kt * 64, nt * 64, p.Wb_in, DM, nullptr, smf, [](int j) {
      if (j < 448) return j;
      if (j < 464) return 1472 + (j - 448);
      if (j < 512) return -1;
      if (j < 1536) return 448 + (j - 512);
      return 1488 + (j - 1536);
    });
    return;
  }
  it -= WC_IN;
  if (it < WC_UQ) {
    const int nt = it >> 2, kt = it & 3;
    transpose_tile(p.w_uq + (size_t)l * 256 * 768, 768, kt * 64, nt * 64, p.Wb_uq, 256, p.g_q + l * 256, smf, [](int j) {
      if (j < 512) return (j >> 7) * 192 + (j & 127);
      const int r = j - 512;
      return (r >> 6) * 192 + 128 + (r & 63);
    });
    return;
  }
  it -= WC_UQ;
  if (it < WC_UKV) {
    const int nt = it >> 1, kt = it & 1;
    transpose_tile(p.w_ukv + (size_t)l * 128 * 1024, 1024, kt * 64, nt * 64, p.Wb_ukv, 128, p.g_kv + l * 128, smf, [](int j) {
      if (j < 512) return (j >> 7) * 256 + (j & 127);
      const int r = j - 512;
      return (r >> 7) * 256 + 128 + (r & 127);
    });
    return;
  }
  it -= WC_UKV;
  if (it < WC_OUT) {
    const int nt = it >> 4, kt = it & 15;
    transpose_tile(p.w_out + (size_t)l * DM * DM, DM, kt * 64, nt * 64, p.Wb_out, DM, nullptr, smf, [](int j) { return j; });
    return;
  }
  it -= WC_OUT;
  if (it < WC_FF1) {
    const int nt = it >> 4, kt = it & 15;
    transpose_tile(p.w_ff1 + (size_t)l * DM * DFF, DFF, kt * 64, nt * 64, p.Wb_ff1, DM, nullptr, smf, [](int j) { return j; });
    return;
  }
  it -= WC_FF1;
  if (it < WC_FF2) {
    const int nt = it >> 6, kt = it & 63;
    transpose_tile(p.w_ff2 + (size_t)l * DFF * DM, DM, kt * 64, nt * 64, p.Wb_ff2, DFF, nullptr, smf, [](int j) { return j; });
    return;
  }
  it -= WC_FF2;
  {
    const int g = it >> 2, which = it & 3, d = which >> 1;
    const float* src = ((which & 1) ? p.w_x : p.w_a) + ((size_t)((l * 2 + d) * 4 + g)) * 4096;
    transpose_tile(src, 64, 0, 0, p.Wb_lru + (size_t)(g * 256 + which * 64) * 64, 64, nullptr, smf, [](int j) { return j; });
  }
}

template <int NR>
DI void norm_rows(CPARAMS p, int l, int which  , int row0, bool from_input) {
  const int lane = tidx_() & 63;
  float4 v[NR][4];
  float ss[NR];
  int sidx[NR];
#pragma unroll
  for (int r = 0; r < NR; ++r) {
    const int row = row0 + r;
    const int b = row / TP, pos = row - b * TP;
    sidx[r] = pos < TC ? 4 : b;
    const float* src;
    if (from_input) src = pos < TC ? p.ctx + ((size_t)b * TC + pos) * DM : p.x + ((size_t)b * TL + (pos - TC)) * DM;
    else src = p.X + (size_t)row * DM;
#pragma unroll
    for (int i = 0; i < 4; ++i) v[r][i] = *(const float4*)(src + lane * 4 + 256 * i);
  }
#pragma unroll
  for (int r = 0; r < NR; ++r) {
    float a = 0.f;
#pragma unroll
    for (int i = 0; i < 4; ++i) a += v[r][i].x * v[r][i].x + v[r][i].y * v[r][i].y + v[r][i].z * v[r][i].z + v[r][i].w * v[r][i].w;
    ss[r] = a;
  }
#pragma unroll
  for (int o = 32; o > 0; o >>= 1)
#pragma unroll
    for (int r = 0; r < NR; ++r) ss[r] += __shfl_xor(ss[r], o, 64);
#pragma unroll
  for (int r = 0; r < NR; ++r) {
    const int row = row0 + r;
    const float rs = rsqrtf(ss[r] * (1.f / DM) + EPSF);
    const float* md = p.MOD + ((size_t)l * 5 + sidx[r]) * 6144 + which * 3072;
#pragma unroll
    for (int i = 0; i < 4; ++i) {
      const int cidx = lane * 4 + 256 * i;
      if (from_input) *(float4*)(p.X + (size_t)row * DM + cidx) = v[r][i];
      const float4 sh = *(const float4*)(md + cidx);
      const float4 sc = *(const float4*)(md + 1024 + cidx);
      uint2 o;
      o.x = pack2(v[r][i].x * rs * (1.f + sc.x) + sh.x, v[r][i].y * rs * (1.f + sc.y) + sh.y);
      o.y = pack2(v[r][i].z * rs * (1.f + sc.z) + sh.z, v[r][i].w * rs * (1.f + sc.w) + sh.w);
      *(uint2*)(p.U + (size_t)row * DM + cidx) = o;
    }
  }
}
DI void norm_all_rows(CPARAMS p, int l, int which, bool from_input) {
  const int gw = bidx_() * 4 + (tidx_() >> 6), nw = VGRID * 4;
  int r = (int)((long)NTOK * gw / nw);
  const int rend = (int)((long)NTOK * (gw + 1) / nw);
  for (; r + 4 <= rend; r += 4) norm_rows<4>(p, l, which, r, from_input);
  for (; r < rend; ++r) norm_rows<1>(p, l, which, r, from_input);
}

#define WC_EARLY (WC_IN + WC_UQ + WC_UKV)
#define WC_LATE (WC_OUT + WC_FF1 + WC_FF2)
DI void phase_norm1(CPARAMS p, int l, unsigned char* smem) {
  for (int it = bidx_(); it < WC_EARLY + WC_LRU; it += VGRID) wconv_item(p, l, it < WC_EARLY ? it : it + WC_LATE, (float*)smem);
  norm_all_rows(p, l, 0, l == 0);
}
DI void phase_norm2(CPARAMS p, int l) { norm_all_rows(p, l, 1, false); }

namespace pg8 {
#define PG8_LAS __attribute__((address_space(3)))
typedef float f32x4 __attribute__((ext_vector_type(4)));
constexpr int BM = 256, BK = 64, HALF = 128, HTB = HALF * BK * 2  , STAGE_BYTES = 8 * HTB;
__device__ __forceinline__ int lds_byte(int r, int c) { const int st = (r >> 4) * 2 + (c >> 5), rr = r & 15, cc = c & 31, ob = rr * 64 + cc * 2; return st * 1024 + (ob ^ (((ob >> 9) & 1) << 5)); }
__device__ __forceinline__ void stage_rc(int b, int& R, int& C) { const int st = b / 1024, sb = b % 1024, swz = sb ^ (((sb >> 9) & 1) << 5); R = (st >> 1) * 16 + swz / 64; C = (st & 1) * 32 + (swz % 64) / 2; }
__device__ __forceinline__ int perm32(int rho) { const int n = rho >> 4, i = rho & 15; return 8 * (i >> 2) + 4 * n + (i & 3); }
struct Unit { int pm, pn, kq; };
struct Gemm { const bf16_t* A; const bf16_t* Bt; int K, ld; };
template <class Epi, class Sched>
__device__ __forceinline__ void gemm_phase(PG8_LAS unsigned char* lds, const Gemm g, const Sched& S, const Epi& E) {
    const int tid = tfull_(), wid = __builtin_amdgcn_readfirstlane(tid >> 6), lane = tid & 63, wr = wid >> 2, wc = wid & 3, fr = lane & 15, fq = lane >> 4;
    const int K = g.ld, nt = g.K / BK;
    unsigned voffA[2], voffB[2];
#pragma unroll
    for (int i = 0; i < 2; ++i) { int R, C; stage_rc(tid * 16 + i * 8192, R, C); const int Rb = Epi::PERM ? ((R & ~31) + perm32(R & 31)) : R;
        voffA[i] = (unsigned)(R * K + C) * 2u; voffB[i] = (unsigned)(Rb * K + C) * 2u; }
    const size_t kstep = (size_t)(BK * 2);
    const size_t hstep = (size_t)HALF * K * 2;
    const size_t tstep = 2 * hstep;
    const unsigned ldsw = (unsigned)wid * 1024u;
    const int aoff = lds_byte(wr * 64 + fr, fq * 8), boff = lds_byte(wc * 32 + fr, fq * 8);
#define PG8_SA(b, h) (((b) * 2 + (h)) * HTB)
#define PG8_SB(b, h) ((4 + (b) * 2 + (h)) * HTB)
#define PG8_STAGE(bufoff, gbase, voff) do { _Pragma("unroll") for (int _i = 0; _i < 2; ++_i) \
        __builtin_amdgcn_global_load_lds((const unsigned*)((const char*)(gbase) + (voff)[_i]), (PG8_LAS unsigned*)(lds + (bufoff) + ldsw + _i * 8192), 16, 0, 0); } while (0)
#define PG8_LDA(dst, b, h) do { _Pragma("unroll") for (int m = 0; m < 4; ++m) _Pragma("unroll") for (int k = 0; k < 2; ++k) dst[m][k] = *(const PG8_LAS bf16x8*)(lds + PG8_SA(b, h) + aoff + m * 2048 + k * 1024); } while (0)
#define PG8_LDB(dst, b, h) do { _Pragma("unroll") for (int n = 0; n < 2; ++n) _Pragma("unroll") for (int k = 0; k < 2; ++k) dst[n][k] = *(const PG8_LAS bf16x8*)(lds + PG8_SB(b, h) + boff + n * 2048 + k * 1024); } while (0)
#define PG8_MMA(ai, bj, At, Bt) do { __builtin_amdgcn_s_setprio(1); _Pragma("unroll") for (int m = 0; m < 4; ++m) _Pragma("unroll") for (int n = 0; n < 2; ++n) _Pragma("unroll") for (int k = 0; k < 2; ++k) \
        acc[ai][bj][m][n] = __builtin_amdgcn_mfma_f32_16x16x32_bf16(Bt[n][k], At[m][k], acc[ai][bj][m][n], 0, 0, 0); __builtin_amdgcn_s_setprio(0); } while (0)
#define PG8_WAIT_V(n) asm volatile("s_waitcnt vmcnt(" #n ")" ::: "memory")
#define PG8_WAIT_L(n) asm volatile("s_waitcnt lgkmcnt(" #n ")" ::: "memory")
#define PG8_BAR __builtin_amdgcn_s_barrier()
#define PG8_SCHED __builtin_amdgcn_sched_barrier(0)
    Unit cur, nxt; int ui = 0;
    if (!S.next(0, cur)) return;
    f32x4 acc[2][2][4][2];
#pragma unroll
    for (int a = 0; a < 2; ++a)
#pragma unroll
        for (int b = 0; b < 2; ++b)
#pragma unroll
            for (int m = 0; m < 4; ++m)
#pragma unroll
                for (int n = 0; n < 2; ++n) acc[a][b][m][n] = (f32x4){0.f, 0.f, 0.f, 0.f};
    bf16x8 At[4][2], B0[2][2], B1[2][2];
    const size_t kqstep = (size_t)g.K * 2;
    const char* cA = (const char*)g.A + (size_t)cur.pm * tstep + (size_t)cur.kq * kqstep; const char* cB = (const char*)g.Bt + (size_t)cur.pn * tstep + (size_t)cur.kq * kqstep;
    S.a_ready(cur);
    PG8_STAGE(PG8_SB(0, 0), cB, voffB); PG8_STAGE(PG8_SA(0, 0), cA, voffA); PG8_STAGE(PG8_SB(0, 1), cB + hstep, voffB); PG8_STAGE(PG8_SA(0, 1), cA + hstep, voffA);
    if (wr == 1) PG8_BAR;
    PG8_WAIT_V(4); PG8_BAR;
    PG8_STAGE(PG8_SB(1, 0), cB + kstep, voffB); PG8_STAGE(PG8_SA(1, 0), cA + kstep, voffA); PG8_STAGE(PG8_SB(1, 1), cB + hstep + kstep, voffB);
    PG8_WAIT_V(6); PG8_BAR;
    for (;;) {
        const bool has_next = S.next(ui + 1, nxt);
        const char* nA = has_next ? (const char*)g.A + (size_t)nxt.pm * tstep + (size_t)nxt.kq * kqstep : cA; const char* nB = has_next ? (const char*)g.Bt + (size_t)nxt.pn * tstep + (size_t)nxt.kq * kqstep : cB;
        for (int t = 0; t < nt; t += 2) {
            const bool last = (t == nt - 2);
            const char* a1 = cA + (size_t)(t + 1) * kstep;
            const char* a2 = last ? nA : cA + (size_t)(t + 2) * kstep; const char* b2 = last ? nB : cB + (size_t)(t + 2) * kstep;
            const char* a3 = a2 + kstep; const char* b3 = b2 + kstep;
            if (last && has_next) S.a_ready(nxt);
            PG8_LDB(B0, 0, 0); PG8_SCHED; PG8_LDA(At, 0, 0); PG8_STAGE(PG8_SA(1, 1), a1 + hstep, voffA);
            PG8_WAIT_L(8); PG8_BAR; PG8_WAIT_L(0); PG8_MMA(0, 0, At, B0); PG8_BAR; PG8_SCHED;
            PG8_LDB(B1, 0, 1); PG8_STAGE(PG8_SB(0, 0), b2, voffB);
            PG8_BAR; PG8_WAIT_L(0); PG8_MMA(0, 1, At, B1); PG8_BAR;
            PG8_LDA(At, 0, 1); PG8_STAGE(PG8_SA(0, 0), a2, voffA);
            PG8_BAR; PG8_WAIT_L(0); PG8_MMA(1, 0, At, B0); PG8_BAR; PG8_SCHED;
            PG8_STAGE(PG8_SB(0, 1), b2 + hstep, voffB);
            PG8_WAIT_V(6); PG8_BAR; PG8_MMA(1, 1, At, B1); PG8_BAR;
            PG8_LDB(B0, 1, 0); PG8_SCHED; PG8_LDA(At, 1, 0); PG8_STAGE(PG8_SA(0, 1), a2 + hstep, voffA);
            PG8_WAIT_L(8); PG8_BAR; PG8_WAIT_L(0); PG8_MMA(0, 0, At, B0); PG8_BAR; PG8_SCHED;
            PG8_LDB(B1, 1, 1); PG8_STAGE(PG8_SB(1, 0), b3, voffB);
            PG8_BAR; PG8_WAIT_L(0); PG8_MMA(0, 1, At, B1); PG8_BAR;
            PG8_LDA(At, 1, 1); PG8_STAGE(PG8_SA(1, 0), a3, voffA);
            PG8_BAR; PG8_WAIT_L(0); PG8_MMA(1, 0, At, B0); PG8_BAR; PG8_SCHED;
            PG8_STAGE(PG8_SB(1, 1), b3 + hstep, voffB);
            PG8_WAIT_V(6); PG8_BAR; PG8_MMA(1, 1, At, B1); PG8_BAR;
        }
            if constexpr (!Epi::AFTER_DRAIN) { E(acc, cur, wr, wc, fr, fq); S.done(cur); }
            if (!has_next) break;
#pragma unroll
        for (int a = 0; a < 2; ++a)
#pragma unroll
            for (int b = 0; b < 2; ++b)
#pragma unroll
                for (int m = 0; m < 4; ++m)
#pragma unroll
                    for (int n = 0; n < 2; ++n) acc[a][b][m][n] = (f32x4){0.f, 0.f, 0.f, 0.f};
        cur = nxt; cA = nA; cB = nB; ++ui;
    }
    PG8_WAIT_V(0);
    if (wr == 0) PG8_BAR;
    PG8_BAR;
    if constexpr (Epi::AFTER_DRAIN) { E.fused(acc, cur, wr, wc, fr, fq, lds, wid, lane); S.done(cur); }
#undef PG8_SA
#undef PG8_SB
#undef PG8_STAGE
#undef PG8_LDA
#undef PG8_LDB
#undef PG8_MMA
#undef PG8_WAIT_V
#undef PG8_WAIT_L
#undef PG8_BAR
#undef PG8_SCHED
}
}

DI int xcd_order() { const int b = rbidx_(), g8 = (int)gridDim.x >> 3; return (b & 7) * g8 + (b >> 3); }

struct UnitOrder {
  int nunits, G, c, mode, nK, skipctx;
  DI bool next(int i, pg8::Unit& u) const {
    const int L = i * G + c;
    if (L >= nunits) return false;
    if (mode == 0) { u.pm = L >> 3; u.pn = L & 7; u.kq = 0; }
    else if (mode == 1) { const int g = L >> 5, j = L & 31; u.pm = (g >> 1) * 4 + (j >> 3); u.pn = (g & 1) * 8 + (j & 7); u.kq = 0; }
    else { u.kq = L % nK; const int t = L / nK; u.pn = t & 3; u.pm = t >> 2; }
    if (skipctx) u.pm += (u.pm >> 4) + 1;
    return true;
  }
  DI void a_ready(const pg8::Unit&) const {}
  DI void done(const pg8::Unit&) const {}
};

struct EpiIn {
  static constexpr bool PERM = true, AFTER_DRAIN = false;
  bf16_t* Z; float* ZGt; const float* gbias;
  DI void operator()(const pg8::f32x4 (&acc)[2][2][4][2], const pg8::Unit& u, int wr, int wc, int fr, int fq) const {
    const int row0 = u.pm * 256 + wr * 64 + fr, col0 = u.pn * 256 + wc * 32 + 8 * fq;
#pragma unroll
    for (int ai = 0; ai < 2; ++ai)
#pragma unroll
      for (int m = 0; m < 4; ++m) {
        const int row = row0 + ai * 128 + m * 16;
        bf16_t* rowp = Z + (size_t)row * ZW + col0;
#pragma unroll
        for (int bj = 0; bj < 2; ++bj) {
          const pg8::f32x4 v0 = acc[ai][bj][m][0], v1 = acc[ai][bj][m][1];
          u32x4 w; w[0] = pack2(v0[0], v0[1]); w[1] = pack2(v0[2], v0[3]); w[2] = pack2(v1[0], v1[1]); w[3] = pack2(v1[2], v1[3]);
          *(u32x4*)(rowp + bj * 128) = w;
          const int c = col0 + bj * 128;
          if (c >= ZG && c < ZG + 16) {
            float* gp = ZGt + (size_t)row * 16 + (c - ZG);
            const float* gb = gbias + (c - ZG);
            *(float4*)gp = make_float4(v0[0] + gb[0], v0[1] + gb[1], v0[2] + gb[2], v0[3] + gb[3]);
            *(float4*)(gp + 4) = make_float4(v1[0] + gb[4], v1[1] + gb[5], v1[2] + gb[6], v1[3] + gb[7]);
          }
        }
      }
  }
};

struct EpiFf1 {
  static constexpr bool PERM = true, AFTER_DRAIN = false;
  bf16_t* H;
  DI void operator()(const pg8::f32x4 (&acc)[2][2][4][2], const pg8::Unit& u, int wr, int wc, int fr, int fq) const {
    const int row0 = u.pm * 256 + wr * 64 + fr, col0 = u.pn * 256 + wc * 32 + 8 * fq;
#pragma unroll
    for (int ai = 0; ai < 2; ++ai)
#pragma unroll
      for (int m = 0; m < 4; ++m) {
        bf16_t* rowp = H + (size_t)(row0 + ai * 128 + m * 16) * DFF + col0;
#pragma unroll
        for (int bj = 0; bj < 2; ++bj) {
          pg8::f32x4 v0 = acc[ai][bj][m][0], v1 = acc[ai][bj][m][1];
#pragma unroll
          for (int j = 0; j < 4; ++j) { const float a = fmaxf(v0[j], 0.f), b = fmaxf(v1[j], 0.f); v0[j] = a * a; v1[j] = b * b; }
          u32x4 w; w[0] = pack2(v0[0], v0[1]); w[1] = pack2(v0[2], v0[3]); w[2] = pack2(v1[0], v1[1]); w[3] = pack2(v1[2], v1[3]);
          *(u32x4*)(rowp + bj * 128) = w;
        }
      }
  }
};

struct EpiResid {
  static constexpr bool PERM = false, AFTER_DRAIN = false;
  float* X; const float* gate_l;
  DI void operator()(const pg8::f32x4 (&acc)[2][2][4][2], const pg8::Unit& u, int wr, int wc, int fr, int fq) const {
    const int row0 = u.pm * 256 + wr * 64 + fr, col0 = u.pn * 256 + wc * 32 + 4 * fq;
    const float* gate = gate_l + (size_t)mod_stream(u.pm * 256) * 6144;
    pg8::f32x4 gv[2][2];
#pragma unroll
    for (int bj = 0; bj < 2; ++bj)
#pragma unroll
      for (int n = 0; n < 2; ++n) gv[bj][n] = *(const pg8::f32x4*)(gate + col0 + bj * 128 + n * 16);
#pragma unroll
    for (int ai = 0; ai < 2; ++ai)
#pragma unroll
      for (int m = 0; m < 4; ++m) {
        float* rowp = X + (size_t)(row0 + ai * 128 + m * 16) * DM + col0;
#pragma unroll
        for (int bj = 0; bj < 2; ++bj)
#pragma unroll
          for (int n = 0; n < 2; ++n) {
            pg8::f32x4* xp = (pg8::f32x4*)(rowp + bj * 128 + n * 16);
            *xp = *xp + gv[bj][n] * acc[ai][bj][m][n];
          }
        asm volatile("" ::: "memory");
      }
  }
};

DI void phase_gemm_in(CPARAMS p, int l, unsigned char* smem, unsigned char* hs) {
  pg8::Gemm g; g.A = p.U; g.Bt = p.Wb_in; g.K = DM; g.ld = DM;
  UnitOrder S; S.nunits = 68 * 8; S.G = (int)gridDim.x; S.c = xcd_order(); S.mode = 0; S.nK = 1; S.skipctx = 0;
  EpiIn E; E.Z = p.Z; E.ZGt = p.ZGt; E.gbias = p.gate_bias + l * 16;
  pg8::gemm_phase((PG8_LAS unsigned char*)smem, g, S, E);
  const int G = (int)gridDim.x, rounds = (544 + G - 1) / G, busy = 544 - (rounds - 1) * G;
  const int nfree = G - busy;
  __syncthreads();
  if (nfree > 0) {
    if (S.c >= busy) {
      const int hv = (S.c - busy) * 2 + hidx_(), nh = nfree * 2;
      for (int it = hv; it < WC_LATE; it += nh) wconv_item(p, l, WC_EARLY + it, (float*)hs);
    }
  } else {
    for (int it = bidx_(); it < WC_LATE; it += VGRID) wconv_item(p, l, WC_EARLY + it, (float*)hs);
  }
}
DI void phase_gemm_ff1(CPARAMS p, int skipctx, unsigned char* smem) {
  pg8::Gemm g; g.A = p.U; g.Bt = p.Wb_ff1; g.K = DM; g.ld = DM;
  UnitOrder S; S.nunits = (skipctx ? 64 : 68) * 16; S.G = (int)gridDim.x; S.c = xcd_order(); S.mode = 1; S.nK = 1; S.skipctx = skipctx;
  EpiFf1 E; E.H = p.H;
  pg8::gemm_phase((PG8_LAS unsigned char*)smem, g, S, E);
}
DI void phase_gemm_resid_left(CPARAMS p, int l, const bf16_t* A, int K, const bf16_t* Wt, int gate_chunk, int first_tile, int ntiles, int skipctx, unsigned char* smem);
DI void phase_gemm_resid(CPARAMS p, int l, const bf16_t* A, int K, const bf16_t* Wt, int gate_chunk, int skipctx, unsigned char* smem) {
  const int G = (int)gridDim.x;
  const int ntiles = skipctx ? 256 : 272;
  const int whole = (ntiles / G) * G;
  pg8::Gemm g; g.A = A; g.Bt = Wt; g.K = K; g.ld = K;
  UnitOrder S; S.nunits = whole; S.G = G; S.c = xcd_order(); S.mode = 2; S.nK = 1; S.skipctx = skipctx;
  EpiResid E; E.X = p.X; E.gate_l = p.MOD + (size_t)l * 5 * 6144 + gate_chunk * 1024;
  pg8::gemm_phase((PG8_LAS unsigned char*)smem, g, S, E);
  __syncthreads();
  phase_gemm_resid_left(p, l, A, K, Wt, gate_chunk, whole, ntiles, skipctx, smem);
}

template <class Epi>
DI void gemm256s(const bf16_t* __restrict__ A, int lda, const bf16_t* __restrict__ B, int ldb, int kt0, int kt1, bf16_t* sm, Epi&& epi) {
  const int tid = tfull_(), lane = tid & 63, w = tid >> 6, wp = w >> 2, wq = w & 3, l32 = lane & 31, hh = lane >> 5;
  bf16_t* sA = sm;
  bf16_t* sB = sm + 2 * 256 * LDT;
  f32x16 acc[4][2];
#pragma unroll
  for (int i = 0; i < 4; ++i)
#pragma unroll
    for (int j = 0; j < 2; ++j) acc[i][j] = zero16();
  const int lrow = tid >> 3, kc = (tid & 7) * 8;
  const bf16_t* gA = A + (size_t)lrow * lda + kc;
  const bf16_t* gB = B + (size_t)lrow * ldb + kc;
  u32x4 ra[4], rb[4];
#pragma unroll
  for (int i = 0; i < 4; ++i) {
    ra[i] = *(const u32x4*)(gA + (size_t)(64 * i) * lda + kt0 * 64);
    rb[i] = *(const u32x4*)(gB + (size_t)(64 * i) * ldb + kt0 * 64);
  }
#pragma unroll
  for (int i = 0; i < 4; ++i) {
    *(u32x4*)(sA + (lrow + 64 * i) * LDT + kc) = ra[i];
    *(u32x4*)(sB + (lrow + 64 * i) * LDT + kc) = rb[i];
  }
  __syncthreads();
#pragma unroll 1
  for (int kt = kt0; kt < kt1; ++kt) {
    const int cur = (kt - kt0) & 1;
    if (kt + 1 < kt1) {
#pragma unroll
      for (int i = 0; i < 4; ++i) {
        ra[i] = *(const u32x4*)(gA + (size_t)(64 * i) * lda + (kt + 1) * 64);
        rb[i] = *(const u32x4*)(gB + (size_t)(64 * i) * ldb + (kt + 1) * 64);
      }
    }
    const bf16_t* cA = sA + cur * 256 * LDT + (128 * wp + l32) * LDT + 8 * hh;
    const bf16_t* cB = sB + cur * 256 * LDT + (64 * wq + l32) * LDT + 8 * hh;
#pragma unroll
    for (int ks = 0; ks < 4; ++ks) {
      const bf16x8 b0 = ldfrag(cB + ks * 16), b1 = ldfrag(cB + 32 * LDT + ks * 16);
#pragma unroll
      for (int mi = 0; mi < 4; ++mi) {
        const bf16x8 a = ldfrag(cA + mi * 32 * LDT + ks * 16);
        acc[mi][0] = mfma(a, b0, acc[mi][0]);
        acc[mi][1] = mfma(a, b1, acc[mi][1]);
      }
    }
    if (kt + 1 < kt1) {
      const int nx = cur ^ 1;
#pragma unroll
      for (int i = 0; i < 4; ++i) {
        *(u32x4*)(sA + nx * 256 * LDT + (lrow + 64 * i) * LDT + kc) = ra[i];
        *(u32x4*)(sB + nx * 256 * LDT + (lrow + 64 * i) * LDT + kc) = rb[i];
      }
    }
    __syncthreads();
  }
  epi(acc);
}

DI void phase_gemm_resid_left(CPARAMS p, int l, const bf16_t* A, int K, const bf16_t* Wt, int gate_chunk, int first_tile, int ntiles, int skipctx, unsigned char* smem) {
  const int tid = tfull_(), lane = tid & 63, w = tid >> 6, wp = w >> 2, wq = w & 3, l32 = lane & 31, hh = lane >> 5;
  const int KT = K >> 6;
  const long total = (long)(ntiles - first_tile) * KT;
  const int vb = xcd_order();
  long u = total * vb / (int)gridDim.x;
  const long uend = total * (vb + 1) / (int)gridDim.x;
  while (u < uend) {
    const int trel = (int)(u / KT), kt0 = (int)(u - (long)trel * KT);
    const int kt1 = (int)((uend - (long)trel * KT) < KT ? (uend - (long)trel * KT) : KT);
    const int tile = first_tile + trel;
    int mt = tile >> 2; const int nt = tile & 3;
    if (skipctx) mt += (mt >> 4) + 1;
    const int s = mod_stream(mt * 256);
    const float* gate = p.MOD + ((size_t)l * 5 + s) * 6144 + gate_chunk * 1024;
    gemm256s(A + (size_t)mt * 256 * K, K, Wt + (size_t)nt * 256 * K, K, kt0, kt1, (bf16_t*)smem, [&](f32x16 (&acc)[4][2]) {
#pragma unroll
      for (int mi = 0; mi < 4; ++mi)
#pragma unroll
        for (int ni = 0; ni < 2; ++ni) {
          const int col = nt * 256 + 64 * wq + 32 * ni + l32;
          const float g = gate[col];
#pragma unroll
          for (int i = 0; i < 16; ++i) {
            const int row = mt * 256 + 128 * wp + 32 * mi + crow(i, hh);
            unsafeAtomicAdd(p.X + (size_t)row * DM + col, g * acc[mi][ni][i]);
          }
        }
    });
    u += kt1 - kt0;
  }
}

DI void mla_krope_item(CPARAMS p, int mt, unsigned char* smem) {
  const int tid = tidx_(), lane = tid & 63, w = tid >> 6, wp = w >> 1, wq = w & 1, l32 = lane & 31, hh = lane >> 5;
  float* rsq = (float*)(smem + 73728);
  float* rskv = rsq + 128;
  const int row0 = mt * 128;
  const int b = row0 / TP, pos0 = row0 - b * TP;
  const bool latent = pos0 >= TC;
  __syncthreads();
  {
    const int tok = tid >> 1, half = tid & 1;
    const bf16_t* zr = p.Z + (size_t)(row0 + tok) * ZW;
    const int pos = pos0 + tok;
    const int t_lat = pos - TC;
    const float coord = half == 0 ? (float)(t_lat >> 6) : (float)(t_lat & 63);
    u32x4 x1v[2], x2v[2], o1v[2], o2v[2];
    x1v[0] = *(const u32x4*)(zr + ZKR + 16 * half); x1v[1] = *(const u32x4*)(zr + ZKR + 16 * half + 8);
    x2v[0] = *(const u32x4*)(zr + ZKR + 32 + 16 * half); x2v[1] = *(const u32x4*)(zr + ZKR + 32 + 16 * half + 8);
#pragma unroll
    for (int q = 0; q < 2; ++q)
#pragma unroll
      for (int jj = 0; jj < 4; ++jj) {
        const unsigned a1 = x1v[q][jj], a2 = x2v[q][jj];
        float cs0 = 1.f, sn0 = 0.f, cs1 = 1.f, sn1 = 0.f;
        if (latent) {
          const int j = 8 * q + 2 * jj;
          const float ang0 = coord * ex2(-(float)j * (13.287712379549449f / 16.f));
          const float ang1 = coord * ex2(-(float)(j + 1) * (13.287712379549449f / 16.f));
          cs0 = __cosf(ang0); sn0 = __sinf(ang0); cs1 = __cosf(ang1); sn1 = __sinf(ang1);
        }
        const float p0 = bflo(a1), p1 = bfhi(a1), r0 = bflo(a2), r1 = bfhi(a2);
        o1v[q][jj] = pack2(p0 * cs0 - r0 * sn0, p1 * cs1 - r1 * sn1);
        o2v[q][jj] = pack2(p0 * sn0 + r0 * cs0, p1 * sn1 + r1 * cs1);
      }
#pragma unroll
    for (int hd = 0; hd < 4; ++hd) {
      bf16_t* kd = p.Kb + ((size_t)(b * 4 + hd) * TP + pos) * 192 + 128 + 16 * half;
      *(u32x4*)(kd) = o1v[0];
      *(u32x4*)(kd + 8) = o1v[1];
      *(u32x4*)(kd + 32) = o2v[0];
      *(u32x4*)(kd + 40) = o2v[1];
    }
  }
  (void)rsq; (void)rskv; (void)wp; (void)wq; (void)l32; (void)hh;
}

DI void mla_q_item(CPARAMS p, int mt, int nt, unsigned char* smem) {
  const int tid = tidx_(), lane = tid & 63, w = tid >> 6, wp = w >> 1, wq = w & 1, l32 = lane & 31, hh = lane >> 5;
  float* rsq = (float*)(smem + 73728);
  float* rskv = rsq + 128;
  const int row0 = mt * 128;
  const int b = row0 / TP, pos0 = row0 - b * TP;
  const bool latent = pos0 >= TC;
  __syncthreads();
  {
    const int tok = tid >> 1, half = tid & 1;
    const bf16_t* zr = p.Z + (size_t)(row0 + tok) * ZW;
    float ss = 0.f;
#pragma unroll
    for (int i = 0; i < 16; ++i) {
      const uint4 u = *(const uint4*)(zr + ZQ + 128 * half + 8 * i);
      float a;
      a = bflo(u.x); ss += a * a; a = bfhi(u.x); ss += a * a; a = bflo(u.y); ss += a * a; a = bfhi(u.y); ss += a * a;
      a = bflo(u.z); ss += a * a; a = bfhi(u.z); ss += a * a; a = bflo(u.w); ss += a * a; a = bfhi(u.w); ss += a * a;
    }
    ss += __shfl_xor(ss, 1, 64);
    if (half == 0) rsq[tok] = rsqrtf(ss * (1.f / 256.f) + EPSF);
  }
  __syncthreads();
  {
    gemm128(p.Z + (size_t)row0 * ZW + ZQ, ZW, p.Wb_uq + (size_t)nt * 128 * 256, 256, 256, (bf16_t*)smem, [&](f32x16 (&acc)[2][2]) {
      {
        const int hd = nt < 4 ? nt : 2 * (nt - 4) + wq;
#pragma unroll
        for (int mi = 0; mi < 2; ++mi)
#pragma unroll
          for (int ni = 0; ni < 2; ++ni) {
            const int d = nt < 4 ? 64 * wq + 32 * ni + l32 : 128 + 32 * ni + l32;
#pragma unroll
            for (int i = 0; i < 16; ++i) {
              const int rl = 64 * wp + 32 * mi + crow(i, hh);
              p.Qb[((size_t)(b * 4 + hd) * TP + pos0 + rl) * 192 + d] = f2bf(acc[mi][ni][i] * rsq[rl] * QSCALE);
            }
          }
      }
    });
  }
  (void)latent; (void)rskv;
}

DI void mla_kv_item(CPARAMS p, int mt, int nt, unsigned char* smem) {
  const int tid = tidx_(), lane = tid & 63, w = tid >> 6, wp = w >> 1, wq = w & 1, l32 = lane & 31, hh = lane >> 5;
  float* rsq = (float*)(smem + 73728);
  float* rskv = rsq + 128;
  const int row0 = mt * 128;
  const int b = row0 / TP, pos0 = row0 - b * TP;
  const bool latent = pos0 >= TC;
  __syncthreads();
  {
    const int tok = tid >> 1, half = tid & 1;
    const bf16_t* zr = p.Z + (size_t)(row0 + tok) * ZW;
    float s2 = 0.f;
#pragma unroll
    for (int i = 0; i < 8; ++i) {
      const uint4 u = *(const uint4*)(zr + ZKV + 64 * half + 8 * i);
      float a;
      a = bflo(u.x); s2 += a * a; a = bfhi(u.x); s2 += a * a; a = bflo(u.y); s2 += a * a; a = bfhi(u.y); s2 += a * a;
      a = bflo(u.z); s2 += a * a; a = bfhi(u.z); s2 += a * a; a = bflo(u.w); s2 += a * a; a = bfhi(u.w); s2 += a * a;
    }
    s2 += __shfl_xor(s2, 1, 64);
    if (half == 0) rskv[tok] = rsqrtf(s2 * (1.f / 128.f) + EPSF);
  }
  __syncthreads();
  {
    gemm128(p.Z + (size_t)row0 * ZW + ZKV, ZW, p.Wb_ukv + (size_t)nt * 128 * 128, 128, 128, (bf16_t*)smem, [&](f32x16 (&acc)[2][2]) {
      if (nt < 4) {
#pragma unroll
        for (int mi = 0; mi < 2; ++mi)
#pragma unroll
          for (int ni = 0; ni < 2; ++ni) {
            const int d = 64 * wq + 32 * ni + l32;
#pragma unroll
            for (int i = 0; i < 16; ++i) {
              const int rl = 64 * wp + 32 * mi + crow(i, hh);
              p.Kb[((size_t)(b * 4 + nt) * TP + pos0 + rl) * 192 + d] = f2bf(acc[mi][ni][i] * rskv[rl]);
            }
          }
      } else {
        const int hd = nt - 4;
#pragma unroll
        for (int mi = 0; mi < 2; ++mi)
#pragma unroll
          for (int ni = 0; ni < 2; ++ni) {
            const int dv = 64 * wq + 32 * ni + l32;
            bf16_t* vd = p.Vt + ((size_t)(b * 4 + hd) * 128 + dv) * TP + pos0;
#pragma unroll
            for (int g = 0; g < 4; ++g) {
              const int rl = 64 * wp + 32 * mi + 8 * g + 4 * hh;
              const int ppos = 64 * wp + 32 * mi + 16 * (g >> 1) + 8 * hh + 4 * (g & 1);
              uint2 o;
              o.x = pack2(acc[mi][ni][4 * g] * rskv[rl], acc[mi][ni][4 * g + 1] * rskv[rl + 1]);
              o.y = pack2(acc[mi][ni][4 * g + 2] * rskv[rl + 2], acc[mi][ni][4 * g + 3] * rskv[rl + 3]);
              *(uint2*)(vd + ppos) = o;
            }
          }
      }
    });
  }
  (void)latent; (void)rsq;
}

DI void attn_item(CPARAMS p, int b, int hd, int q0, int nkt, unsigned char* smem) {
  const int tid = tidx_(), lane = tid & 63, w = tid >> 6, l32 = lane & 31, hh = lane >> 5;
  bf16_t* sK = (bf16_t*)smem;
  bf16_t* sV = sK + 2 * 64 * 200;
  const size_t bh = (size_t)(b * 4 + hd);
  bf16x8 qf[12];
  {
    const bf16_t* Qg = p.Qb + (bh * TP + q0 + 32 * w + l32) * 192 + 8 * hh;
#pragma unroll
    for (int ks = 0; ks < 12; ++ks) qf[ks] = ldfrag(Qg + 16 * ks);
    if (q0 >= TC) {
      const int t_lat = q0 - TC + 32 * w + l32;
#pragma unroll
      for (int kq = 0; kq < 2; ++kq) {
        const float coord = kq == 0 ? (float)(t_lat >> 6) : (float)(t_lat & 63);
        const u32x4 a1 = __builtin_bit_cast(u32x4, qf[8 + kq]), a2 = __builtin_bit_cast(u32x4, qf[10 + kq]);
        u32x4 n1, n2;
#pragma unroll
        for (int jj = 0; jj < 4; ++jj) {
          const int j = 8 * hh + 2 * jj;
          const float ang0 = coord * ex2(-(float)j * (13.287712379549449f / 16.f));
          const float ang1 = coord * ex2(-(float)(j + 1) * (13.287712379549449f / 16.f));
          const float cs0 = __cosf(ang0), sn0 = __sinf(ang0), cs1 = __cosf(ang1), sn1 = __sinf(ang1);
          const float p0 = bflo(a1[jj]), p1 = bfhi(a1[jj]), r0 = bflo(a2[jj]), r1 = bfhi(a2[jj]);
          n1[jj] = pack2(p0 * cs0 - r0 * sn0, p1 * cs1 - r1 * sn1);
          n2[jj] = pack2(p0 * sn0 + r0 * cs0, p1 * sn1 + r1 * cs1);
        }
        qf[8 + kq] = __builtin_bit_cast(bf16x8, n1);
        qf[10 + kq] = __builtin_bit_cast(bf16x8, n2);
      }
    }
  }
  const bf16_t* Kg = p.Kb + bh * TP * 192;
  const bf16_t* Vg = p.Vt + bh * 128 * TP;
  typedef __attribute__((address_space(3))) unsigned lds_u32;
  const int hoff = hidx_();
  const int w8 = __builtin_amdgcn_readfirstlane(w + 4 * hoff);
  lds_u32* sKl = (lds_u32*)sK;
  lds_u32* sVl = (lds_u32*)sV;
#define ATT_LOAD_K(T)                                                                             \
  _Pragma("unroll") for (int i = 0; i < 4; ++i) {                                                 \
    const int ch = w8 + 8 * i;                                                                    \
    if (ch < 25) {                                                                                \
      const int ob = ch * 1024 + lane * 16, row = ob / 400, cb = ob - row * 400;                  \
      const bf16_t* sp = Kg + (size_t)(T) * (64 * 192) + (cb < 384 ? row * 192 + (cb >> 1) : 0);  \
      __builtin_amdgcn_global_load_lds((const unsigned*)sp, sKl + ((T) & 1) * 6400 + ch * 256, 16, 0, 0); \
    }                                                                                             \
  }
#define ATT_LOAD_V(T)                                                                             \
  _Pragma("unroll") for (int i = 0; i < 3; ++i) {                                                 \
    const int ch = w8 + 8 * i;                                                                    \
    if (ch < 18) {                                                                                \
      const int ob = ch * 1024 + lane * 16, row = ob / 144, cb = ob - row * 144;                  \
      const bf16_t* sp = Vg + 64 * (T) + (cb < 128 ? (size_t)row * TP + (cb >> 1) : 0);          \
      __builtin_amdgcn_global_load_lds((const unsigned*)sp, sVl + ((T) & 1) * 4608 + ch * 256, 16, 0, 0); \
    }                                                                                             \
  }
#define ATT_RD1(D, A, OFF) asm volatile("ds_read_b128 %0, %1 offset:%2" : "=v"(D) : "v"(A), "n"(OFF))
#define ATT_RD4(F, A, O0, O1, O2, O3) do { ATT_RD1(F[0], A, O0); ATT_RD1(F[1], A, O1); ATT_RD1(F[2], A, O2); ATT_RD1(F[3], A, O3); } while (0)
#define ATT_RD2(F, A, O0, O1) do { ATT_RD1(F[0], A, O0); ATT_RD1(F[1], A, O1); } while (0)
#define ATT_WAIT2(F, N) asm volatile("s_waitcnt lgkmcnt(%2)" : "+v"(F[0]), "+v"(F[1]) : "n"(N))
#define ATT_WAIT4(F, N) asm volatile("s_waitcnt lgkmcnt(%4)" : "+v"(F[0]), "+v"(F[1]), "+v"(F[2]), "+v"(F[3]) : "n"(N))
  const unsigned kaddr0 = (unsigned)(size_t)(sK + l32 * 200 + 8 * hh);
  const unsigned vaddr0 = (unsigned)(size_t)(sV + l32 * LDT + 8 * hh);
  __syncthreads();
  ATT_LOAD_K(0);
  asm volatile("s_waitcnt vmcnt(0)" ::: "memory");
  for (int i = tfull_(); i < 2 * 18432 / 16; i += 512) ((u32x4*)sV)[i] = (u32x4){0u, 0u, 0u, 0u};
  f32x16 o[4];
#pragma unroll
  for (int i = 0; i < 4; ++i) o[i] = zero16();
  f32x16 sX = zero16(), sY = zero16();
  bf16x8 pX[2], pY[2];
  pX[0] = (bf16x8){0, 0, 0, 0, 0, 0, 0, 0}; pX[1] = pX[0]; pY[0] = pX[0]; pY[1] = pX[0];
  float m = -1e30f, lsum = 0.f;
  __syncthreads();
#define ATT_EXP2(SV, J0, J1) { SV[J0] = ex2(SV[J0] - m); SV[J1] = ex2(SV[J1] - m); ps += SV[J0] + SV[J1]; }
#define ATT_QK(F, G, SO_) { SO_ = mfma(F[0], qf[2 * (G)], SO_); SO_ = mfma(F[1], qf[2 * (G) + 1], SO_); }
#define ATT_PV(F, P_, PI_) { o[2 * ((P_) & 1)] = mfma(F[0], PI_[(P_) >> 1], o[2 * ((P_) & 1)]); o[2 * ((P_) & 1) + 1] = mfma(F[1], PI_[(P_) >> 1], o[2 * ((P_) & 1) + 1]); }
#define ATT_RDK(F, G, KB) ATT_RD2(F, kaddr, (KB) * 12800 + 64 * (G), (KB) * 12800 + 64 * (G) + 32)
#define ATT_RDV(F, P_, KB) ATT_RD2(F, vaddr, 2 * ((P_) & 1) * 4608 + (KB) * 64 + ((P_) >> 1) * 32, (2 * ((P_) & 1) + 1) * 4608 + (KB) * 64 + ((P_) >> 1) * 32)
#define ATT_STEP(J, KB, SI, SO, PI, PO)                                                                           \
  {                                                                                                               \
    const int jj = (J), T = jj >> 1;                                                                              \
    if ((KB) == 0) {                                                                                              \
      if (T + 1 < nkt) { ATT_LOAD_K(T + 1); }                                                                     \
      if (T < nkt) { ATT_LOAD_V(T); }                                                                             \
    }                                                                                                             \
    const unsigned kaddr = kaddr0 + (T & 1) * 25600, vaddr = vaddr0 + ((T + 1) & 1) * 18432;                      \
    const bool valid = jj >= 1 && jj <= 2 * nkt;                                                                  \
    float tmax = SI[0];                                                                                           \
    _Pragma("unroll") for (int q = 1; q < 16; ++q) tmax = fmaxf(tmax, SI[q]);                                     \
    tmax = fmaxf(tmax, xhalf(tmax));                                                                              \
    const bool need = valid && (tmax > m + 8.f);                                                                  \
    const float mn = need ? tmax : m;                                                                             \
    const float alpha = ex2(m - mn);                                                                              \
    m = mn;                                                                                                       \
    float ps = 0.f;                                                                                               \
    SO = zero16();                                                                                                \
    bf16x8 fa[2], fb[2], fc[2];                                                                                   \
    ATT_RDK(fa, 0, KB); ATT_RDK(fb, 1, KB);                                                                       \
    ATT_RDK(fc, 2, KB); ATT_WAIT2(fa, 4); ATT_QK(fa, 0, SO); ATT_EXP2(SI, 0, 1);                                      \
    ATT_RDK(fa, 3, KB); ATT_WAIT2(fb, 4); ATT_QK(fb, 1, SO); ATT_EXP2(SI, 2, 3);                                      \
    ATT_RDK(fb, 4, KB); ATT_WAIT2(fc, 4); ATT_QK(fc, 2, SO); ATT_EXP2(SI, 4, 5);                                      \
    ATT_RDK(fc, 5, KB); ATT_WAIT2(fa, 4); ATT_QK(fa, 3, SO); ATT_EXP2(SI, 6, 7);                                      \
    ATT_RDV(fa, 0, KB); ATT_WAIT2(fb, 4); ATT_QK(fb, 4, SO); ATT_EXP2(SI, 8, 9);                                      \
    ATT_RDV(fb, 1, KB); ATT_WAIT2(fc, 4); ATT_QK(fc, 5, SO); ATT_EXP2(SI, 10, 11);                                    \
    ATT_RDV(fc, 2, KB); ATT_WAIT2(fa, 4); ATT_PV(fa, 0, PI); ATT_EXP2(SI, 12, 13);                                    \
    ATT_RDV(fa, 3, KB); ATT_WAIT2(fb, 4); ATT_PV(fb, 1, PI); ATT_EXP2(SI, 14, 15);                                    \
    ATT_WAIT2(fc, 2); ATT_PV(fc, 2, PI);                                                                              \
    if (valid) {                                                                                                  \
      PO[0] = pack8(SI[0], SI[1], SI[2], SI[3], SI[4], SI[5], SI[6], SI[7]);                                      \
      PO[1] = pack8(SI[8], SI[9], SI[10], SI[11], SI[12], SI[13], SI[14], SI[15]);                                \
      lsum = lsum * alpha + ps;                                                                                   \
    }                                                                                                             \
    ATT_WAIT2(fa, 0); ATT_PV(fa, 3, PI);                                                                              \
    if (__builtin_amdgcn_ballot_w64(need) != 0ull) {                                                              \
      _Pragma("unroll") for (int dt = 0; dt < 4; ++dt)                                                            \
        _Pragma("unroll") for (int q = 0; q < 16; ++q) o[dt][q] *= alpha;                                         \
    }                                                                                                             \
    if ((KB) == 1) {                                                                                              \
      asm volatile("s_waitcnt vmcnt(0)" ::: "memory");                                                            \
      __syncthreads();                                                                                            \
    }                                                                                                             \
  }
#pragma unroll 1
  for (int j = 0; j <= 2 * nkt; j += 2) {
    ATT_STEP(j, 0, sX, sY, pX, pY);
    ATT_STEP(j + 1, 1, sY, sX, pY, pX);
  }
#undef ATT_STEP
#undef ATT_EXP2
#undef ATT_QK
#undef ATT_PV
#undef ATT_RDK
#undef ATT_RDV
#undef ATT_LOAD_K
#undef ATT_LOAD_V
#undef ATT_RD1
#undef ATT_RD4
#undef ATT_RD2
#undef ATT_WAIT2
#undef ATT_WAIT4
  lsum += xhalf(lsum);
  const float inv = 1.f / lsum;
  bf16_t* od = p.U + ((size_t)b * TP + q0 + 32 * w + l32) * DM + hd * 128 + 4 * hh;
#pragma unroll
  for (int dt = 0; dt < 4; ++dt)
#pragma unroll
    for (int g = 0; g < 4; ++g) {
      uint2 u;
      u.x = pack2(o[dt][4 * g] * inv, o[dt][4 * g + 1] * inv);
      u.y = pack2(o[dt][4 * g + 2] * inv, o[dt][4 * g + 3] * inv);
      *(uint2*)(od + 32 * dt + 8 * g) = u;
    }
}

DI float masked_sum128(const float* v, int lo, int hi, float& total) {
  float acc = 0.f, tot = 0.f;
#pragma unroll 8
  for (int u4 = 0; u4 < 32; ++u4) {
    const float4 x = *(const float4*)(v + 4 * u4);
    const int u = 4 * u4;
    tot += (x.x + x.y) + (x.z + x.w);
    acc += ((u >= lo && u <= hi) ? x.x : 0.f) + ((u + 1 >= lo && u + 1 <= hi) ? x.y : 0.f)
         + ((u + 2 >= lo && u + 2 <= hi) ? x.z : 0.f) + ((u + 3 >= lo && u + 3 <= hi) ? x.w : 0.f);
  }
  total = tot;
  return acc;
}
DI float masked_max128(const float* v, int lo, int hi) {
  float acc = -1e30f;
#pragma unroll 8
  for (int u4 = 0; u4 < 32; ++u4) {
    const float4 x = *(const float4*)(v + 4 * u4);
    const int u = 4 * u4;
    acc = fmaxf(acc, fmaxf(fmaxf((u >= lo && u <= hi) ? x.x : -1e30f, (u + 1 >= lo && u + 1 <= hi) ? x.y : -1e30f),
                           fmaxf((u + 2 >= lo && u + 2 <= hi) ? x.z : -1e30f, (u + 3 >= lo && u + 3 <= hi) ? x.w : -1e30f)));
  }
  return acc;
}
DI float log_sigmoid_(float x) { return fminf(x, 0.f) - log1pf(fexp(-fabsf(x))); }

DI void mlstm_local_item(CPARAMS p, int bh, int ck, unsigned char* smem) {
  const int tid = tidx_(), lane = tid & 63, w = tid >> 6, l32 = lane & 31, hh = lane >> 5;
  const int b = bh >> 2, hd = bh & 3;
  bf16_t* sKt = (bf16_t*)smem;
  bf16_t* sVf = sKt + 64 * 136;
  bf16_t* sVb = sVf + 64 * 136;
  float* slf = (float*)(sVb + 64 * 136);
  float* sg = slf + 256;
  float* sw = sg + 256;
  float* snp = sw + 256;
  const int row0 = b * TP + ck * 128;
  const int dir = tid >> 7, tok = tid & 127;
  __syncthreads();
  const float* zg = p.ZGt + (size_t)(row0 + tok) * 16;
  const float ipre = zg[dir * 8 + hd];
  slf[dir * 128 + tok] = log_sigmoid_(zg[dir * 8 + 4 + hd]);
  __syncthreads();
  const int plo = dir == 0 ? 0 : tok, phi = dir == 0 ? tok : 127;
  float tot;
  const float bc = masked_sum128(slf + dir * 128, plo, phi, tot);
  const float g = tot - bc + ipre;
  sg[dir * 128 + tok] = g;
  __syncthreads();
  const float mloc = masked_max128(sg + dir * 128, 0, 127);
  sw[dir * 128 + tok] = fexp(g - mloc);
  __syncthreads();
#pragma unroll
  for (int i = 0; i < 4; ++i) {
    const int c = tid + 256 * i, tk = c >> 3, f8 = (c & 7) * 8;
    const bf16_t* zr = p.Z + (size_t)(row0 + tk) * ZW + 64 * hd + f8;
    const uint4 ku = *(const uint4*)(zr + ZMK);
    const uint4 vu = *(const uint4*)(zr + ZMV);
    const unsigned kk[4] = {ku.x, ku.y, ku.z, ku.w}, vv[4] = {vu.x, vu.y, vu.z, vu.w};
    const float wf = sw[tk], wb = sw[128 + tk];
#pragma unroll
    for (int e = 0; e < 4; ++e) {
      sKt[(f8 + 2 * e) * 136 + tk] = (bf16_t)(kk[e] & 0xffffu);
      sKt[(f8 + 2 * e + 1) * 136 + tk] = (bf16_t)(kk[e] >> 16);
      const float v0 = bflo(vv[e]), v1 = bfhi(vv[e]);
      sVf[(f8 + 2 * e) * 136 + tk] = f2bf(v0 * wf);
      sVf[(f8 + 2 * e + 1) * 136 + tk] = f2bf(v1 * wf);
      sVb[(f8 + 2 * e) * 136 + tk] = f2bf(v0 * wb);
      sVb[(f8 + 2 * e + 1) * 136 + tk] = f2bf(v1 * wb);
    }
  }
  __syncthreads();
  const int mi = w >> 1, ni = w & 1;
#pragma unroll
  for (int d = 0; d < 2; ++d) {
    const bf16_t* sV = d ? sVb : sVf;
    f32x16 acc = zero16();
#pragma unroll
    for (int ks = 0; ks < 8; ++ks)
      acc = mfma(ldfrag(sV + (32 * mi + l32) * 136 + 16 * ks + 8 * hh), ldfrag(sKt + (32 * ni + l32) * 136 + 16 * ks + 8 * hh), acc);
    float* rec = p.CST + ((size_t)(bh * 34 + ck) * 2 + d) * CREC;
#pragma unroll
    for (int i = 0; i < 16; ++i) rec[(32 * mi + crow(i, hh)) * 64 + 32 * ni + l32] = acc[i];
  }
  {
    const int dk = tid & 63, part = tid >> 6;
    float nf = 0.f, nb = 0.f;
    for (int s = part * 32; s < part * 32 + 32; ++s) {
      const float kv = bf2f(sKt[dk * 136 + s]);
      nf += sw[s] * kv; nb += sw[128 + s] * kv;
    }
    snp[(part * 2 + 0) * 64 + dk] = nf;
    snp[(part * 2 + 1) * 64 + dk] = nb;
  }
  __syncthreads();
  if (tid < 128) {
    const int d = tid >> 6, dk = tid & 63;
    float* rec = p.CST + ((size_t)(bh * 34 + ck) * 2 + d) * CREC;
    rec[4096 + dk] = snp[(0 * 2 + d) * 64 + dk] + snp[(1 * 2 + d) * 64 + dk] + snp[(2 * 2 + d) * 64 + dk] + snp[(3 * 2 + d) * 64 + dk];
  }
  if (tok == 0) {
    float* rec = p.CST + ((size_t)(bh * 34 + ck) * 2 + dir) * CREC;
    rec[4160] = mloc;
    rec[4161] = tot;
  }
}

DI void phase_mlstm_scan(CPARAMS p) {
  const int total = 32 * 4096;
  for (int idx = bidx_() * 256 + tidx_(); idx < total; idx += VGRID * 256) {
    const int combo = idx >> 12, e = idx & 4095;
    const int bh = combo >> 1, d = combo & 1;
    const bool has2 = e < 64;
    const int e2 = has2 ? 4096 + e : e;
    float* base = p.CST + ((size_t)(bh * 34) * 2 + d) * CREC;
    float loc[34], loc2[34], mloc[34], tot[34];
#pragma unroll
    for (int ck = 0; ck < 34; ++ck) {
      const float* rec = base + (size_t)ck * 2 * CREC;
      loc[ck] = rec[e]; loc2[ck] = rec[e2]; mloc[ck] = rec[4160]; tot[ck] = rec[4161];
    }
    float st = 0.f, st2 = 0.f, m = 0.f;
#pragma unroll
    for (int step = 0; step < 34; ++step) {
      const int ck = d == 0 ? step : (step < 2 ? 1 - step : 35 - step);
      float* rec = base + (size_t)ck * 2 * CREC;
      rec[e] = st;
      if (has2) rec[e2] = st2;
      if (e == 0) rec[4162] = m;
      const float mn = fmaxf(tot[ck] + m, mloc[ck]);
      const float wo = fexp(tot[ck] + m - mn), wl = fexp(mloc[ck] - mn);
      st = wo * st + wl * loc[ck];
      st2 = wo * st2 + wl * loc2[ck];
      m = mn;
    }
  }
}

DI void mlstm_out_item(CPARAMS p, int bh, int ck, unsigned char* smem) {
  const int tid = tidx_(), lane = tid & 63, w = tid >> 6, l32 = lane & 31, hh = lane >> 5;
  const int b = bh >> 2, hd = bh & 3;
  bf16_t* sK = (bf16_t*)smem;
  bf16_t* sVt = sK + 128 * LDT;
  bf16_t* sC = sVt + 64 * 136;
  float* slf = (float*)(sC + 2 * 64 * LDT);
  float* sb = slf + 256;
  float* se = sb + 256;
  float* sM = se + 256;
  float* sn = sM + 256;
  const int row0 = b * TP + ck * 128;
  const float* rec0 = p.CST + ((size_t)(bh * 34 + ck) * 2) * CREC;
  __syncthreads();
  {
    const int dir = tid >> 7, tok = tid & 127;
    const float* zg = p.ZGt + (size_t)(row0 + tok) * 16;
    const float ipre = zg[dir * 8 + hd];
    slf[dir * 128 + tok] = log_sigmoid_(zg[dir * 8 + 4 + hd]);
#pragma unroll
    for (int i = 0; i < 4; ++i) {
      const int c = tid + 256 * i, tk = c >> 3, f8 = (c & 7) * 8;
      const bf16_t* zr = p.Z + (size_t)(row0 + tk) * ZW + 64 * hd + f8;
      *(uint4*)(sK + tk * LDT + f8) = *(const uint4*)(zr + ZMK);
      const uint4 vu = *(const uint4*)(zr + ZMV);
      const unsigned vv[4] = {vu.x, vu.y, vu.z, vu.w};
      const int pk = permk(tk);
#pragma unroll
      for (int e = 0; e < 4; ++e) {
        sVt[(f8 + 2 * e) * 136 + pk] = (bf16_t)(vv[e] & 0xffffu);
        sVt[(f8 + 2 * e + 1) * 136 + pk] = (bf16_t)(vv[e] >> 16);
      }
    }
#pragma unroll
    for (int d = 0; d < 2; ++d) {
      const int dv = tid >> 2, dk0 = (tid & 3) * 16;
      const float* src = rec0 + (size_t)d * CREC + dv * 64 + dk0;
      const float4 f0 = *(const float4*)(src), f1 = *(const float4*)(src + 4), f2 = *(const float4*)(src + 8), f3 = *(const float4*)(src + 12);
      bf16_t* dd = sC + d * 64 * LDT + dv * LDT + dk0;
      *(uint4*)dd = make_uint4(pack2(f0.x, f0.y), pack2(f0.z, f0.w), pack2(f1.x, f1.y), pack2(f1.z, f1.w));
      *(uint4*)(dd + 8) = make_uint4(pack2(f2.x, f2.y), pack2(f2.z, f2.w), pack2(f3.x, f3.y), pack2(f3.z, f3.w));
    }
    if (tid < 128) sn[tid] = rec0[(size_t)(tid >> 6) * CREC + 4096 + (tid & 63)];
    __syncthreads();
    const int plo = dir == 0 ? 0 : tok, phi = dir == 0 ? tok : 127;
    float tot_unused;
    const float bc = masked_sum128(slf + dir * 128, plo, phi, tot_unused);
    sb[dir * 128 + tok] = bc;
    se[dir * 128 + tok] = ipre - bc;
    __syncthreads();
    const float cm = masked_max128(se + dir * 128, plo, phi);
    const float mprev = rec0[(size_t)dir * CREC + 4162];
    sM[dir * 128 + tok] = fmaxf(mprev, cm);
    __syncthreads();
  }
  const int tq = 32 * w + l32;
  bf16x8 qf[4];
  {
    const bf16_t* qg = p.Z + (size_t)(row0 + tq) * ZW + ZMQ + 64 * hd + 8 * hh;
#pragma unroll
    for (int ks = 0; ks < 4; ++ks) qf[ks] = ldfrag(qg + 16 * ks);
  }
  f32x16 hs[2];
  hs[0] = zero16(); hs[1] = zero16();
#pragma unroll
  for (int d = 0; d < 2; ++d) {
    const float mprev = rec0[(size_t)d * CREC + 4162];
    const float Mt = sM[d * 128 + tq], bt = sb[d * 128 + tq];
    const float winter = fexp(mprev - Mt) * 0.125f;
    float qn = 0.f;
#pragma unroll
    for (int ks = 0; ks < 4; ++ks) {
      const uint4 qu = __builtin_bit_cast(uint4, qf[ks]);
      const float* nn = sn + d * 64 + 16 * ks + 8 * hh;
      qn += bflo(qu.x) * nn[0] + bfhi(qu.x) * nn[1] + bflo(qu.y) * nn[2] + bfhi(qu.y) * nn[3]
          + bflo(qu.z) * nn[4] + bfhi(qu.z) * nn[5] + bflo(qu.w) * nn[6] + bfhi(qu.w) * nn[7];
    }
    qn += xhalf(qn);
    f32x16 num[2];
#pragma unroll
    for (int dt = 0; dt < 2; ++dt) {
      f32x16 a = zero16();
#pragma unroll
      for (int ks = 0; ks < 4; ++ks) a = mfma(ldfrag(sC + d * 64 * LDT + (32 * dt + l32) * LDT + 16 * ks + 8 * hh), qf[ks], a);
#pragma unroll
      for (int i = 0; i < 16; ++i) a[i] *= winter;
      num[dt] = a;
    }
    float den = 0.f;
#pragma unroll
    for (int kb = 0; kb < 4; ++kb) {
      const bool active = d == 0 ? (kb <= w) : (kb >= w);
      if (active) {
        f32x16 s = zero16();
#pragma unroll
        for (int ks = 0; ks < 4; ++ks) s = mfma(ldfrag(sK + (32 * kb + l32) * LDT + 16 * ks + 8 * hh), qf[ks], s);
#pragma unroll
        for (int g = 0; g < 4; ++g) {
          const float4 e4 = *(const float4*)(se + d * 128 + 32 * kb + 8 * g + 4 * hh);
          const float ee[4] = {e4.x, e4.y, e4.z, e4.w};
#pragma unroll
          for (int j = 0; j < 4; ++j) {
            const int sidx = 32 * kb + 8 * g + 4 * hh + j;
            const bool ok = d == 0 ? (sidx <= tq) : (sidx >= tq);
            const float arg = ok ? (ee[j] - Mt) : -1e30f;
            const float pv = s[4 * g + j] * (0.125f * fexp(arg));
            s[4 * g + j] = pv;
            den += pv;
          }
        }
#pragma unroll
        for (int s2 = 0; s2 < 2; ++s2) {
          const bf16x8 pb = pack8(s[8 * s2], s[8 * s2 + 1], s[8 * s2 + 2], s[8 * s2 + 3], s[8 * s2 + 4], s[8 * s2 + 5], s[8 * s2 + 6], s[8 * s2 + 7]);
#pragma unroll
          for (int dt = 0; dt < 2; ++dt) num[dt] = mfma(ldfrag(sVt + (32 * dt + l32) * 136 + 32 * kb + 16 * s2 + 8 * hh), pb, num[dt]);
        }
      }
    }
    den += xhalf(den);
    den += winter * qn;
    const float dn = fmaxf(fabsf(den), fexp(-(bt + Mt)));
    const float inv = 1.f / dn;
#pragma unroll
    for (int dt = 0; dt < 2; ++dt)
#pragma unroll
      for (int i = 0; i < 16; ++i) hs[dt][i] += num[dt][i] * inv;
  }
  float ss = 0.f;
#pragma unroll
  for (int dt = 0; dt < 2; ++dt)
#pragma unroll
    for (int i = 0; i < 16; ++i) ss += hs[dt][i] * hs[dt][i];
  ss += xhalf(ss);
  const float rs = rsqrtf(ss * (1.f / 64.f) + EPSF);
  const bf16_t* og = p.Z + (size_t)(row0 + tq) * ZW + ZMO + 64 * hd + 4 * hh;
  bf16_t* od = p.U + (size_t)(row0 + tq) * DM + 512 + 64 * hd + 4 * hh;
#pragma unroll
  for (int dt = 0; dt < 2; ++dt)
#pragma unroll
    for (int g = 0; g < 4; ++g) {
      const uint2 ou = *(const uint2*)(og + 32 * dt + 8 * g);
      uint2 r;
      r.x = pack2(sigmoidf_(bflo(ou.x)) * hs[dt][4 * g] * rs, sigmoidf_(bfhi(ou.x)) * hs[dt][4 * g + 1] * rs);
      r.y = pack2(sigmoidf_(bflo(ou.y)) * hs[dt][4 * g + 2] * rs, sigmoidf_(bfhi(ou.y)) * hs[dt][4 * g + 3] * rs);
      *(uint2*)(od + 32 * dt + 8 * g) = r;
    }
}

DI void lru_local_item(CPARAMS p, int l, int mt, int gd0, unsigned char* smem) {
  const int tid = tidx_(), lane = tid & 63, w = tid >> 6, l32 = lane & 31, hh = lane >> 5;
  bf16_t* sX = (bf16_t*)smem;
  bf16_t* sW = sX + 128 * LDT;
  float* sAa = (float*)smem;
  float* sUu = sAa + 128 * 64;
  const int row0 = mt * 128;
  const int b = row0 / TP, pos0 = row0 - b * TP;
  const int seg_lo = pos0 < TC ? 0 : TC, seg_hi = pos0 < TC ? TC : TP;
  {
    const int gd = gd0;
    const int g = gd >> 1, d = gd & 1;
    __syncthreads();
    {
      const int c8 = (tid & 7) * 8, ch0 = 64 * g + c8;
      float cw[4][8], cb[8];
#pragma unroll
      for (int e = 0; e < 8; ++e) {
        cb[e] = p.conv_b[l * 256 + ch0 + e];
#pragma unroll
        for (int j = 0; j < 4; ++j) cw[j][e] = p.conv_w[(l * 4 + j) * 256 + ch0 + e];
      }
#pragma unroll
      for (int i = 0; i < 4; ++i) {
        const int tk = (tid >> 3) + 32 * i;
        float a[8];
#pragma unroll
        for (int e = 0; e < 8; ++e) a[e] = cb[e];
#pragma unroll
        for (int j = 0; j < 4; ++j) {
          const int ps = pos0 + tk + j - 2;
          const bool inr = ps >= seg_lo && ps < seg_hi;
          const int psc = inr ? ps : pos0 + tk;
          u32x4 u = *(const u32x4*)(p.Z + (size_t)(b * TP + psc) * ZW + ZLX + ch0);
          u[0] = inr ? u[0] : 0u; u[1] = inr ? u[1] : 0u; u[2] = inr ? u[2] : 0u; u[3] = inr ? u[3] : 0u;
          a[0] += bflo(u[0]) * cw[j][0]; a[1] += bfhi(u[0]) * cw[j][1]; a[2] += bflo(u[1]) * cw[j][2]; a[3] += bfhi(u[1]) * cw[j][3];
          a[4] += bflo(u[2]) * cw[j][4]; a[5] += bfhi(u[2]) * cw[j][5]; a[6] += bflo(u[3]) * cw[j][6]; a[7] += bfhi(u[3]) * cw[j][7];
        }
        u32x4 o;
        o[0] = pack2(a[0], a[1]); o[1] = pack2(a[2], a[3]); o[2] = pack2(a[4], a[5]); o[3] = pack2(a[6], a[7]);
        *(u32x4*)(sX + tk * LDT + c8) = o;
        {
          float* xg = p.XS + (size_t)(row0 + tk) * 256 + ch0;
          *(float4*)xg = make_float4(a[0], a[1], a[2], a[3]);
          *(float4*)(xg + 4) = make_float4(a[4], a[5], a[6], a[7]);
        }
      }
#pragma unroll
      for (int i = 0; i < 4; ++i) {
        const int c = tid + 256 * i, r = c >> 3, k8 = (c & 7) * 8;
        *(u32x4*)(sW + r * LDT + k8) = *(const u32x4*)(p.Wb_lru + (size_t)(g * 256 + d * 128 + r) * 64 + k8);
      }
    }
    __syncthreads();
    f32x16 acc[4];
#pragma unroll
    for (int nt = 0; nt < 4; ++nt) acc[nt] = zero16();
#pragma unroll
    for (int ks = 0; ks < 4; ++ks) {
      const bf16x8 a = ldfrag(sX + (32 * w + l32) * LDT + 16 * ks + 8 * hh);
#pragma unroll
      for (int nt = 0; nt < 4; ++nt) acc[nt] = mfma(a, ldfrag(sW + (32 * nt + l32) * LDT + 16 * ks + 8 * hh), acc[nt]);
    }
    __syncthreads();
#pragma unroll
    for (int pt = 0; pt < 2; ++pt) {
      const int chl = 32 * pt + l32, ch = 64 * g + chl;
      const float ba = p.b_a[(l * 2 + d) * 256 + ch], bx = p.b_x[(l * 2 + d) * 256 + ch];
      const float lm = p.lam[(l * 2 + d) * 256 + ch];
      const float spl = fmaxf(-lm, 0.f) + log1pf(fexp(-fabsf(lm)));
#pragma unroll
      for (int i = 0; i < 16; ++i) {
        const int tk = 32 * w + crow(i, hh);
        const float r = sigmoidf_(acc[pt][i] + ba), ig = sigmoidf_(acc[2 + pt][i] + bx);
        const float la = -8.f * r * spl;
        const float a = fexp(la);
        const float u = sqrtf(-expm1f(2.f * la)) * ig * p.XS[(size_t)(row0 + tk) * 256 + ch];
        sAa[tk * 64 + chl] = a;
        sUu[tk * 64 + chl] = u;
      }
    }
    __syncthreads();
    const int chl = tid & 63, sg = tid >> 6;
    {
      float P = 1.f, hv = 0.f;
      float av[32], uv[32];
#pragma unroll
      for (int s = 0; s < 32; ++s) {
        const int tk = d == 0 ? 32 * sg + s : 32 * sg + 31 - s;
        av[s] = sAa[tk * 64 + chl]; uv[s] = sUu[tk * 64 + chl];
      }
#pragma unroll
      for (int s = 0; s < 32; ++s) {
        hv = av[s] * hv + uv[s]; P *= av[s];
        av[s] = P; uv[s] = hv;
      }
#pragma unroll
      for (int s = 0; s < 32; ++s) {
        const int tk = d == 0 ? 32 * sg + s : 32 * sg + 31 - s;
        sAa[tk * 64 + chl] = av[s]; sUu[tk * 64 + chl] = uv[s];
      }
    }
    __syncthreads();
    {
      float cP = 1.f, cH = 0.f;
#pragma unroll
      for (int q = 0; q < 4; ++q) {
        const int sq = d == 0 ? q : 3 - q;
        const bool before = d == 0 ? (sq < sg) : (sq > sg);
        const int tl = d == 0 ? 32 * sq + 31 : 32 * sq;
        const float Pr = sAa[tl * 64 + chl], Hr = sUu[tl * 64 + chl];
        const float Pq = before ? Pr : 1.f, Hq = before ? Hr : 0.f;
        cH = Pq * cH + Hq; cP *= Pq;
      }
      bf16_t* auH = p.AU + ((size_t)(d * 2 + 0) * NTOK + row0) * 256 + 64 * g + chl;
      bf16_t* auP = p.AU + ((size_t)(d * 2 + 1) * NTOK + row0) * 256 + 64 * g + chl;
      float Pl = 1.f, Hl = 0.f;
#pragma unroll
      for (int s = 0; s < 32; ++s) {
        const int tk = d == 0 ? 32 * sg + s : 32 * sg + 31 - s;
        const float pa = sAa[tk * 64 + chl], hu = sUu[tk * 64 + chl];
        Pl = pa * cP;
        Hl = hu + pa * cH;
        auH[(size_t)tk * 256] = f2bf(Hl);
        auP[(size_t)tk * 256] = f2bf(Pl);
      }
      const bool lastseg = d == 0 ? (sg == 3) : (sg == 0);
      if (lastseg) {
        float* ag = p.AGG + ((size_t)(mt * 2 + d) * 2) * 256 + 64 * g + chl;
        ag[0] = Pl; ag[256] = Hl;
      }
    }
  }
}

DI float gelu_tanh_(float x) {
  const float y = 0.7978845608028654f * (x + 0.044715f * x * x * x);
  const float t = 1.f - 2.f / (fexp(2.f * y) + 1.f);
  return 0.5f * x * (1.f + t);
}

DI void lru_out_item(CPARAMS p, int mt, unsigned char* smem) {
  const int tid = tidx_();
  float* scf = (float*)smem;
  float* scb = scf + 256;
  const int row0 = mt * 128;
  const int b = row0 / TP;
  const int tl = mt - b * 34;
  __syncthreads();
  {
    const int ch = tid;
    float cf = 0.f, cb = 0.f;
    {
      float av[34], hv[34];
#pragma unroll
      for (int j = 0; j < 34; ++j) {
        const float* ag = p.AGG + ((size_t)((b * 34 + j) * 2 + 0) * 2) * 256 + ch;
        av[j] = ag[0]; hv[j] = ag[256];
      }
#pragma unroll
      for (int j = 0; j < 34; ++j) asm volatile("" : "+v"(av[j]), "+v"(hv[j]));
#pragma unroll
      for (int j = 0; j < 34; ++j) {
        const float ae = j < tl ? av[j] : 1.f, he = j < tl ? hv[j] : 0.f;
        cf = ae * cf + he;
      }
    }
    {
      float av[34], hv[34];
#pragma unroll
      for (int j = 0; j < 34; ++j) {
        const float* ag = p.AGG + ((size_t)((b * 34 + j) * 2 + 1) * 2) * 256 + ch;
        av[j] = ag[0]; hv[j] = ag[256];
      }
#pragma unroll
      for (int j = 0; j < 34; ++j) asm volatile("" : "+v"(av[j]), "+v"(hv[j]));
#pragma unroll
      for (int step = 0; step < 34; ++step) {
        const int j = step < 2 ? 1 - step : 35 - step;
        const bool before = tl < 2 ? (j < 2 && j > tl) : (j < 2 || j > tl);
        const float ae = before ? av[j] : 1.f, he = before ? hv[j] : 0.f;
        cb = ae * cb + he;
      }
    }
    scf[ch] = cf; scb[ch] = cb;
  }
  __syncthreads();
  const int c8 = (tid & 31) * 8;
  float cf[8], cb[8];
#pragma unroll
  for (int e = 0; e < 8; ++e) { cf[e] = scf[c8 + e]; cb[e] = scb[c8 + e]; }
#pragma unroll 4
  for (int i = 0; i < 16; ++i) {
    const int t = (tid >> 5) + 8 * i;
    const size_t ro = (size_t)(row0 + t) * 256 + c8;
    const u32x4 hf = *(const u32x4*)(p.AU + (size_t)0 * NTOK * 256 + ro);
    const u32x4 pf = *(const u32x4*)(p.AU + (size_t)1 * NTOK * 256 + ro);
    const u32x4 hb = *(const u32x4*)(p.AU + (size_t)2 * NTOK * 256 + ro);
    const u32x4 pb = *(const u32x4*)(p.AU + (size_t)3 * NTOK * 256 + ro);
    const u32x4 gz = *(const u32x4*)(p.Z + (size_t)(row0 + t) * ZW + ZLG + c8);
    u32x4 o;
#pragma unroll
    for (int q = 0; q < 4; ++q) {
      const float h0 = bflo(hf[q]) + bflo(pf[q]) * cf[2 * q] + bflo(hb[q]) + bflo(pb[q]) * cb[2 * q];
      const float h1 = bfhi(hf[q]) + bfhi(pf[q]) * cf[2 * q + 1] + bfhi(hb[q]) + bfhi(pb[q]) * cb[2 * q + 1];
      o[q] = pack2(gelu_tanh_(bflo(gz[q])) * h0, gelu_tanh_(bfhi(gz[q])) * h1);
    }
    *(u32x4*)(p.U + (size_t)(row0 + t) * DM + 768 + c8) = o;
  }
}

DI int next_item(unsigned* ctr, unsigned char* smem_full) {
  int* slot = (int*)(smem_full + 163808);
  __syncthreads();
  if (tfull_() == 0) *slot = (int)atomicAdd(ctr, 2u);
  __syncthreads();
  return *slot + hidx_();
}
DI void phase_prep(CPARAMS p, int l, unsigned char* smem, unsigned char* smem_full) {
  unsigned* ctr = p.CTR + 2 * l;
  for (;;) {
    int it = next_item(ctr, smem_full);
    if (it >= 1088 + 544 + 816 + 1088 + 136) break;
    if (it < 1088) { lru_local_item(p, l, it >> 3, it & 7, smem); continue; }
    it -= 1088;
    if (it < 544) { mlstm_local_item(p, it / 34, it % 34, smem); continue; }
    it -= 544;
    if (it < 816) { mla_q_item(p, it / 6, it % 6, smem); continue; }
    it -= 816;
    if (it < 1088) { mla_kv_item(p, it >> 3, it & 7, smem); continue; }
    it -= 1088;
    mla_krope_item(p, it, smem);
  }
}
DI void phase_mix(CPARAMS p, int l, unsigned char* smem, unsigned char* smem_full) {
  for (int a = bidx_(); a < 512; a += VGRID) {
    const int rb = a >> 1, x = rb & 7, j = ((rb >> 3) << 1) | (a & 1);
    const int bh = 2 * x + (j >> 5), qt = j & 31;
    attn_item(p, bh >> 2, bh & 3, TC + 128 * qt, 68, smem_full);
  }
  unsigned* ctr = p.CTR + 2 * l + 1;
  for (;;) {
    const int it = next_item(ctr, smem_full);
    if (it >= 32 + 544 + 136) break;
    if (it < 32) { const int bh = it >> 1, qt = it & 1; attn_item(p, bh >> 2, bh & 3, 128 * qt, 4, smem_full); }
    else if (it < 576) { const int j = it - 32; mlstm_out_item(p, j / 34, j % 34, smem); }
    else lru_out_item(p, it - 576, smem);
  }
}
DI void phase_final(CPARAMS p) {
  const int lane = tidx_() & 63, w = tidx_() >> 6;
  for (int it = bidx_(); it < NB * TL / 4; it += VGRID) {
    const int r = it * 4 + w;
    const int b = r >> 12, t = r & 4095;
    const float* src = p.X + ((size_t)b * TP + TC + t) * DM;
    float4 v[4];
    float ss = 0.f;
#pragma unroll
    for (int i = 0; i < 4; ++i) {
      v[i] = *(const float4*)(src + lane * 4 + 256 * i);
      ss += v[i].x * v[i].x + v[i].y * v[i].y + v[i].z * v[i].z + v[i].w * v[i].w;
    }
#pragma unroll
    for (int o = 32; o > 0; o >>= 1) ss += __shfl_xor(ss, o, 64);
    const float rs = rsqrtf(ss * (1.f / DM) + EPSF);
#pragma unroll
    for (int i = 0; i < 4; ++i) {
      const int cidx = lane * 4 + 256 * i;
      const float4 g = *(const float4*)(p.final_g + cidx);
      float4 o4;
      o4.x = v[i].x * rs * g.x; o4.y = v[i].y * rs * g.y; o4.z = v[i].z * rs * g.z; o4.w = v[i].w * rs * g.w;
      *(float4*)(p.out + (size_t)r * DM + cidx) = o4;
    }
  }
}

__global__ void __launch_bounds__(512, 2) mega_kernel(Params p_unused) {
  __shared__ __attribute__((aligned(16))) unsigned char smem[163840];
  cg::grid_group grid = cg::this_grid();
  unsigned char* hs = smem + hidx_() * 81920;
  if (threadIdx.x < 4) ((unsigned*)(smem + 163824))[threadIdx.x] = 0u;
  __syncthreads();
  phase_mod(*kparams(), hs);
  grid.sync();
  XcdBarrier xb = xcd_barrier_post(kparams()->BAR, (volatile LAS unsigned*)(smem + 163824));
#pragma unroll 1
  for (int l = 0; l < NLAYER; ++l) {
    phase_norm1(*kparams(), l, hs);
    xcd_barrier(xb);
    phase_gemm_in(*kparams(), l, smem, hs);
    xcd_barrier(xb);
    phase_prep(*kparams(), l, hs, smem);
    xcd_barrier(xb);
    phase_mlstm_scan(*kparams());
    xcd_barrier(xb);
    phase_mix(*kparams(), l, hs, smem);
    xcd_barrier(xb);
    phase_gemm_resid(*kparams(), l, kparams()->U, DM, kparams()->Wb_out, 2, l == NLAYER - 1, smem);
    xcd_barrier(xb);
    phase_norm2(*kparams(), l);
    xcd_barrier(xb);
    phase_gemm_ff1(*kparams(), l == NLAYER - 1, smem);
    xcd_barrier(xb);
    phase_gemm_resid(*kparams(), l, kparams()->H, DFF, kparams()->Wb_ff2, 5, l == NLAYER - 1, smem);
    xcd_barrier(xb);
  }
  phase_final(*kparams());
}

extern "C" void kernel_launch(void* const* d_in, const int* in_sizes, int n_in, void* d_out, int out_size, void* d_ws, size_t ws_size,
                              hipStream_t stream) {
  static int grid_blocks = 0;
  if (!grid_blocks) {
    int dev = 0, cus = 0, per_cu = 0;
    hipGetDevice(&dev);
    hipDeviceGetAttribute(&cus, hipDeviceAttributeMultiprocessorCount, dev);
    hipOccupancyMaxActiveBlocksPerMultiprocessor(&per_cu, mega_kernel, 512, 0);
    if (per_cu > 1) per_cu = 1;
    if (per_cu < 1) per_cu = 1;
    grid_blocks = cus * per_cu;
  }
  Params p{};
  const float* const* in = (const float* const*)d_in;
  p.x = in[0]; p.c = in[1]; p.ctx = in[2]; p.c_ctx = in[3]; p.w_mod = in[4]; p.b_mod = in[5]; p.w_in = in[6];
  p.g_q = in[7]; p.w_uq = in[8]; p.g_kv = in[9]; p.w_ukv = in[10]; p.gate_bias = in[11];
  p.conv_w = in[12]; p.conv_b = in[13]; p.w_a = in[14]; p.b_a = in[15]; p.w_x = in[16]; p.b_x = in[17]; p.lam = in[18];
  p.w_out = in[19]; p.w_ff1 = in[20]; p.w_ff2 = in[21]; p.final_g = in[22];
  p.out = (float*)d_out;
  unsigned char* ws = (unsigned char*)d_ws;
  size_t off = 0;
  auto take = [&](size_t bytes) { unsigned char* r = ws + off; off += (bytes + 255) & ~(size_t)255; return r; };
  p.Wb_in = (bf16_t*)take((size_t)2048 * 1024 * 2);
  p.Wb_uq = (bf16_t*)take((size_t)768 * 256 * 2);
  p.Wb_ukv = (bf16_t*)take((size_t)1024 * 128 * 2);
  p.Wb_out = (bf16_t*)take((size_t)1024 * 1024 * 2);
  p.Wb_ff1 = (bf16_t*)take((size_t)4096 * 1024 * 2);
  p.Wb_ff2 = (bf16_t*)take((size_t)4096 * 1024 * 2);
  p.Wb_lru = (bf16_t*)take((size_t)4 * 256 * 64 * 2);
  p.MOD = (float*)take((size_t)4 * 5 * 6144 * 4);
  p.X = (float*)take((size_t)NTOK * DM * 4);
  p.U = (bf16_t*)take((size_t)NTOK * DM * 2);
  p.H = (bf16_t*)take((size_t)NTOK * DFF * 2);
  p.Z = p.H;
  p.Qb = p.Z + (size_t)NTOK * ZW;
  p.Kb = p.Qb + (size_t)16 * TP * 192;
  p.Vt = p.Kb + (size_t)16 * TP * 192;
  p.ZGt = (float*)take((size_t)NTOK * 16 * 4);
  p.AU = (bf16_t*)take((size_t)4 * NTOK * 256 * 2);
  p.AGG = (float*)take((size_t)136 * 2 * 2 * 256 * 4);
  p.CST = (float*)take((size_t)16 * 34 * 2 * CREC * 4);
  p.XS = (float*)take((size_t)NTOK * 256 * 4);
  p.CTR = (unsigned*)take(256);
  p.BAR = (unsigned*)take((size_t)XCD_BAR_WORDS * 4);
  if (off > ws_size) fprintf(stderr, "workspace too small: need %zu have %zu\n", off, ws_size);
  void* args[] = {&p};
  hipError_t e = hipLaunchCooperativeKernel((void*)mega_kernel, dim3(grid_blocks), dim3(512), args, 0, stream);
  if (e != hipSuccess) fprintf(stderr, "cooperative launch failed: %s (grid %d)\n", hipGetErrorString(e), grid_blocks);
}
```

```cpp
#include <hip/hip_runtime.h>
#include <hip/hip_cooperative_groups.h>
#include <cstdio>
namespace cg = cooperative_groups;

#define DI __device__ __forceinline__
typedef unsigned short bf16_t;
typedef __attribute__((ext_vector_type(8))) short bf16x8;
typedef __attribute__((ext_vector_type(16))) float f32x16;
typedef __attribute__((ext_vector_type(4))) unsigned u32x4;
typedef __bf16 bf16v2_t __attribute__((ext_vector_type(2)));
typedef float f32v2_t __attribute__((ext_vector_type(2)));

#define NB 4
#define TL 4096
#define TC 256
#define TP 4352
#define NTOK 17408
#define DM 1024
#define DFF 4096
#define ZW 2048
#define NLAYER 4
#define EPSF 1e-6f
#define ZQ 0
#define ZKV 256
#define ZKR 384
#define ZG 448
#define ZMQ 512
#define ZMK 768
#define ZMV 1024
#define ZMO 1280
#define ZLX 1536
#define ZLG 1792
#define LDT 72
#define CREC 4224
#define QSCALE (0.07216878364870322f * 1.4426950408889634f)

struct Params {
  const float *x, *c, *ctx, *c_ctx, *w_mod, *b_mod, *w_in, *g_q, *w_uq, *g_kv, *w_ukv, *gate_bias;
  const float *conv_w, *conv_b, *w_a, *b_a, *w_x, *b_x, *lam, *w_out, *w_ff1, *w_ff2, *final_g;
  float* out;
  bf16_t *Wb_in, *Wb_uq, *Wb_ukv, *Wb_out, *Wb_ff1, *Wb_ff2, *Wb_lru;
  float* MOD;
  float* X;
  bf16_t* U;
  bf16_t* Z;
  bf16_t* Qb;
  bf16_t* Kb;
  bf16_t* Vt;
  bf16_t* H;
  float* ZGt;
  bf16_t* AU;
  float* AGG;
  float* CST;
  float* XS;
  unsigned* CTR;
  unsigned* BAR;
};

typedef const __attribute__((address_space(4))) Params CParamsT;
typedef CParamsT& CPARAMS;
__device__ __forceinline__ CParamsT* kparams() {
  CParamsT* q = (CParamsT*)__builtin_amdgcn_kernarg_segment_ptr();
  asm volatile("" : "+s"(q));
  return q;
}

DI int tfull_() { int t = threadIdx.x; asm volatile("" : "+v"(t)); return t; }
DI int tidx_() { return tfull_() & 255; }
DI int hidx_() { return tfull_() >> 8; }
DI int rbidx_() { int t = blockIdx.x; asm volatile("" : "+s"(t)); return t; }
DI int bidx_() { return rbidx_() * 2 + hidx_(); }
#define VGRID ((int)gridDim.x * 2)
DI unsigned pack2(float a, float b) {
  f32v2_t v = {a, b};
  bf16v2_t r = __builtin_convertvector(v, bf16v2_t);
  return __builtin_bit_cast(unsigned, r);
}
DI bf16_t f2bf(float a) { return (bf16_t)(pack2(a, 0.f) & 0xffffu); }
DI float bf2f(bf16_t v) { return __uint_as_float(((unsigned)v) << 16); }
DI float bflo(unsigned u) { return __uint_as_float(u << 16); }
DI float bfhi(unsigned u) { return __uint_as_float(u & 0xffff0000u); }
DI f32x16 mfma(bf16x8 a, bf16x8 b, f32x16 c) { return __builtin_amdgcn_mfma_f32_32x32x16_bf16(a, b, c, 0, 0, 0); }
DI f32x16 zero16() { f32x16 z;
#pragma unroll
  for (int i = 0; i < 16; ++i) z[i] = 0.f; return z; }
DI float ex2(float x) { return __builtin_amdgcn_exp2f(x); }
DI float fexp(float x) { return __builtin_amdgcn_exp2f(x * 1.4426950408889634f); }
DI float sigmoidf_(float x) { return 1.f / (1.f + fexp(-x)); }
DI float xhalf(float v) { return __shfl_xor(v, 32, 64); }
DI bf16x8 ldfrag(const bf16_t* p) { return *(const bf16x8*)p; }
DI bf16x8 pack8(float a0, float a1, float a2, float a3, float a4, float a5, float a6, float a7) {
  uint4 u; u.x = pack2(a0, a1); u.y = pack2(a2, a3); u.z = pack2(a4, a5); u.w = pack2(a6, a7);
  return __builtin_bit_cast(bf16x8, u);
}
DI int crow(int i, int hh) { return (i & 3) + 8 * (i >> 2) + 4 * hh; }
DI int permk(int t) { return (t & ~12) | ((t & 4) << 1) | ((t & 8) >> 1); }

#define XB_TMO      128
#define XB_XCNT(j)  (256  + 64 * (j))
#define XB_XSUB(j)  (1280 + 64 * (j))
#define XB_XGEN(j)  (2304 + 64 * (j))
#define XB_TOP      3328
#define XB_TOPGEN   3392
#define XCD_BAR_WORDS 3456
#define XB_SPIN_CAP (1u << 18)
#define LAS __attribute__((address_space(3)))

__device__ __forceinline__ unsigned xb_ld(unsigned* p)              { return __hip_atomic_load(p, __ATOMIC_RELAXED, __HIP_MEMORY_SCOPE_AGENT); }
__device__ __forceinline__ unsigned xb_add(unsigned* p, unsigned v) { return __hip_atomic_fetch_add(p, v, __ATOMIC_RELAXED, __HIP_MEMORY_SCOPE_AGENT); }
__device__ __forceinline__ unsigned xb_xcc_id() { return (unsigned)__builtin_amdgcn_s_getreg((3 << 11) | 20) & 0xFu; }
#define XB_SPIN(cond, bar) do { unsigned _sp = 0; while (cond) { __builtin_amdgcn_s_sleep(1); \
    if ((++_sp & 255u) == 0u) { if (xb_ld(&(bar)[XB_TMO])) break; if (_sp > XB_SPIN_CAP) { atomicAdd(&(bar)[XB_TMO], 1u); break; } } } } while (0)

struct XcdBarrier {
    unsigned* bar; unsigned x;
    volatile LAS unsigned* st;
};

__device__ __forceinline__ XcdBarrier xcd_barrier_post(unsigned* bar, volatile LAS unsigned* st) {
    XcdBarrier b; b.bar = bar; b.x = xb_xcc_id(); b.st = st;
    if (threadIdx.x == 0) (void)xb_add(&bar[XB_XCNT(b.x)], 1u);
    return b;
}
__device__ __forceinline__ void xcd_barrier_complete(unsigned* bar, unsigned x, unsigned& nloc, unsigned& nx) {
    const unsigned G = gridDim.x * gridDim.y * gridDim.z;
    unsigned sum, cnt, mine, sp = 0u;
    for (;;) {
        sum = 0u; cnt = 0u; mine = 0u;
#pragma unroll
        for (unsigned j = 0; j < 16; ++j) { const unsigned c = xb_ld(&bar[XB_XCNT(j)]); sum += c; cnt += (c > 0u) ? 1u : 0u; mine = (j == x) ? c : mine; }
        if (sum == G) break;
        __builtin_amdgcn_s_sleep(1);
        if ((++sp & 255u) == 0u) { if (xb_ld(&bar[XB_TMO])) break; if (sp > XB_SPIN_CAP) { atomicAdd(&bar[XB_TMO], 1u); break; } }
    }
    nloc = mine > 0u ? mine : 1u; nx = cnt > 0u ? cnt : 1u;
}

__device__ __forceinline__ void xcd_barrier(const XcdBarrier& b) {
    asm volatile("s_waitcnt vmcnt(0)" ::: "memory");
    __syncthreads();
    if (threadIdx.x == 0) {
        unsigned* bar = b.bar;
        __builtin_amdgcn_s_waitcnt(0);
        unsigned nloc = b.st[0], nx = b.st[1];
        if (nloc == 0u) { xcd_barrier_complete(bar, b.x, nloc, nx); b.st[0] = nloc; b.st[1] = nx; }
        const unsigned old = xb_add(&bar[XB_XSUB(b.x)], 1u);
        const unsigned gen = old / nloc;
        if (old + 1u == (gen + 1u) * nloc) {
            __builtin_amdgcn_fence(__ATOMIC_RELEASE, "agent");
            asm volatile("s_waitcnt vmcnt(0)" ::: "memory");
            const unsigned og = xb_add(&bar[XB_TOP], 1u);
            const unsigned tg = og / nx;
            if (og + 1u == (tg + 1u) * nx) xb_add(&bar[XB_TOPGEN], 1u);
            else XB_SPIN(xb_ld(&bar[XB_TOPGEN]) == tg, bar);
            __builtin_amdgcn_fence(__ATOMIC_ACQUIRE, "agent");
            xb_add(&bar[XB_XGEN(b.x)], 1u);
            asm volatile("s_waitcnt vmcnt(0)" ::: "memory");
        } else {
            XB_SPIN(xb_ld(&bar[XB_XGEN(b.x)]) == gen, bar);
            __builtin_amdgcn_fence(__ATOMIC_ACQUIRE, "agent");
            asm volatile("s_waitcnt vmcnt(0)" ::: "memory");
        }
    }
    __syncthreads();
}


template <class Epi>
DI void gemm128(const bf16_t* __restrict__ A, int lda, const bf16_t* __restrict__ B, int ldb, int K, bf16_t* sm, Epi&& epi) {
  const int tid = tidx_(), lane = tid & 63, w = tid >> 6, wp = w >> 1, wq = w & 1, l32 = lane & 31, hh = lane >> 5;
  bf16_t* sA = sm;
  bf16_t* sB = sm + 2 * 128 * LDT;
  f32x16 acc[2][2];
#pragma unroll
  for (int i = 0; i < 2; ++i)
#pragma unroll
    for (int j = 0; j < 2; ++j) acc[i][j] = zero16();
  const int lrow = tid >> 3, kc = (tid & 7) * 8;
  const bf16_t* gA = A + (size_t)lrow * lda + kc;
  const bf16_t* gB = B + (size_t)lrow * ldb + kc;
  u32x4 ra[4], rb[4];
#pragma unroll
  for (int i = 0; i < 4; ++i) {
    ra[i] = *(const u32x4*)(gA + (size_t)(32 * i) * lda);
    rb[i] = *(const u32x4*)(gB + (size_t)(32 * i) * ldb);
  }
#pragma unroll
  for (int i = 0; i < 4; ++i) {
    *(u32x4*)(sA + (lrow + 32 * i) * LDT + kc) = ra[i];
    *(u32x4*)(sB + (lrow + 32 * i) * LDT + kc) = rb[i];
  }
  __syncthreads();
  const int KT = K >> 6;
#pragma unroll 1
  for (int kt = 0; kt < KT; ++kt) {
    const int cur = kt & 1;
    if (kt + 1 < KT) {
#pragma unroll
      for (int i = 0; i < 4; ++i) {
        ra[i] = *(const u32x4*)(gA + (size_t)(32 * i) * lda + (kt + 1) * 64);
        rb[i] = *(const u32x4*)(gB + (size_t)(32 * i) * ldb + (kt + 1) * 64);
      }
    }
    const bf16_t* cA = sA + cur * 128 * LDT + (64 * wp + l32) * LDT + 8 * hh;
    const bf16_t* cB = sB + cur * 128 * LDT + (64 * wq + l32) * LDT + 8 * hh;
#pragma unroll
    for (int ks = 0; ks < 4; ++ks) {
      bf16x8 a0 = ldfrag(cA + ks * 16), a1 = ldfrag(cA + 32 * LDT + ks * 16);
      bf16x8 b0 = ldfrag(cB + ks * 16), b1 = ldfrag(cB + 32 * LDT + ks * 16);
      acc[0][0] = mfma(a0, b0, acc[0][0]);
      acc[0][1] = mfma(a0, b1, acc[0][1]);
      acc[1][0] = mfma(a1, b0, acc[1][0]);
      acc[1][1] = mfma(a1, b1, acc[1][1]);
    }
    if (kt + 1 < KT) {
      const int nx = cur ^ 1;
#pragma unroll
      for (int i = 0; i < 4; ++i) {
        *(u32x4*)(sA + nx * 128 * LDT + (lrow + 32 * i) * LDT + kc) = ra[i];
        *(u32x4*)(sB + nx * 128 * LDT + (lrow + 32 * i) * LDT + kc) = rb[i];
      }
    }
    __syncthreads();
  }
  epi(acc);
}

template <class CM>
DI void transpose_tile(const float* __restrict__ src, int ld_src, int k0, int n0, bf16_t* __restrict__ dst, int ld_dst,
                       const float* __restrict__ sc, float* smf, CM cm) {
  const int tid = tidx_();
  __syncthreads();
  {
    const int nl = tid & 63, kp = tid >> 6;
    const int sn = cm(n0 + nl);
#pragma unroll
    for (int kk = 0; kk < 16; ++kk) {
      const int k = kp * 16 + kk;
      float v = 0.f;
      if (sn >= 0) {
        v = src[(size_t)(k0 + k) * ld_src + sn];
        if (sc) v *= sc[k0 + k];
      }
      smf[nl * 65 + k] = v;
    }
  }
  __syncthreads();
  {
    const int nl = tid >> 2, ks = (tid & 3) * 16;
    const float* r = smf + nl * 65 + ks;
    uint4 u0, u1;
    u0.x = pack2(r[0], r[1]); u0.y = pack2(r[2], r[3]); u0.z = pack2(r[4], r[5]); u0.w = pack2(r[6], r[7]);
    u1.x = pack2(r[8], r[9]); u1.y = pack2(r[10], r[11]); u1.z = pack2(r[12], r[13]); u1.w = pack2(r[14], r[15]);
    bf16_t* d = dst + (size_t)(n0 + nl) * ld_dst + k0 + ks;
    *(uint4*)d = u0;
    *(uint4*)(d + 8) = u1;
  }
}

DI int mod_stream(int row) { const int b = row / TP; return (row - b * TP) < TC ? 4 : b; }

DI void phase_mod(CPARAMS p, unsigned char* smem) {
  float* cs = (float*)smem;
  float* red = cs + 5 * 1024;
  const int tid = tidx_();
  if (bidx_() == 0 && tid < 16) p.CTR[tid] = 0u;
  if (rbidx_() == 0) for (int i = tfull_(); i < XCD_BAR_WORDS; i += 512) p.BAR[i] = 0u;
  bool loaded = false;
  for (int item = bidx_(); item < NLAYER * 96; item += VGRID) {
    if (!loaded) {
      for (int i = tid; i < 5 * 1024; i += 256) {
        const float v = i < 4096 ? p.c[i] : p.c_ctx[i - 4096];
        cs[i] = v * sigmoidf_(v);
      }
      loaded = true;
    }
    __syncthreads();
    const int l = item / 96, cch = item % 96;
    const int col = cch * 64 + (tid & 63), part = tid >> 6;
    const float* wm = p.w_mod + (size_t)l * DM * 6144 + col;
    float a0 = 0.f, a1 = 0.f, a2 = 0.f, a3 = 0.f, a4 = 0.f;
#pragma unroll 16
    for (int k = part * 256; k < part * 256 + 256; ++k) {
      const float wv = wm[(size_t)k * 6144];
      a0 += cs[k] * wv; a1 += cs[1024 + k] * wv; a2 += cs[2048 + k] * wv; a3 += cs[3072 + k] * wv; a4 += cs[4096 + k] * wv;
    }
    float* rr = red + part * 320 + (tid & 63);
    rr[0] = a0; rr[64] = a1; rr[128] = a2; rr[192] = a3; rr[256] = a4;
    __syncthreads();
    for (int i = tid; i < 320; i += 256) {
      const int s = i >> 6, cl = i & 63;
      const float v = red[i] + red[320 + i] + red[640 + i] + red[960 + i] + p.b_mod[l * 6144 + cch * 64 + cl];
      p.MOD[((size_t)l * 5 + s) * 6144 + cch * 64 + cl] = v;
    }
  }
}

#define WC_IN 512
#define WC_UQ 48
#define WC_UKV 32
#define WC_OUT 256
#define WC_FF1 1024
#define WC_FF2 1024
#define WC_LRU 16
#define WC_TOTAL (WC_IN + WC_UQ + WC_UKV + WC_OUT + WC_FF1 + WC_FF2 + WC_LRU)
DI void wconv_item(CPARAMS p, int l, int it, float* smf) {
  if (it < WC_IN) {
    const int nt = it >> 4, kt = it & 15;
    transpose_tile(p.w_in + (size_t)l * DM * 2000, 2000, kt * 64, nt * 64, p.Wb_in, DM, nullptr, smf, [](int j) {
      if (j < 448) return j;
      if (j < 464) return 1472 + (j - 448);
      if (j < 512) return -1;
      if (j < 1536) return 448 + (j - 512);
      return 1488 + (j - 1536);
    });
    return;
  }
  it -= WC_IN;
  if (it < WC_UQ) {
    const int nt = it >> 2, kt = it & 3;
    transpose_tile(p.w_uq + (size_t)l * 256 * 768, 768, kt * 64, nt * 64, p.Wb_uq, 256, p.g_q + l * 256, smf, [](int j) {
      if (j < 512) return (j >> 7) * 192 + (j & 127);
      const int r = j - 512;
      return (r >> 6) * 192 + 128 + (r & 63);
    });
    return;
  }
  it -= WC_UQ;
  if (it < WC_UKV) {
    const int nt = it >> 1, kt = it & 1;
    transpose_tile(p.w_ukv + (size_t)l * 128 * 1024, 1024, kt * 64, nt * 64, p.Wb_ukv, 128, p.g_kv + l * 128, smf, [](int j) {
      if (j < 512) return (j >> 7) * 256 + (j & 127);
      const int r = j - 512;
      return (r >> 7) * 256 + 128 + (r & 127);
    });
    return;
  }
  it -= WC_UKV;
  if (it < WC_OUT) {
    const int nt = it >> 4, kt = it & 15;
    transpose_tile(p.w_out + (size_t)l * DM * DM, DM, kt * 64, nt * 64, p.Wb_out, DM, nullptr, smf, [](int j) { return j; });
    return;
  }
  it -= WC_OUT;
  if (it < WC_FF1) {
    const int nt = it >> 4, kt = it & 15;
    transpose_tile(p.w_ff1 + (size_t)l * DM * DFF, DFF, kt * 64, nt * 64, p.Wb_ff1, DM, nullptr, smf, [](int j) { return j; });
    return;
  }
  it -= WC_FF1;
  if (it < WC_FF2) {
    const int nt = it >> 6, kt = it & 63;
    transpose_tile(p.w_ff2 + (size_t)l * DFF * DM, DM, kt * 64, nt * 64, p.Wb_ff2, DFF, nullptr, smf, [](int j) { return j; });
    return;
  }
  it -= WC_FF2;
  {
    const int g = it >> 2, which = it & 3, d = which >> 1;
    const float* src = ((which & 1) ? p.w_x : p.w_a) + ((size_t)((l * 2 + d) * 4 + g)) * 4096;
    transpose_tile(src, 64, 0, 0, p.Wb_lru + (size_t)(g * 256 + which * 64) * 64, 64, nullptr, smf, [](int j) { return j; });
  }
}

template <int NR>
DI void norm_rows(CPARAMS p, int l, int which  , int row0, bool from_input) {
  const int lane = tidx_() & 63;
  float4 v[NR][4];
  float ss[NR];
  int sidx[NR];
#pragma unroll
  for (int r = 0; r < NR; ++r) {
    const int row = row0 + r;
    const int b = row / TP, pos = row - b * TP;
    sidx[r] = pos < TC ? 4 : b;
    const float* src;
    if (from_input) src = pos < TC ? p.ctx + ((size_t)b * TC + pos) * DM : p.x + ((size_t)b * TL + (pos - TC)) * DM;
    else src = p.X + (size_t)row * DM;
#pragma unroll
    for (int i = 0; i < 4; ++i) v[r][i] = *(const float4*)(src + lane * 4 + 256 * i);
  }
#pragma unroll
  for (int r = 0; r < NR; ++r) {
    float a = 0.f;
#pragma unroll
    for (int i = 0; i < 4; ++i) a += v[r][i].x * v[r][i].x + v[r][i].y * v[r][i].y + v[r][i].z * v[r][i].z + v[r][i].w * v[r][i].w;
    ss[r] = a;
  }
#pragma unroll
  for (int o = 32; o > 0; o >>= 1)
#pragma unroll
    for (int r = 0; r < NR; ++r) ss[r] += __shfl_xor(ss[r], o, 64);
#pragma unroll
  for (int r = 0; r < NR; ++r) {
    const int row = row0 + r;
    const float rs = rsqrtf(ss[r] * (1.f / DM) + EPSF);
    const float* md = p.MOD + ((size_t)l * 5 + sidx[r]) * 6144 + which * 3072;
#pragma unroll
    for (int i = 0; i < 4; ++i) {
      const int cidx = lane * 4 + 256 * i;
      if (from_input) *(float4*)(p.X + (size_t)row * DM + cidx) = v[r][i];
      const float4 sh = *(const float4*)(md + cidx);
      const float4 sc = *(const float4*)(md + 1024 + cidx);
      uint2 o;
      o.x = pack2(v[r][i].x * rs * (1.f + sc.x) + sh.x, v[r][i].y * rs * (1.f + sc.y) + sh.y);
      o.y = pack2(v[r][i].z * rs * (1.f + sc.z) + sh.z, v[r][i].w * rs * (1.f + sc.w) + sh.w);
      *(uint2*)(p.U + (size_t)row * DM + cidx) = o;
    }
  }
}
DI void norm_all_rows(CPARAMS p, int l, int which, bool from_input) {
  const int gw = bidx_() * 4 + (tidx_() >> 6), nw = VGRID * 4;
  int r = (int)((long)NTOK * gw / nw);
  const int rend = (int)((long)NTOK * (gw + 1) / nw);
  for (; r + 4 <= rend; r += 4) norm_rows<4>(p, l, which, r, from_input);
  for (; r < rend; ++r) norm_rows<1>(p, l, which, r, from_input);
}

#define WC_EARLY (WC_IN + WC_UQ + WC_UKV)
#define WC_LATE (WC_OUT + WC_FF1 + WC_FF2)
DI void phase_norm1(CPARAMS p, int l, unsigned char* smem) {
  for (int it = bidx_(); it < WC_EARLY + WC_LRU; it += VGRID) wconv_item(p, l, it < WC_EARLY ? it : it + WC_LATE, (float*)smem);
  norm_all_rows(p, l, 0, l == 0);
}
DI void phase_norm2(CPARAMS p, int l) { norm_all_rows(p, l, 1, false); }

namespace pg8 {
#define PG8_LAS __attribute__((address_space(3)))
typedef float f32x4 __attribute__((ext_vector_type(4)));
constexpr int BM = 256, BK = 64, HALF = 128, HTB = HALF * BK * 2  , STAGE_BYTES = 8 * HTB;
__device__ __forceinline__ int lds_byte(int r, int c) { const int st = (r >> 4) * 2 + (c >> 5), rr = r & 15, cc = c & 31, ob = rr * 64 + cc * 2; return st * 1024 + (ob ^ (((ob >> 9) & 1) << 5)); }
__device__ __forceinline__ void stage_rc(int b, int& R, int& C) { const int st = b / 1024, sb = b % 1024, swz = sb ^ (((sb >> 9) & 1) << 5); R = (st >> 1) * 16 + swz / 64; C = (st & 1) * 32 + (swz % 64) / 2; }
__device__ __forceinline__ int perm32(int rho) { const int n = rho >> 4, i = rho & 15; return 8 * (i >> 2) + 4 * n + (i & 3); }
struct Unit { int pm, pn, kq; };
struct Gemm { const bf16_t* A; const bf16_t* Bt; int K, ld; };
template <class Epi, class Sched>
__device__ __forceinline__ void gemm_phase(PG8_LAS unsigned char* lds, const Gemm g, const Sched& S, const Epi& E) {
    const int tid = tfull_(), wid = __builtin_amdgcn_readfirstlane(tid >> 6), lane = tid & 63, wr = wid >> 2, wc = wid & 3, fr = lane & 15, fq = lane >> 4;
    const int K = g.ld, nt = g.K / BK;
    unsigned voffA[2], voffB[2];
#pragma unroll
    for (int i = 0; i < 2; ++i) { int R, C; stage_rc(tid * 16 + i * 8192, R, C); const int Rb = Epi::PERM ? ((R & ~31) + perm32(R & 31)) : R;
        voffA[i] = (unsigned)(R * K + C) * 2u; voffB[i] = (unsigned)(Rb * K + C) * 2u; }
    const size_t kstep = (size_t)(BK * 2);
    const size_t hstep = (size_t)HALF * K * 2;
    const size_t tstep = 2 * hstep;
    const unsigned ldsw = (unsigned)wid * 1024u;
    const int aoff = lds_byte(wr * 64 + fr, fq * 8), boff = lds_byte(wc * 32 + fr, fq * 8);
#define PG8_SA(b, h) (((b) * 2 + (h)) * HTB)
#define PG8_SB(b, h) ((4 + (b) * 2 + (h)) * HTB)
#define PG8_STAGE(bufoff, gbase, voff) do { _Pragma("unroll") for (int _i = 0; _i < 2; ++_i) \
        __builtin_amdgcn_global_load_lds((const unsigned*)((const char*)(gbase) + (voff)[_i]), (PG8_LAS unsigned*)(lds + (bufoff) + ldsw + _i * 8192), 16, 0, 0); } while (0)
#define PG8_LDA(dst, b, h) do { _Pragma("unroll") for (int m = 0; m < 4; ++m) _Pragma("unroll") for (int k = 0; k < 2; ++k) dst[m][k] = *(const PG8_LAS bf16x8*)(lds + PG8_SA(b, h) + aoff + m * 2048 + k * 1024); } while (0)
#define PG8_LDB(dst, b, h) do { _Pragma("unroll") for (int n = 0; n < 2; ++n) _Pragma("unroll") for (int k = 0; k < 2; ++k) dst[n][k] = *(const PG8_LAS bf16x8*)(lds + PG8_SB(b, h) + boff + n * 2048 + k * 1024); } while (0)
#define PG8_MMA(ai, bj, At, Bt) do { __builtin_amdgcn_s_setprio(1); _Pragma("unroll") for (int m = 0; m < 4; ++m) _Pragma("unroll") for (int n = 0; n < 2; ++n) _Pragma("unroll") for (int k = 0; k < 2; ++k) \
        acc[ai][bj][m][n] = __builtin_amdgcn_mfma_f32_16x16x32_bf16(Bt[n][k], At[m][k], acc[ai][bj][m][n], 0, 0, 0); __builtin_amdgcn_s_setprio(0); } while (0)
#define PG8_WAIT_V(n) asm volatile("s_waitcnt vmcnt(" #n ")" ::: "memory")
#define PG8_WAIT_L(n) asm volatile("s_waitcnt lgkmcnt(" #n ")" ::: "memory")
#define PG8_BAR __builtin_amdgcn_s_barrier()
#define PG8_SCHED __builtin_amdgcn_sched_barrier(0)
    Unit cur, nxt; int ui = 0;
    if (!S.next(0, cur)) return;
    f32x4 acc[2][2][4][2];
#pragma unroll
    for (int a = 0; a < 2; ++a)
#pragma unroll
        for (int b = 0; b < 2; ++b)
#pragma unroll
            for (int m = 0; m < 4; ++m)
#pragma unroll
                for (int n = 0; n < 2; ++n) acc[a][b][m][n] = (f32x4){0.f, 0.f, 0.f, 0.f};
    bf16x8 At[4][2], B0[2][2], B1[2][2];
    const size_t kqstep = (size_t)g.K * 2;
    const char* cA = (const char*)g.A + (size_t)cur.pm * tstep + (size_t)cur.kq * kqstep; const char* cB = (const char*)g.Bt + (size_t)cur.pn * tstep + (size_t)cur.kq * kqstep;
    S.a_ready(cur);
    PG8_STAGE(PG8_SB(0, 0), cB, voffB); PG8_STAGE(PG8_SA(0, 0), cA, voffA); PG8_STAGE(PG8_SB(0, 1), cB + hstep, voffB); PG8_STAGE(PG8_SA(0, 1), cA + hstep, voffA);
    if (wr == 1) PG8_BAR;
    PG8_WAIT_V(4); PG8_BAR;
    PG8_STAGE(PG8_SB(1, 0), cB + kstep, voffB); PG8_STAGE(PG8_SA(1, 0), cA + kstep, voffA); PG8_STAGE(PG8_SB(1, 1), cB + hstep + kstep, voffB);
    PG8_WAIT_V(6); PG8_BAR;
    for (;;) {
        const bool has_next = S.next(ui + 1, nxt);
        const char* nA = has_next ? (const char*)g.A + (size_t)nxt.pm * tstep + (size_t)nxt.kq * kqstep : cA; const char* nB = has_next ? (const char*)g.Bt + (size_t)nxt.pn * tstep + (size_t)nxt.kq * kqstep : cB;
        for (int t = 0; t < nt; t += 2) {
            const bool last = (t == nt - 2);
            const char* a1 = cA + (size_t)(t + 1) * kstep;
            const char* a2 = last ? nA : cA + (size_t)(t + 2) * kstep; const char* b2 = last ? nB : cB + (size_t)(t + 2) * kstep;
            const char* a3 = a2 + kstep; const char* b3 = b2 + kstep;
            if (last && has_next) S.a_ready(nxt);
            PG8_LDB(B0, 0, 0); PG8_SCHED; PG8_LDA(At, 0, 0); PG8_STAGE(PG8_SA(1, 1), a1 + hstep, voffA);
            PG8_WAIT_L(8); PG8_BAR; PG8_WAIT_L(0); PG8_MMA(0, 0, At, B0); PG8_BAR; PG8_SCHED;
            PG8_LDB(B1, 0, 1); PG8_STAGE(PG8_SB(0, 0), b2, voffB);
            PG8_BAR; PG8_WAIT_L(0); PG8_MMA(0, 1, At, B1); PG8_BAR;
            PG8_LDA(At, 0, 1); PG8_STAGE(PG8_SA(0, 0), a2, voffA);
            PG8_BAR; PG8_WAIT_L(0); PG8_MMA(1, 0, At, B0); PG8_BAR; PG8_SCHED;
            PG8_STAGE(PG8_SB(0, 1), b2 + hstep, voffB);
            PG8_WAIT_V(6); PG8_BAR; PG8_MMA(1, 1, At, B1); PG8_BAR;
            PG8_LDB(B0, 1, 0); PG8_SCHED; PG8_LDA(At, 1, 0); PG8_STAGE(PG8_SA(0, 1), a2 + hstep, voffA);
            PG8_WAIT_L(8); PG8_BAR; PG8_WAIT_L(0); PG8_MMA(0, 0, At, B0); PG8_BAR; PG8_SCHED;
            PG8_LDB(B1, 1, 1); PG8_STAGE(PG8_SB(1, 0), b3, voffB);
            PG8_BAR; PG8_WAIT_L(0); PG8_MMA(0, 1, At, B1); PG8_BAR;
            PG8_LDA(At, 1, 1); PG8_STAGE(PG8_SA(1, 0), a3, voffA);
            PG8_BAR; PG8_WAIT_L(0); PG8_MMA(1, 0, At, B0); PG8_BAR; PG8_SCHED;
            PG8_STAGE(PG8_SB(1, 1), b3 + hstep, voffB);
            PG8_WAIT_V(6); PG8_BAR; PG8_MMA(1, 1, At, B1); PG8_BAR;
        }
            if constexpr (!Epi::AFTER_DRAIN) { E(acc, cur, wr, wc, fr, fq); S.done(cur); }
            if (!has_next) break;
#pragma unroll
        for (int a = 0; a < 2; ++a)
#pragma unroll
            for (int b = 0; b < 2; ++b)
#pragma unroll
                for (int m = 0; m < 4; ++m)
#pragma unroll
                    for (int n = 0; n < 2; ++n) acc[a][b][m][n] = (f32x4){0.f, 0.f, 0.f, 0.f};
        cur = nxt; cA = nA; cB = nB; ++ui;
    }
    PG8_WAIT_V(0);
    if (wr == 0) PG8_BAR;
    PG8_BAR;
    if constexpr (Epi::AFTER_DRAIN) { E.fused(acc, cur, wr, wc, fr, fq, lds, wid, lane); S.done(cur); }
#undef PG8_SA
#undef PG8_SB
#undef PG8_STAGE
#undef PG8_LDA
#undef PG8_LDB
#undef PG8_MMA
#undef PG8_WAIT_V
#undef PG8_WAIT_L
#undef PG8_BAR
#undef PG8_SCHED
}
}

DI int xcd_order() { const int b = rbidx_(), g8 = (int)gridDim.x >> 3; return (b & 7) * g8 + (b >> 3); }

struct UnitOrder {
  int nunits, G, c, mode, nK, skipctx;
  DI bool next(int i, pg8::Unit& u) const {
    const int L = i * G + c;
    if (L >= nunits) return false;
    if (mode == 0) { u.pm = L >> 3; u.pn = L & 7; u.kq = 0; }
    else if (mode == 1) { const int g = L >> 5, j = L & 31; u.pm = (g >> 1) * 4 + (j >> 3); u.pn = (g & 1) * 8 + (j & 7); u.kq = 0; }
    else { u.kq = L % nK; const int t = L / nK; u.pn = t & 3; u.pm = t >> 2; }
    if (skipctx) u.pm += (u.pm >> 4) + 1;
    return true;
  }
  DI void a_ready(const pg8::Unit&) const {}
  DI void done(const pg8::Unit&) const {}
};

struct EpiIn {
  static constexpr bool PERM = true, AFTER_DRAIN = false;
  bf16_t* Z; float* ZGt; const float* gbias;
  DI void operator()(const pg8::f32x4 (&acc)[2][2][4][2], const pg8::Unit& u, int wr, int wc, int fr, int fq) const {
    const int row0 = u.pm * 256 + wr * 64 + fr, col0 = u.pn * 256 + wc * 32 + 8 * fq;
#pragma unroll
    for (int ai = 0; ai < 2; ++ai)
#pragma unroll
      for (int m = 0; m < 4; ++m) {
        const int row = row0 + ai * 128 + m * 16;
        bf16_t* rowp = Z + (size_t)row * ZW + col0;
#pragma unroll
        for (int bj = 0; bj < 2; ++bj) {
          const pg8::f32x4 v0 = acc[ai][bj][m][0], v1 = acc[ai][bj][m][1];
          u32x4 w; w[0] = pack2(v0[0], v0[1]); w[1] = pack2(v0[2], v0[3]); w[2] = pack2(v1[0], v1[1]); w[3] = pack2(v1[2], v1[3]);
          *(u32x4*)(rowp + bj * 128) = w;
          const int c = col0 + bj * 128;
          if (c >= ZG && c < ZG + 16) {
            float* gp = ZGt + (size_t)row * 16 + (c - ZG);
            const float* gb = gbias + (c - ZG);
            *(float4*)gp = make_float4(v0[0] + gb[0], v0[1] + gb[1], v0[2] + gb[2], v0[3] + gb[3]);
            *(float4*)(gp + 4) = make_float4(v1[0] + gb[4], v1[1] + gb[5], v1[2] + gb[6], v1[3] + gb[7]);
          }
        }
      }
  }
};

struct EpiFf1 {
  static constexpr bool PERM = true, AFTER_DRAIN = false;
  bf16_t* H;
  DI void operator()(const pg8::f32x4 (&acc)[2][2][4][2], const pg8::Unit& u, int wr, int wc, int fr, int fq) const {
    const int row0 = u.pm * 256 + wr * 64 + fr, col0 = u.pn * 256 + wc * 32 + 8 * fq;
#pragma unroll
    for (int ai = 0; ai < 2; ++ai)
#pragma unroll
      for (int m = 0; m < 4; ++m) {
        bf16_t* rowp = H + (size_t)(row0 + ai * 128 + m * 16) * DFF + col0;
#pragma unroll
        for (int bj = 0; bj < 2; ++bj) {
          pg8::f32x4 v0 = acc[ai][bj][m][0], v1 = acc[ai][bj][m][1];
#pragma unroll
          for (int j = 0; j < 4; ++j) { const float a = fmaxf(v0[j], 0.f), b = fmaxf(v1[j], 0.f); v0[j] = a * a; v1[j] = b * b; }
          u32x4 w; w[0] = pack2(v0[0], v0[1]); w[1] = pack2(v0[2], v0[3]); w[2] = pack2(v1[0], v1[1]); w[3] = pack2(v1[2], v1[3]);
          *(u32x4*)(rowp + bj * 128) = w;
        }
      }
  }
};

struct EpiResid {
  static constexpr bool PERM = false, AFTER_DRAIN = false;
  float* X; const float* gate_l;
  DI void operator()(const pg8::f32x4 (&acc)[2][2][4][2], const pg8::Unit& u, int wr, int wc, int fr, int fq) const {
    const int row0 = u.pm * 256 + wr * 64 + fr, col0 = u.pn * 256 + wc * 32 + 4 * fq;
    const float* gate = gate_l + (size_t)mod_stream(u.pm * 256) * 6144;
    pg8::f32x4 gv[2][2];
#pragma unroll
    for (int bj = 0; bj < 2; ++bj)
#pragma unroll
      for (int n = 0; n < 2; ++n) gv[bj][n] = *(const pg8::f32x4*)(gate + col0 + bj * 128 + n * 16);
#pragma unroll
    for (int ai = 0; ai < 2; ++ai)
#pragma unroll
      for (int m = 0; m < 4; ++m) {
        float* rowp = X + (size_t)(row0 + ai * 128 + m * 16) * DM + col0;
#pragma unroll
        for (int bj = 0; bj < 2; ++bj)
#pragma unroll
          for (int n = 0; n < 2; ++n) {
            pg8::f32x4* xp = (pg8::f32x4*)(rowp + bj * 128 + n * 16);
            *xp = *xp + gv[bj][n] * acc[ai][bj][m][n];
          }
        asm volatile("" ::: "memory");
      }
  }
};

DI void phase_gemm_in(CPARAMS p, int l, unsigned char* smem, unsigned char* hs) {
  pg8::Gemm g; g.A = p.U; g.Bt = p.Wb_in; g.K = DM; g.ld = DM;
  UnitOrder S; S.nunits = 68 * 8; S.G = (int)gridDim.x; S.c = xcd_order(); S.mode = 0; S.nK = 1; S.skipctx = 0;
  EpiIn E; E.Z = p.Z; E.ZGt = p.ZGt; E.gbias = p.gate_bias + l * 16;
  pg8::gemm_phase((PG8_LAS unsigned char*)smem, g, S, E);
  const int G = (int)gridDim.x, rounds = (544 + G - 1) / G, busy = 544 - (rounds - 1) * G;
  const int nfree = G - busy;
  __syncthreads();
  if (nfree > 0) {
    if (S.c >= busy) {
      const int hv = (S.c - busy) * 2 + hidx_(), nh = nfree * 2;
      for (int it = hv; it < WC_LATE; it += nh) wconv_item(p, l, WC_EARLY + it, (float*)hs);
    }
  } else {
    for (int it = bidx_(); it < WC_LATE; it += VGRID) wconv_item(p, l, WC_EARLY + it, (float*)hs);
  }
}
DI void phase_gemm_ff1(CPARAMS p, int skipctx, unsigned char* smem) {
  pg8::Gemm g; g.A = p.U; g.Bt = p.Wb_ff1; g.K = DM; g.ld = DM;
  UnitOrder S; S.nunits = (skipctx ? 64 : 68) * 16; S.G = (int)gridDim.x; S.c = xcd_order(); S.mode = 1; S.nK = 1; S.skipctx = skipctx;
  EpiFf1 E; E.H = p.H;
  pg8::gemm_phase((PG8_LAS unsigned char*)smem, g, S, E);
}
DI void phase_gemm_resid_left(CPARAMS p, int l, const bf16_t* A, int K, const bf16_t* Wt, int gate_chunk, int first_tile, int ntiles, int skipctx, unsigned char* smem);
DI void phase_gemm_resid(CPARAMS p, int l, const bf16_t* A, int K, const bf16_t* Wt, int gate_chunk, int skipctx, unsigned char* smem) {
  const int G = (int)gridDim.x;
  const int ntiles = skipctx ? 256 : 272;
  const int whole = (ntiles / G) * G;
  pg8::Gemm g; g.A = A; g.Bt = Wt; g.K = K; g.ld = K;
  UnitOrder S; S.nunits = whole; S.G = G; S.c = xcd_order(); S.mode = 2; S.nK = 1; S.skipctx = skipctx;
  EpiResid E; E.X = p.X; E.gate_l = p.MOD + (size_t)l * 5 * 6144 + gate_chunk * 1024;
  pg8::gemm_phase((PG8_LAS unsigned char*)smem, g, S, E);
  __syncthreads();
  phase_gemm_resid_left(p, l, A, K, Wt, gate_chunk, whole, ntiles, skipctx, smem);
}

template <class Epi>
DI void gemm256s(const bf16_t* __restrict__ A, int lda, const bf16_t* __restrict__ B, int ldb, int kt0, int kt1, bf16_t* sm, Epi&& epi) {
  const int tid = tfull_(), lane = tid & 63, w = tid >> 6, wp = w >> 2, wq = w & 3, l32 = lane & 31, hh = lane >> 5;
  bf16_t* sA = sm;
  bf16_t* sB = sm + 2 * 256 * LDT;
  f32x16 acc[4][2];
#pragma unroll
  for (int i = 0; i < 4; ++i)
#pragma unroll
    for (int j = 0; j < 2; ++j) acc[i][j] = zero16();
  const int lrow = tid >> 3, kc = (tid & 7) * 8;
  const bf16_t* gA = A + (size_t)lrow * lda + kc;
  const bf16_t* gB = B + (size_t)lrow * ldb + kc;
  u32x4 ra[4], rb[4];
#pragma unroll
  for (int i = 0; i < 4; ++i) {
    ra[i] = *(const u32x4*)(gA + (size_t)(64 * i) * lda + kt0 * 64);
    rb[i] = *(const u32x4*)(gB + (size_t)(64 * i) * ldb + kt0 * 64);
  }
#pragma unroll
  for (int i = 0; i < 4; ++i) {
    *(u32x4*)(sA + (lrow + 64 * i) * LDT + kc) = ra[i];
    *(u32x4*)(sB + (lrow + 64 * i) * LDT + kc) = rb[i];
  }
  __syncthreads();
#pragma unroll 1
  for (int kt = kt0; kt < kt1; ++kt) {
    const int cur = (kt - kt0) & 1;
    if (kt + 1 < kt1) {
#pragma unroll
      for (int i = 0; i < 4; ++i) {
        ra[i] = *(const u32x4*)(gA + (size_t)(64 * i) * lda + (kt + 1) * 64);
        rb[i] = *(const u32x4*)(gB + (size_t)(64 * i) * ldb + (kt + 1) * 64);
      }
    }
    const bf16_t* cA = sA + cur * 256 * LDT + (128 * wp + l32) * LDT + 8 * hh;
    const bf16_t* cB = sB + cur * 256 * LDT + (64 * wq + l32) * LDT + 8 * hh;
#pragma unroll
    for (int ks = 0; ks < 4; ++ks) {
      const bf16x8 b0 = ldfrag(cB + ks * 16), b1 = ldfrag(cB + 32 * LDT + ks * 16);
#pragma unroll
      for (int mi = 0; mi < 4; ++mi) {
        const bf16x8 a = ldfrag(cA + mi * 32 * LDT + ks * 16);
        acc[mi][0] = mfma(a, b0, acc[mi][0]);
        acc[mi][1] = mfma(a, b1, acc[mi][1]);
      }
    }
    if (kt + 1 < kt1) {
      const int nx = cur ^ 1;
#pragma unroll
      for (int i = 0; i < 4; ++i) {
        *(u32x4*)(sA + nx * 256 * LDT + (lrow + 64 * i) * LDT + kc) = ra[i];
        *(u32x4*)(sB + nx * 256 * LDT + (lrow + 64 * i) * LDT + kc) = rb[i];
      }
    }
    __syncthreads();
  }
  epi(acc);
}

DI void phase_gemm_resid_left(CPARAMS p, int l, const bf16_t* A, int K, const bf16_t* Wt, int gate_chunk, int first_tile, int ntiles, int skipctx, unsigned char* smem) {
  const int tid = tfull_(), lane = tid & 63, w = tid >> 6, wp = w >> 2, wq = w & 3, l32 = lane & 31, hh = lane >> 5;
  const int KT = K >> 6;
  const long total = (long)(ntiles - first_tile) * KT;
  const int vb = xcd_order();
  long u = total * vb / (int)gridDim.x;
  const long uend = total * (vb + 1) / (int)gridDim.x;
  while (u < uend) {
    const int trel = (int)(u / KT), kt0 = (int)(u - (long)trel * KT);
    const int kt1 = (int)((uend - (long)trel * KT) < KT ? (uend - (long)trel * KT) : KT);
    const int tile = first_tile + trel;
    int mt = tile >> 2; const int nt = tile & 3;
    if (skipctx) mt += (mt >> 4) + 1;
    const int s = mod_stream(mt * 256);
    const float* gate = p.MOD + ((size_t)l * 5 + s) * 6144 + gate_chunk * 1024;
    gemm256s(A + (size_t)mt * 256 * K, K, Wt + (size_t)nt * 256 * K, K, kt0, kt1, (bf16_t*)smem, [&](f32x16 (&acc)[4][2]) {
#pragma unroll
      for (int mi = 0; mi < 4; ++mi)
#pragma unroll
        for (int ni = 0; ni < 2; ++ni) {
          const int col = nt * 256 + 64 * wq + 32 * ni + l32;
          const float g = gate[col];
#pragma unroll
          for (int i = 0; i < 16; ++i) {
            const int row = mt * 256 + 128 * wp + 32 * mi + crow(i, hh);
            unsafeAtomicAdd(p.X + (size_t)row * DM + col, g * acc[mi][ni][i]);
          }
        }
    });
    u += kt1 - kt0;
  }
}

DI void mla_krope_item(CPARAMS p, int mt, unsigned char* smem) {
  const int tid = tidx_(), lane = tid & 63, w = tid >> 6, wp = w >> 1, wq = w & 1, l32 = lane & 31, hh = lane >> 5;
  float* rsq = (float*)(smem + 73728);
  float* rskv = rsq + 128;
  const int row0 = mt * 128;
  const int b = row0 / TP, pos0 = row0 - b * TP;
  const bool latent = pos0 >= TC;
  __syncthreads();
  {
    const int tok = tid >> 1, half = tid & 1;
    const bf16_t* zr = p.Z + (size_t)(row0 + tok) * ZW;
    const int pos = pos0 + tok;
    const int t_lat = pos - TC;
    const float coord = half == 0 ? (float)(t_lat >> 6) : (float)(t_lat & 63);
    u32x4 x1v[2], x2v[2], o1v[2], o2v[2];
    x1v[0] = *(const u32x4*)(zr + ZKR + 16 * half); x1v[1] = *(const u32x4*)(zr + ZKR + 16 * half + 8);
    x2v[0] = *(const u32x4*)(zr + ZKR + 32 + 16 * half); x2v[1] = *(const u32x4*)(zr + ZKR + 32 + 16 * half + 8);
#pragma unroll
    for (int q = 0; q < 2; ++q)
#pragma unroll
      for (int jj = 0; jj < 4; ++jj) {
        const unsigned a1 = x1v[q][jj], a2 = x2v[q][jj];
        float cs0 = 1.f, sn0 = 0.f, cs1 = 1.f, sn1 = 0.f;
        if (latent) {
          const int j = 8 * q + 2 * jj;
          const float ang0 = coord * ex2(-(float)j * (13.287712379549449f / 16.f));
          const float ang1 = coord * ex2(-(float)(j + 1) * (13.287712379549449f / 16.f));
          cs0 = __cosf(ang0); sn0 = __sinf(ang0); cs1 = __cosf(ang1); sn1 = __sinf(ang1);
        }
        const float p0 = bflo(a1), p1 = bfhi(a1), r0 = bflo(a2), r1 = bfhi(a2);
        o1v[q][jj] = pack2(p0 * cs0 - r0 * sn0, p1 * cs1 - r1 * sn1);
        o2v[q][jj] = pack2(p0 * sn0 + r0 * cs0, p1 * sn1 + r1 * cs1);
      }
#pragma unroll
    for (int hd = 0; hd < 4; ++hd) {
      bf16_t* kd = p.Kb + ((size_t)(b * 4 + hd) * TP + pos) * 192 + 128 + 16 * half;
      *(u32x4*)(kd) = o1v[0];
      *(u32x4*)(kd + 8) = o1v[1];
      *(u32x4*)(kd + 32) = o2v[0];
      *(u32x4*)(kd + 40) = o2v[1];
    }
  }
  (void)rsq; (void)rskv; (void)wp; (void)wq; (void)l32; (void)hh;
}

DI void mla_q_item(CPARAMS p, int mt, int nt, unsigned char* smem) {
  const int tid = tidx_(), lane = tid & 63, w = tid >> 6, wp = w >> 1, wq = w & 1, l32 = lane & 31, hh = lane >> 5;
  float* rsq = (float*)(smem + 73728);
  float* rskv = rsq + 128;
  const int row0 = mt * 128;
  const int b = row0 / TP, pos0 = row0 - b * TP;
  const bool latent = pos0 >= TC;
  __syncthreads();
  {
    const int tok = tid >> 1, half = tid & 1;
    const bf16_t* zr = p.Z + (size_t)(row0 + tok) * ZW;
    float ss = 0.f;
#pragma unroll
    for (int i = 0; i < 16; ++i) {
      const uint4 u = *(const uint4*)(zr + ZQ + 128 * half + 8 * i);
      float a;
      a = bflo(u.x); ss += a * a; a = bfhi(u.x); ss += a * a; a = bflo(u.y); ss += a * a; a = bfhi(u.y); ss += a * a;
      a = bflo(u.z); ss += a * a; a = bfhi(u.z); ss += a * a; a = bflo(u.w); ss += a * a; a = bfhi(u.w); ss += a * a;
    }
    ss += __shfl_xor(ss, 1, 64);
    if (half == 0) rsq[tok] = rsqrtf(ss * (1.f / 256.f) + EPSF);
  }
  __syncthreads();
  {
    gemm128(p.Z + (size_t)row0 * ZW + ZQ, ZW, p.Wb_uq + (size_t)nt * 128 * 256, 256, 256, (bf16_t*)smem, [&](f32x16 (&acc)[2][2]) {
      {
        const int hd = nt < 4 ? nt : 2 * (nt - 4) + wq;
#pragma unroll
        for (int mi = 0; mi < 2; ++mi)
#pragma unroll
          for (int ni = 0; ni < 2; ++ni) {
            const int d = nt < 4 ? 64 * wq + 32 * ni + l32 : 128 + 32 * ni + l32;
#pragma unroll
            for (int i = 0; i < 16; ++i) {
              const int rl = 64 * wp + 32 * mi + crow(i, hh);
              p.Qb[((size_t)(b * 4 + hd) * TP + pos0 + rl) * 192 + d] = f2bf(acc[mi][ni][i] * rsq[rl] * QSCALE);
            }
          }
      }
    });
  }
  (void)latent; (void)rskv;
}

DI void mla_kv_item(CPARAMS p, int mt, int nt, unsigned char* smem) {
  const int tid = tidx_(), lane = tid & 63, w = tid >> 6, wp = w >> 1, wq = w & 1, l32 = lane & 31, hh = lane >> 5;
  float* rsq = (float*)(smem + 73728);
  float* rskv = rsq + 128;
  const int row0 = mt * 128;
  const int b = row0 / TP, pos0 = row0 - b * TP;
  const bool latent = pos0 >= TC;
  __syncthreads();
  {
    const int tok = tid >> 1, half = tid & 1;
    const bf16_t* zr = p.Z + (size_t)(row0 + tok) * ZW;
    float s2 = 0.f;
#pragma unroll
    for (int i = 0; i < 8; ++i) {
      const uint4 u = *(const uint4*)(zr + ZKV + 64 * half + 8 * i);
      float a;
      a = bflo(u.x); s2 += a * a; a = bfhi(u.x); s2 += a * a; a = bflo(u.y); s2 += a * a; a = bfhi(u.y); s2 += a * a;
      a = bflo(u.z); s2 += a * a; a = bfhi(u.z); s2 += a * a; a = bflo(u.w); s2 += a * a; a = bfhi(u.w); s2 += a * a;
    }
    s2 += __shfl_xor(s2, 1, 64);
    if (half == 0) rskv[tok] = rsqrtf(s2 * (1.f / 128.f) + EPSF);
  }
  __syncthreads();
  {
    gemm128(p.Z + (size_t)row0 * ZW + ZKV, ZW, p.Wb_ukv + (size_t)nt * 128 * 128, 128, 128, (bf16_t*)smem, [&](f32x16 (&acc)[2][2]) {
      if (nt < 4) {
#pragma unroll
        for (int mi = 0; mi < 2; ++mi)
#pragma unroll
          for (int ni = 0; ni < 2; ++ni) {
            const int d = 64 * wq + 32 * ni + l32;
#pragma unroll
            for (int i = 0; i < 16; ++i) {
              const int rl = 64 * wp + 32 * mi + crow(i, hh);
              p.Kb[((size_t)(b * 4 + nt) * TP + pos0 + rl) * 192 + d] = f2bf(acc[mi][ni][i] * rskv[rl]);
            }
          }
      } else {
        const int hd = nt - 4;
#pragma unroll
        for (int mi = 0; mi < 2; ++mi)
#pragma unroll
          for (int ni = 0; ni < 2; ++ni) {
            const int dv = 64 * wq + 32 * ni + l32;
            bf16_t* vd = p.Vt + ((size_t)(b * 4 + hd) * 128 + dv) * TP + pos0;
#pragma unroll
            for (int g = 0; g < 4; ++g) {
              const int rl = 64 * wp + 32 * mi + 8 * g + 4 * hh;
              const int ppos = 64 * wp + 32 * mi + 16 * (g >> 1) + 8 * hh + 4 * (g & 1);
              uint2 o;
              o.x = pack2(acc[mi][ni][4 * g] * rskv[rl], acc[mi][ni][4 * g + 1] * rskv[rl + 1]);
              o.y = pack2(acc[mi][ni][4 * g + 2] * rskv[rl + 2], acc[mi][ni][4 * g + 3] * rskv[rl + 3]);
              *(uint2*)(vd + ppos) = o;
            }
          }
      }
    });
  }
  (void)latent; (void)rsq;
}

DI void attn_item(CPARAMS p, int b, int hd, int q0, int nkt, unsigned char* smem) {
  const int tid = tidx_(), lane = tid & 63, w = tid >> 6, l32 = lane & 31, hh = lane >> 5;
  bf16_t* sK = (bf16_t*)smem;
  bf16_t* sV = sK + 2 * 64 * 200;
  const size_t bh = (size_t)(b * 4 + hd);
  bf16x8 qf[12];
  {
    const bf16_t* Qg = p.Qb + (bh * TP + q0 + 32 * w + l32) * 192 + 8 * hh;
#pragma unroll
    for (int ks = 0; ks < 12; ++ks) qf[ks] = ldfrag(Qg + 16 * ks);
    if (q0 >= TC) {
      const int t_lat = q0 - TC + 32 * w + l32;
#pragma unroll
      for (int kq = 0; kq < 2; ++kq) {
        const float coord = kq == 0 ? (float)(t_lat >> 6) : (float)(t_lat & 63);
        const u32x4 a1 = __builtin_bit_cast(u32x4, qf[8 + kq]), a2 = __builtin_bit_cast(u32x4, qf[10 + kq]);
        u32x4 n1, n2;
#pragma unroll
        for (int jj = 0; jj < 4; ++jj) {
          const int j = 8 * hh + 2 * jj;
          const float ang0 = coord * ex2(-(float)j * (13.287712379549449f / 16.f));
          const float ang1 = coord * ex2(-(float)(j + 1) * (13.287712379549449f / 16.f));
          const float cs0 = __cosf(ang0), sn0 = __sinf(ang0), cs1 = __cosf(ang1), sn1 = __sinf(ang1);
          const float p0 = bflo(a1[jj]), p1 = bfhi(a1[jj]), r0 = bflo(a2[jj]), r1 = bfhi(a2[jj]);
          n1[jj] = pack2(p0 * cs0 - r0 * sn0, p1 * cs1 - r1 * sn1);
          n2[jj] = pack2(p0 * sn0 + r0 * cs0, p1 * sn1 + r1 * cs1);
        }
        qf[8 + kq] = __builtin_bit_cast(bf16x8, n1);
        qf[10 + kq] = __builtin_bit_cast(bf16x8, n2);
      }
    }
  }
  const bf16_t* Kg = p.Kb + bh * TP * 192;
  const bf16_t* Vg = p.Vt + bh * 128 * TP;
  typedef __attribute__((address_space(3))) unsigned lds_u32;
  const int hoff = hidx_();
  const int w8 = __builtin_amdgcn_readfirstlane(w + 4 * hoff);
  lds_u32* sKl = (lds_u32*)sK;
  lds_u32* sVl = (lds_u32*)sV;
#define ATT_LOAD_K(T)                                                                             \
  _Pragma("unroll") for (int i = 0; i < 4; ++i) {                                                 \
    const int ch = w8 + 8 * i;                                                                    \
    if (ch < 25) {                                                                                \
      const int ob = ch * 1024 + lane * 16, row = ob / 400, cb = ob - row * 400;                  \
      const bf16_t* sp = Kg + (size_t)(T) * (64 * 192) + (cb < 384 ? row * 192 + (cb >> 1) : 0);  \
      __builtin_amdgcn_global_load_lds((const unsigned*)sp, sKl + ((T) & 1) * 6400 + ch * 256, 16, 0, 0); \
    }                                                                                             \
  }
#define ATT_LOAD_V(T)                                                                             \
  _Pragma("unroll") for (int i = 0; i < 3; ++i) {                                                 \
    const int ch = w8 + 8 * i;                                                                    \
    if (ch < 18) {                                                                                \
      const int ob = ch * 1024 + lane * 16, row = ob / 144, cb = ob - row * 144;                  \
      const bf16_t* sp = Vg + 64 * (T) + (cb < 128 ? (size_t)row * TP + (cb >> 1) : 0);          \
      __builtin_amdgcn_global_load_lds((const unsigned*)sp, sVl + ((T) & 1) * 4608 + ch * 256, 16, 0, 0); \
    }                                                                                             \
  }
#define ATT_RD1(D, A, OFF) asm volatile("ds_read_b128 %0, %1 offset:%2" : "=v"(D) : "v"(A), "n"(OFF))
#define ATT_RD4(F, A, O0, O1, O2, O3) do { ATT_RD1(F[0], A, O0); ATT_RD1(F[1], A, O1); ATT_RD1(F[2], A, O2); ATT_RD1(F[3], A, O3); } while (0)
#define ATT_RD2(F, A, O0, O1) do { ATT_RD1(F[0], A, O0); ATT_RD1(F[1], A, O1); } while (0)
#define ATT_WAIT2(F, N) asm volatile("s_waitcnt lgkmcnt(%2)" : "+v"(F[0]), "+v"(F[1]) : "n"(N))
#define ATT_WAIT4(F, N) asm volatile("s_waitcnt lgkmcnt(%4)" : "+v"(F[0]), "+v"(F[1]), "+v"(F[2]), "+v"(F[3]) : "n"(N))
  const unsigned kaddr0 = (unsigned)(size_t)(sK + l32 * 200 + 8 * hh);
  const unsigned vaddr0 = (unsigned)(size_t)(sV + l32 * LDT + 8 * hh);
  __syncthreads();
  ATT_LOAD_K(0);
  asm volatile("s_waitcnt vmcnt(0)" ::: "memory");
  for (int i = tfull_(); i < 2 * 18432 / 16; i += 512) ((u32x4*)sV)[i] = (u32x4){0u, 0u, 0u, 0u};
  f32x16 o[4];
#pragma unroll
  for (int i = 0; i < 4; ++i) o[i] = zero16();
  f32x16 sX = zero16(), sY = zero16();
  bf16x8 pX[2], pY[2];
  pX[0] = (bf16x8){0, 0, 0, 0, 0, 0, 0, 0}; pX[1] = pX[0]; pY[0] = pX[0]; pY[1] = pX[0];
  float m = -1e30f, lsum = 0.f;
  __syncthreads();
#define ATT_EXP2(SV, J0, J1) { SV[J0] = ex2(SV[J0] - m); SV[J1] = ex2(SV[J1] - m); ps += SV[J0] + SV[J1]; }
#define ATT_QK(F, G, SO_) { SO_ = mfma(F[0], qf[2 * (G)], SO_); SO_ = mfma(F[1], qf[2 * (G) + 1], SO_); }
#define ATT_PV(F, P_, PI_) { o[2 * ((P_) & 1)] = mfma(F[0], PI_[(P_) >> 1], o[2 * ((P_) & 1)]); o[2 * ((P_) & 1) + 1] = mfma(F[1], PI_[(P_) >> 1], o[2 * ((P_) & 1) + 1]); }
#define ATT_RDK(F, G, KB) ATT_RD2(F, kaddr, (KB) * 12800 + 64 * (G), (KB) * 12800 + 64 * (G) + 32)
#define ATT_RDV(F, P_, KB) ATT_RD2(F, vaddr, 2 * ((P_) & 1) * 4608 + (KB) * 64 + ((P_) >> 1) * 32, (2 * ((P_) & 1) + 1) * 4608 + (KB) * 64 + ((P_) >> 1) * 32)
#define ATT_STEP(J, KB, SI, SO, PI, PO)                                                                           \
  {                                                                                                               \
    const int jj = (J), T = jj >> 1;                                                                              \
    if ((KB) == 0) {                                                                                              \
      if (T + 1 < nkt) { ATT_LOAD_K(T + 1); }                                                                     \
      if (T < nkt) { ATT_LOAD_V(T); }                                                                             \
    }                                                                                                             \
    const unsigned kaddr = kaddr0 + (T & 1) * 25600, vaddr = vaddr0 + ((T + 1) & 1) * 18432;                      \
    const bool valid = jj >= 1 && jj <= 2 * nkt;                                                                  \
    float tmax = SI[0];                                                                                           \
    _Pragma("unroll") for (int q = 1; q < 16; ++q) tmax = fmaxf(tmax, SI[q]);                                     \
    tmax = fmaxf(tmax, xhalf(tmax));                                                                              \
    const bool need = valid && (tmax > m + 8.f);                                                                  \
    const float mn = need ? tmax : m;                                                                             \
    const float alpha = ex2(m - mn);                                                                              \
    m = mn;                                                                                                       \
    float ps = 0.f;                                                                                               \
    SO = zero16();                                                                                                \
    bf16x8 fa[2], fb[2], fc[2];                                                                                   \
    ATT_RDK(fa, 0, KB); ATT_RDK(fb, 1, KB);                                                                       \
    ATT_RDK(fc, 2, KB); ATT_WAIT2(fa, 4); ATT_QK(fa, 0, SO); ATT_EXP2(SI, 0, 1);                                      \
    ATT_RDK(fa, 3, KB); ATT_WAIT2(fb, 4); ATT_QK(fb, 1, SO); ATT_EXP2(SI, 2, 3);                                      \
    ATT_RDK(fb, 4, KB); ATT_WAIT2(fc, 4); ATT_QK(fc, 2, SO); ATT_EXP2(SI, 4, 5);                                      \
    ATT_RDK(fc, 5, KB); ATT_WAIT2(fa, 4); ATT_QK(fa, 3, SO); ATT_EXP2(SI, 6, 7);                                      \
    ATT_RDV(fa, 0, KB); ATT_WAIT2(fb, 4); ATT_QK(fb, 4, SO); ATT_EXP2(SI, 8, 9);                                      \
    ATT_RDV(fb, 1, KB); ATT_WAIT2(fc, 4); ATT_QK(fc, 5, SO); ATT_EXP2(SI, 10, 11);                                    \
    ATT_RDV(fc, 2, KB); ATT_WAIT2(fa, 4); ATT_PV(fa, 0, PI); ATT_EXP2(SI, 12, 13);                                    \
    ATT_RDV(fa, 3, KB); ATT_WAIT2(fb, 4); ATT_PV(fb, 1, PI); ATT_EXP2(SI, 14, 15);                                    \
    ATT_WAIT2(fc, 2); ATT_PV(fc, 2, PI);                                                                              \
    if (valid) {                                                                                                  \
      PO[0] = pack8(SI[0], SI[1], SI[2], SI[3], SI[4], SI[5], SI[6], SI[7]);                                      \
      PO[1] = pack8(SI[8], SI[9], SI[10], SI[11], SI[12], SI[13], SI[14], SI[15]);                                \
      lsum = lsum * alpha + ps;                                                                                   \
    }                                                                                                             \
    ATT_WAIT2(fa, 0); ATT_PV(fa, 3, PI);                                                                              \
    if (__builtin_amdgcn_ballot_w64(need) != 0ull) {                                                              \
      _Pragma("unroll") for (int dt = 0; dt < 4; ++dt)                                                            \
        _Pragma("unroll") for (int q = 0; q < 16; ++q) o[dt][q] *= alpha;                                         \
    }                                                                                                             \
    if ((KB) == 1) {                                                                                              \
      asm volatile("s_waitcnt vmcnt(0)" ::: "memory");                                                            \
      __syncthreads();                                                                                            \
    }                                                                                                             \
  }
#pragma unroll 1
  for (int j = 0; j <= 2 * nkt; j += 2) {
    ATT_STEP(j, 0, sX, sY, pX, pY);
    ATT_STEP(j + 1, 1, sY, sX, pY, pX);
  }
#undef ATT_STEP
#undef ATT_EXP2
#undef ATT_QK
#undef ATT_PV
#undef ATT_RDK
#undef ATT_RDV
#undef ATT_LOAD_K
#undef ATT_LOAD_V
#undef ATT_RD1
#undef ATT_RD4
#undef ATT_RD2
#undef ATT_WAIT2
#undef ATT_WAIT4
  lsum += xhalf(lsum);
  const float inv = 1.f / lsum;
  bf16_t* od = p.U + ((size_t)b * TP + q0 + 32 * w + l32) * DM + hd * 128 + 4 * hh;
#pragma unroll
  for (int dt = 0; dt < 4; ++dt)
#pragma unroll
    for (int g = 0; g < 4; ++g) {
      uint2 u;
      u.x = pack2(o[dt][4 * g] * inv, o[dt][4 * g + 1] * inv);
      u.y = pack2(o[dt][4 * g + 2] * inv, o[dt][4 * g + 3] * inv);
      *(uint2*)(od + 32 * dt + 8 * g) = u;
    }
}

DI float masked_sum128(const float* v, int lo, int hi, float& total) {
  float acc = 0.f, tot = 0.f;
#pragma unroll 8
  for (int u4 = 0; u4 < 32; ++u4) {
    const float4 x = *(const float4*)(v + 4 * u4);
    const int u = 4 * u4;
    tot += (x.x + x.y) + (x.z + x.w);
    acc += ((u >= lo && u <= hi) ? x.x : 0.f) + ((u + 1 >= lo && u + 1 <= hi) ? x.y : 0.f)
         + ((u + 2 >= lo && u + 2 <= hi) ? x.z : 0.f) + ((u + 3 >= lo && u + 3 <= hi) ? x.w : 0.f);
  }
  total = tot;
  return acc;
}
DI float masked_max128(const float* v, int lo, int hi) {
  float acc = -1e30f;
#pragma unroll 8
  for (int u4 = 0; u4 < 32; ++u4) {
    const float4 x = *(const float4*)(v + 4 * u4);
    const int u = 4 * u4;
    acc = fmaxf(acc, fmaxf(fmaxf((u >= lo && u <= hi) ? x.x : -1e30f, (u + 1 >= lo && u + 1 <= hi) ? x.y : -1e30f),
                           fmaxf((u + 2 >= lo && u + 2 <= hi) ? x.z : -1e30f, (u + 3 >= lo && u + 3 <= hi) ? x.w : -1e30f)));
  }
  return acc;
}
DI float log_sigmoid_(float x) { return fminf(x, 0.f) - log1pf(fexp(-fabsf(x))); }

DI void mlstm_local_item(CPARAMS p, int bh, int ck, unsigned char* smem) {
  const int tid = tidx_(), lane = tid & 63, w = tid >> 6, l32 = lane & 31, hh = lane >> 5;
  const int b = bh >> 2, hd = bh & 3;
  bf16_t* sKt = (bf16_t*)smem;
  bf16_t* sVf = sKt + 64 * 136;
  bf16_t* sVb = sVf + 64 * 136;
  float* slf = (float*)(sVb + 64 * 136);
  float* sg = slf + 256;
  float* sw = sg + 256;
  float* snp = sw + 256;
  const int row0 = b * TP + ck * 128;
  const int dir = tid >> 7, tok = tid & 127;
  __syncthreads();
  const float* zg = p.ZGt + (size_t)(row0 + tok) * 16;
  const float ipre = zg[dir * 8 + hd];
  slf[dir * 128 + tok] = log_sigmoid_(zg[dir * 8 + 4 + hd]);
  __syncthreads();
  const int plo = dir == 0 ? 0 : tok, phi = dir == 0 ? tok : 127;
  float tot;
  const float bc = masked_sum128(slf + dir * 128, plo, phi, tot);
  const float g = tot - bc + ipre;
  sg[dir * 128 + tok] = g;
  __syncthreads();
  const float mloc = masked_max128(sg + dir * 128, 0, 127);
  sw[dir * 128 + tok] = fexp(g - mloc);
  __syncthreads();
#pragma unroll
  for (int i = 0; i < 4; ++i) {
    const int c = tid + 256 * i, tk = c >> 3, f8 = (c & 7) * 8;
    const bf16_t* zr = p.Z + (size_t)(row0 + tk) * ZW + 64 * hd + f8;
    const uint4 ku = *(const uint4*)(zr + ZMK);
    const uint4 vu = *(const uint4*)(zr + ZMV);
    const unsigned kk[4] = {ku.x, ku.y, ku.z, ku.w}, vv[4] = {vu.x, vu.y, vu.z, vu.w};
    const float wf = sw[tk], wb = sw[128 + tk];
#pragma unroll
    for (int e = 0; e < 4; ++e) {
      sKt[(f8 + 2 * e) * 136 + tk] = (bf16_t)(kk[e] & 0xffffu);
      sKt[(f8 + 2 * e + 1) * 136 + tk] = (bf16_t)(kk[e] >> 16);
      const float v0 = bflo(vv[e]), v1 = bfhi(vv[e]);
      sVf[(f8 + 2 * e) * 136 + tk] = f2bf(v0 * wf);
      sVf[(f8 + 2 * e + 1) * 136 + tk] = f2bf(v1 * wf);
      sVb[(f8 + 2 * e) * 136 + tk] = f2bf(v0 * wb);
      sVb[(f8 + 2 * e + 1) * 136 + tk] = f2bf(v1 * wb);
    }
  }
  __syncthreads();
  const int mi = w >> 1, ni = w & 1;
#pragma unroll
  for (int d = 0; d < 2; ++d) {
    const bf16_t* sV = d ? sVb : sVf;
    f32x16 acc = zero16();
#pragma unroll
    for (int ks = 0; ks < 8; ++ks)
      acc = mfma(ldfrag(sV + (32 * mi + l32) * 136 + 16 * ks + 8 * hh), ldfrag(sKt + (32 * ni + l32) * 136 + 16 * ks + 8 * hh), acc);
    float* rec = p.CST + ((size_t)(bh * 34 + ck) * 2 + d) * CREC;
#pragma unroll
    for (int i = 0; i < 16; ++i) rec[(32 * mi + crow(i, hh)) * 64 + 32 * ni + l32] = acc[i];
  }
  {
    const int dk = tid & 63, part = tid >> 6;
    float nf = 0.f, nb = 0.f;
    for (int s = part * 32; s < part * 32 + 32; ++s) {
      const float kv = bf2f(sKt[dk * 136 + s]);
      nf += sw[s] * kv; nb += sw[128 + s] * kv;
    }
    snp[(part * 2 + 0) * 64 + dk] = nf;
    snp[(part * 2 + 1) * 64 + dk] = nb;
  }
  __syncthreads();
  if (tid < 128) {
    const int d = tid >> 6, dk = tid & 63;
    float* rec = p.CST + ((size_t)(bh * 34 + ck) * 2 + d) * CREC;
    rec[4096 + dk] = snp[(0 * 2 + d) * 64 + dk] + snp[(1 * 2 + d) * 64 + dk] + snp[(2 * 2 + d) * 64 + dk] + snp[(3 * 2 + d) * 64 + dk];
  }
  if (tok == 0) {
    float* rec = p.CST + ((size_t)(bh * 34 + ck) * 2 + dir) * CREC;
    rec[4160] = mloc;
    rec[4161] = tot;
  }
}

DI void phase_mlstm_scan(CPARAMS p) {
  const int total = 32 * 4160;
  for (int idx = bidx_() * 256 + tidx_(); idx < total; idx += VGRID * 256) {
    const int combo = idx / 4160, e = idx - combo * 4160;
    const int bh = combo >> 1, d = combo & 1;
    float* base = p.CST + ((size_t)(bh * 34) * 2 + d) * CREC;
    float loc[34], mloc[34], tot[34];
#pragma unroll
    for (int ck = 0; ck < 34; ++ck) {
      const float* rec = base + (size_t)ck * 2 * CREC;
      loc[ck] = rec[e]; mloc[ck] = rec[4160]; tot[ck] = rec[4161];
    }
    float st = 0.f, m = 0.f;
    if (d == 0) {
#pragma unroll
      for (int ck = 0; ck < 34; ++ck) {
        float* rec = base + (size_t)ck * 2 * CREC;
        rec[e] = st;
        if (e == 0) rec[4162] = m;
        const float mn = fmaxf(tot[ck] + m, mloc[ck]);
        st = fexp(tot[ck] + m - mn) * st + fexp(mloc[ck] - mn) * loc[ck];
        m = mn;
      }
    } else {
#pragma unroll
      for (int step = 0; step < 34; ++step) {
        const int ck = step < 2 ? 1 - step : 35 - step;
        float* rec = base + (size_t)ck * 2 * CREC;
        rec[e] = st;
        if (e == 0) rec[4162] = m;
        const float mn = fmaxf(tot[ck] + m, mloc[ck]);
        st = fexp(tot[ck] + m - mn) * st + fexp(mloc[ck] - mn) * loc[ck];
        m = mn;
      }
    }
  }
}

DI void mlstm_out_item(CPARAMS p, int bh, int ck, unsigned char* smem) {
  const int tid = tidx_(), lane = tid & 63, w = tid >> 6, l32 = lane & 31, hh = lane >> 5;
  const int b = bh >> 2, hd = bh & 3;
  bf16_t* sK = (bf16_t*)smem;
  bf16_t* sVt = sK + 128 * LDT;
  bf16_t* sC = sVt + 64 * 136;
  float* slf = (float*)(sC + 2 * 64 * LDT);
  float* sb = slf + 256;
  float* se = sb + 256;
  float* sM = se + 256;
  float* sn = sM + 256;
  const int row0 = b * TP + ck * 128;
  const float* rec0 = p.CST + ((size_t)(bh * 34 + ck) * 2) * CREC;
  __syncthreads();
  {
    const int dir = tid >> 7, tok = tid & 127;
    const float* zg = p.ZGt + (size_t)(row0 + tok) * 16;
    const float ipre = zg[dir * 8 + hd];
    slf[dir * 128 + tok] = log_sigmoid_(zg[dir * 8 + 4 + hd]);
#pragma unroll
    for (int i = 0; i < 4; ++i) {
      const int c = tid + 256 * i, tk = c >> 3, f8 = (c & 7) * 8;
      const bf16_t* zr = p.Z + (size_t)(row0 + tk) * ZW + 64 * hd + f8;
      *(uint4*)(sK + tk * LDT + f8) = *(const uint4*)(zr + ZMK);
      const uint4 vu = *(const uint4*)(zr + ZMV);
      const unsigned vv[4] = {vu.x, vu.y, vu.z, vu.w};
      const int pk = permk(tk);
#pragma unroll
      for (int e = 0; e < 4; ++e) {
        sVt[(f8 + 2 * e) * 136 + pk] = (bf16_t)(vv[e] & 0xffffu);
        sVt[(f8 + 2 * e + 1) * 136 + pk] = (bf16_t)(vv[e] >> 16);
      }
    }
#pragma unroll
    for (int d = 0; d < 2; ++d) {
      const int dv = tid >> 2, dk0 = (tid & 3) * 16;
      const float* src = rec0 + (size_t)d * CREC + dv * 64 + dk0;
      const float4 f0 = *(const float4*)(src), f1 = *(const float4*)(src + 4), f2 = *(const float4*)(src + 8), f3 = *(const float4*)(src + 12);
      bf16_t* dd = sC + d * 64 * LDT + dv * LDT + dk0;
      *(uint4*)dd = make_uint4(pack2(f0.x, f0.y), pack2(f0.z, f0.w), pack2(f1.x, f1.y), pack2(f1.z, f1.w));
      *(uint4*)(dd + 8) = make_uint4(pack2(f2.x, f2.y), pack2(f2.z, f2.w), pack2(f3.x, f3.y), pack2(f3.z, f3.w));
    }
    if (tid < 128) sn[tid] = rec0[(size_t)(tid >> 6) * CREC + 4096 + (tid & 63)];
    __syncthreads();
    const int plo = dir == 0 ? 0 : tok, phi = dir == 0 ? tok : 127;
    float tot_unused;
    const float bc = masked_sum128(slf + dir * 128, plo, phi, tot_unused);
    sb[dir * 128 + tok] = bc;
    se[dir * 128 + tok] = ipre - bc;
    __syncthreads();
    const float cm = masked_max128(se + dir * 128, plo, phi);
    const float mprev = rec0[(size_t)dir * CREC + 4162];
    sM[dir * 128 + tok] = fmaxf(mprev, cm);
    __syncthreads();
  }
  const int tq = 32 * w + l32;
  bf16x8 qf[4];
  {
    const bf16_t* qg = p.Z + (size_t)(row0 + tq) * ZW + ZMQ + 64 * hd + 8 * hh;
#pragma unroll
    for (int ks = 0; ks < 4; ++ks) qf[ks] = ldfrag(qg + 16 * ks);
  }
  f32x16 hs[2];
  hs[0] = zero16(); hs[1] = zero16();
#pragma unroll
  for (int d = 0; d < 2; ++d) {
    const float mprev = rec0[(size_t)d * CREC + 4162];
    const float Mt = sM[d * 128 + tq], bt = sb[d * 128 + tq];
    const float winter = fexp(mprev - Mt) * 0.125f;
    float qn = 0.f;
#pragma unroll
    for (int ks = 0; ks < 4; ++ks) {
      const uint4 qu = __builtin_bit_cast(uint4, qf[ks]);
      const float* nn = sn + d * 64 + 16 * ks + 8 * hh;
      qn += bflo(qu.x) * nn[0] + bfhi(qu.x) * nn[1] + bflo(qu.y) * nn[2] + bfhi(qu.y) * nn[3]
          + bflo(qu.z) * nn[4] + bfhi(qu.z) * nn[5] + bflo(qu.w) * nn[6] + bfhi(qu.w) * nn[7];
    }
    qn += xhalf(qn);
    f32x16 num[2];
#pragma unroll
    for (int dt = 0; dt < 2; ++dt) {
      f32x16 a = zero16();
#pragma unroll
      for (int ks = 0; ks < 4; ++ks) a = mfma(ldfrag(sC + d * 64 * LDT + (32 * dt + l32) * LDT + 16 * ks + 8 * hh), qf[ks], a);
#pragma unroll
      for (int i = 0; i < 16; ++i) a[i] *= winter;
      num[dt] = a;
    }
    float den = 0.f;
#pragma unroll
    for (int kb = 0; kb < 4; ++kb) {
      const bool active = d == 0 ? (kb <= w) : (kb >= w);
      if (active) {
        f32x16 s = zero16();
#pragma unroll
        for (int ks = 0; ks < 4; ++ks) s = mfma(ldfrag(sK + (32 * kb + l32) * LDT + 16 * ks + 8 * hh), qf[ks], s);
#pragma unroll
        for (int g = 0; g < 4; ++g) {
          const float4 e4 = *(const float4*)(se + d * 128 + 32 * kb + 8 * g + 4 * hh);
          const float ee[4] = {e4.x, e4.y, e4.z, e4.w};
#pragma unroll
          for (int j = 0; j < 4; ++j) {
            const int sidx = 32 * kb + 8 * g + 4 * hh + j;
            const bool ok = d == 0 ? (sidx <= tq) : (sidx >= tq);
            const float arg = ok ? (ee[j] - Mt) : -1e30f;
            const float pv = s[4 * g + j] * (0.125f * fexp(arg));
            s[4 * g + j] = pv;
            den += pv;
          }
        }
#pragma unroll
        for (int s2 = 0; s2 < 2; ++s2) {
          const bf16x8 pb = pack8(s[8 * s2], s[8 * s2 + 1], s[8 * s2 + 2], s[8 * s2 + 3], s[8 * s2 + 4], s[8 * s2 + 5], s[8 * s2 + 6], s[8 * s2 + 7]);
#pragma unroll
          for (int dt = 0; dt < 2; ++dt) num[dt] = mfma(ldfrag(sVt + (32 * dt + l32) * 136 + 32 * kb + 16 * s2 + 8 * hh), pb, num[dt]);
        }
      }
    }
    den += xhalf(den);
    den += winter * qn;
    const float dn = fmaxf(fabsf(den), fexp(-(bt + Mt)));
    const float inv = 1.f / dn;
#pragma unroll
    for (int dt = 0; dt < 2; ++dt)
#pragma unroll
      for (int i = 0; i < 16; ++i) hs[dt][i] += num[dt][i] * inv;
  }
  float ss = 0.f;
#pragma unroll
  for (int dt = 0; dt < 2; ++dt)
#pragma unroll
    for (int i = 0; i < 16; ++i) ss += hs[dt][i] * hs[dt][i];
  ss += xhalf(ss);
  const float rs = rsqrtf(ss * (1.f / 64.f) + EPSF);
  const bf16_t* og = p.Z + (size_t)(row0 + tq) * ZW + ZMO + 64 * hd + 4 * hh;
  bf16_t* od = p.U + (size_t)(row0 + tq) * DM + 512 + 64 * hd + 4 * hh;
#pragma unroll
  for (int dt = 0; dt < 2; ++dt)
#pragma unroll
    for (int g = 0; g < 4; ++g) {
      const uint2 ou = *(const uint2*)(og + 32 * dt + 8 * g);
      uint2 r;
      r.x = pack2(sigmoidf_(bflo(ou.x)) * hs[dt][4 * g] * rs, sigmoidf_(bfhi(ou.x)) * hs[dt][4 * g + 1] * rs);
      r.y = pack2(sigmoidf_(bflo(ou.y)) * hs[dt][4 * g + 2] * rs, sigmoidf_(bfhi(ou.y)) * hs[dt][4 * g + 3] * rs);
      *(uint2*)(od + 32 * dt + 8 * g) = r;
    }
}

DI void lru_local_item(CPARAMS p, int l, int mt, int gd0, unsigned char* smem) {
  const int tid = tidx_(), lane = tid & 63, w = tid >> 6, l32 = lane & 31, hh = lane >> 5;
  bf16_t* sX = (bf16_t*)smem;
  bf16_t* sW = sX + 128 * LDT;
  float* sAa = (float*)smem;
  float* sUu = sAa + 128 * 64;
  const int row0 = mt * 128;
  const int b = row0 / TP, pos0 = row0 - b * TP;
  const int seg_lo = pos0 < TC ? 0 : TC, seg_hi = pos0 < TC ? TC : TP;
  {
    const int gd = gd0;
    const int g = gd >> 1, d = gd & 1;
    __syncthreads();
    {
      const int c8 = (tid & 7) * 8, ch0 = 64 * g + c8;
      float cw[4][8], cb[8];
#pragma unroll
      for (int e = 0; e < 8; ++e) {
        cb[e] = p.conv_b[l * 256 + ch0 + e];
#pragma unroll
        for (int j = 0; j < 4; ++j) cw[j][e] = p.conv_w[(l * 4 + j) * 256 + ch0 + e];
      }
#pragma unroll
      for (int i = 0; i < 4; ++i) {
        const int tk = (tid >> 3) + 32 * i;
        float a[8];
#pragma unroll
        for (int e = 0; e < 8; ++e) a[e] = cb[e];
#pragma unroll
        for (int j = 0; j < 4; ++j) {
          const int ps = pos0 + tk + j - 2;
          const bool inr = ps >= seg_lo && ps < seg_hi;
          const int psc = inr ? ps : pos0 + tk;
          u32x4 u = *(const u32x4*)(p.Z + (size_t)(b * TP + psc) * ZW + ZLX + ch0);
          u[0] = inr ? u[0] : 0u; u[1] = inr ? u[1] : 0u; u[2] = inr ? u[2] : 0u; u[3] = inr ? u[3] : 0u;
          a[0] += bflo(u[0]) * cw[j][0]; a[1] += bfhi(u[0]) * cw[j][1]; a[2] += bflo(u[1]) * cw[j][2]; a[3] += bfhi(u[1]) * cw[j][3];
          a[4] += bflo(u[2]) * cw[j][4]; a[5] += bfhi(u[2]) * cw[j][5]; a[6] += bflo(u[3]) * cw[j][6]; a[7] += bfhi(u[3]) * cw[j][7];
        }
        u32x4 o;
        o[0] = pack2(a[0], a[1]); o[1] = pack2(a[2], a[3]); o[2] = pack2(a[4], a[5]); o[3] = pack2(a[6], a[7]);
        *(u32x4*)(sX + tk * LDT + c8) = o;
        {
          float* xg = p.XS + (size_t)(row0 + tk) * 256 + ch0;
          *(float4*)xg = make_float4(a[0], a[1], a[2], a[3]);
          *(float4*)(xg + 4) = make_float4(a[4], a[5], a[6], a[7]);
        }
      }
#pragma unroll
      for (int i = 0; i < 4; ++i) {
        const int c = tid + 256 * i, r = c >> 3, k8 = (c & 7) * 8;
        *(u32x4*)(sW + r * LDT + k8) = *(const u32x4*)(p.Wb_lru + (size_t)(g * 256 + d * 128 + r) * 64 + k8);
      }
    }
    __syncthreads();
    f32x16 acc[4];
#pragma unroll
    for (int nt = 0; nt < 4; ++nt) acc[nt] = zero16();
#pragma unroll
    for (int ks = 0; ks < 4; ++ks) {
      const bf16x8 a = ldfrag(sX + (32 * w + l32) * LDT + 16 * ks + 8 * hh);
#pragma unroll
      for (int nt = 0; nt < 4; ++nt) acc[nt] = mfma(a, ldfrag(sW + (32 * nt + l32) * LDT + 16 * ks + 8 * hh), acc[nt]);
    }
    __syncthreads();
#pragma unroll
    for (int pt = 0; pt < 2; ++pt) {
      const int chl = 32 * pt + l32, ch = 64 * g + chl;
      const float ba = p.b_a[(l * 2 + d) * 256 + ch], bx = p.b_x[(l * 2 + d) * 256 + ch];
      const float lm = p.lam[(l * 2 + d) * 256 + ch];
      const float spl = fmaxf(-lm, 0.f) + log1pf(fexp(-fabsf(lm)));
#pragma unroll
      for (int i = 0; i < 16; ++i) {
        const int tk = 32 * w + crow(i, hh);
        const float r = sigmoidf_(acc[pt][i] + ba), ig = sigmoidf_(acc[2 + pt][i] + bx);
        const float la = -8.f * r * spl;
        const float a = fexp(la);
        const float u = sqrtf(-expm1f(2.f * la)) * ig * p.XS[(size_t)(row0 + tk) * 256 + ch];
        sAa[tk * 64 + chl] = a;
        sUu[tk * 64 + chl] = u;
      }
    }
    __syncthreads();
    const int chl = tid & 63, sg = tid >> 6;
    {
      float P = 1.f, hv = 0.f;
      float av[32], uv[32];
#pragma unroll
      for (int s = 0; s < 32; ++s) {
        const int tk = d == 0 ? 32 * sg + s : 32 * sg + 31 - s;
        av[s] = sAa[tk * 64 + chl]; uv[s] = sUu[tk * 64 + chl];
      }
#pragma unroll
      for (int s = 0; s < 32; ++s) {
        hv = av[s] * hv + uv[s]; P *= av[s];
        av[s] = P; uv[s] = hv;
      }
#pragma unroll
      for (int s = 0; s < 32; ++s) {
        const int tk = d == 0 ? 32 * sg + s : 32 * sg + 31 - s;
        sAa[tk * 64 + chl] = av[s]; sUu[tk * 64 + chl] = uv[s];
      }
    }
    __syncthreads();
    {
      float cP = 1.f, cH = 0.f;
#pragma unroll
      for (int q = 0; q < 4; ++q) {
        const int sq = d == 0 ? q : 3 - q;
        const bool before = d == 0 ? (sq < sg) : (sq > sg);
        const int tl = d == 0 ? 32 * sq + 31 : 32 * sq;
        const float Pr = sAa[tl * 64 + chl], Hr = sUu[tl * 64 + chl];
        const float Pq = before ? Pr : 1.f, Hq = before ? Hr : 0.f;
        cH = Pq * cH + Hq; cP *= Pq;
      }
      bf16_t* auH = p.AU + ((size_t)(d * 2 + 0) * NTOK + row0) * 256 + 64 * g + chl;
      bf16_t* auP = p.AU + ((size_t)(d * 2 + 1) * NTOK + row0) * 256 + 64 * g + chl;
      float Pl = 1.f, Hl = 0.f;
#pragma unroll
      for (int s = 0; s < 32; ++s) {
        const int tk = d == 0 ? 32 * sg + s : 32 * sg + 31 - s;
        const float pa = sAa[tk * 64 + chl], hu = sUu[tk * 64 + chl];
        Pl = pa * cP;
        Hl = hu + pa * cH;
        auH[(size_t)tk * 256] = f2bf(Hl);
        auP[(size_t)tk * 256] = f2bf(Pl);
      }
      const bool lastseg = d == 0 ? (sg == 3) : (sg == 0);
      if (lastseg) {
        float* ag = p.AGG + ((size_t)(mt * 2 + d) * 2) * 256 + 64 * g + chl;
        ag[0] = Pl; ag[256] = Hl;
      }
    }
  }
}

DI float gelu_tanh_(float x) {
  const float y = 0.7978845608028654f * (x + 0.044715f * x * x * x);
  const float t = 1.f - 2.f / (fexp(2.f * y) + 1.f);
  return 0.5f * x * (1.f + t);
}

DI void lru_out_item(CPARAMS p, int mt, unsigned char* smem) {
  const int tid = tidx_();
  float* scf = (float*)smem;
  float* scb = scf + 256;
  const int row0 = mt * 128;
  const int b = row0 / TP;
  const int tl = mt - b * 34;
  __syncthreads();
  {
    const int ch = tid;
    float cf = 0.f, cb = 0.f;
    {
      float av[34], hv[34];
#pragma unroll
      for (int j = 0; j < 34; ++j) {
        const float* ag = p.AGG + ((size_t)((b * 34 + j) * 2 + 0) * 2) * 256 + ch;
        av[j] = ag[0]; hv[j] = ag[256];
      }
#pragma unroll
      for (int j = 0; j < 34; ++j) asm volatile("" : "+v"(av[j]), "+v"(hv[j]));
#pragma unroll
      for (int j = 0; j < 34; ++j) {
        const float ae = j < tl ? av[j] : 1.f, he = j < tl ? hv[j] : 0.f;
        cf = ae * cf + he;
      }
    }
    {
      float av[34], hv[34];
#pragma unroll
      for (int j = 0; j < 34; ++j) {
        const float* ag = p.AGG + ((size_t)((b * 34 + j) * 2 + 1) * 2) * 256 + ch;
        av[j] = ag[0]; hv[j] = ag[256];
      }
#pragma unroll
      for (int j = 0; j < 34; ++j) asm volatile("" : "+v"(av[j]), "+v"(hv[j]));
#pragma unroll
      for (int step = 0; step < 34; ++step) {
        const int j = step < 2 ? 1 - step : 35 - step;
        const bool before = tl < 2 ? (j < 2 && j > tl) : (j < 2 || j > tl);
        const float ae = before ? av[j] : 1.f, he = before ? hv[j] : 0.f;
        cb = ae * cb + he;
      }
    }
    scf[ch] = cf; scb[ch] = cb;
  }
  __syncthreads();
  const int c8 = (tid & 31) * 8;
  float cf[8], cb[8];
#pragma unroll
  for (int e = 0; e < 8; ++e) { cf[e] = scf[c8 + e]; cb[e] = scb[c8 + e]; }
#pragma unroll 4
  for (int i = 0; i < 16; ++i) {
    const int t = (tid >> 5) + 8 * i;
    const size_t ro = (size_t)(row0 + t) * 256 + c8;
    const u32x4 hf = *(const u32x4*)(p.AU + (size_t)0 * NTOK * 256 + ro);
    const u32x4 pf = *(const u32x4*)(p.AU + (size_t)1 * NTOK * 256 + ro);
    const u32x4 hb = *(const u32x4*)(p.AU + (size_t)2 * NTOK * 256 + ro);
    const u32x4 pb = *(const u32x4*)(p.AU + (size_t)3 * NTOK * 256 + ro);
    const u32x4 gz = *(const u32x4*)(p.Z + (size_t)(row0 + t) * ZW + ZLG + c8);
    u32x4 o;
#pragma unroll
    for (int q = 0; q < 4; ++q) {
      const float h0 = bflo(hf[q]) + bflo(pf[q]) * cf[2 * q] + bflo(hb[q]) + bflo(pb[q]) * cb[2 * q];
      const float h1 = bfhi(hf[q]) + bfhi(pf[q]) * cf[2 * q + 1] + bfhi(hb[q]) + bfhi(pb[q]) * cb[2 * q + 1];
      o[q] = pack2(gelu_tanh_(bflo(gz[q])) * h0, gelu_tanh_(bfhi(gz[q])) * h1);
    }
    *(u32x4*)(p.U + (size_t)(row0 + t) * DM + 768 + c8) = o;
  }
}

DI int next_item(unsigned* ctr, unsigned char* smem_full) {
  int* slot = (int*)(smem_full + 163808);
  __syncthreads();
  if (tfull_() == 0) *slot = (int)atomicAdd(ctr, 2u);
  __syncthreads();
  return *slot + hidx_();
}
DI void phase_prep(CPARAMS p, int l, unsigned char* smem, unsigned char* smem_full) {
  unsigned* ctr = p.CTR + 2 * l;
  for (;;) {
    int it = next_item(ctr, smem_full);
    if (it >= 1088 + 544 + 816 + 1088 + 136) break;
    if (it < 1088) { lru_local_item(p, l, it >> 3, it & 7, smem); continue; }
    it -= 1088;
    if (it < 544) { mlstm_local_item(p, it / 34, it % 34, smem); continue; }
    it -= 544;
    if (it < 816) { mla_q_item(p, it / 6, it % 6, smem); continue; }
    it -= 816;
    if (it < 1088) { mla_kv_item(p, it >> 3, it & 7, smem); continue; }
    it -= 1088;
    mla_krope_item(p, it, smem);
  }
}
DI void phase_mix(CPARAMS p, int l, unsigned char* smem, unsigned char* smem_full) {
  for (int a = bidx_(); a < 512; a += VGRID) {
    const int rb = a >> 1, x = rb & 7, j = ((rb >> 3) << 1) | (a & 1);
    const int bh = 2 * x + (j >> 5), qt = j & 31;
    attn_item(p, bh >> 2, bh & 3, TC + 128 * qt, 68, smem_full);
  }
  unsigned* ctr = p.CTR + 2 * l + 1;
  if (l == NLAYER - 1) {
    for (;;) {
      const int it = next_item(ctr, smem_full);
      if (it >= 512 + 128) break;
      if (it < 512) mlstm_out_item(p, it >> 5, 2 + (it & 31), smem);
      else { const int t = it - 512; lru_out_item(p, (t >> 5) * 34 + 2 + (t & 31), smem); }
    }
    return;
  }
  for (;;) {
    const int it = next_item(ctr, smem_full);
    if (it >= 32 + 544 + 136) break;
    if (it < 32) { const int bh = it >> 1, qt = it & 1; attn_item(p, bh >> 2, bh & 3, 128 * qt, 4, smem_full); }
    else if (it < 576) { const int j = it - 32; mlstm_out_item(p, j / 34, j % 34, smem); }
    else lru_out_item(p, it - 576, smem);
  }
}
DI void phase_final(CPARAMS p) {
  const int lane = tidx_() & 63, w = tidx_() >> 6;
  for (int it = bidx_(); it < NB * TL / 4; it += VGRID) {
    const int r = it * 4 + w;
    const int b = r >> 12, t = r & 4095;
    const float* src = p.X + ((size_t)b * TP + TC + t) * DM;
    float4 v[4];
    float ss = 0.f;
#pragma unroll
    for (int i = 0; i < 4; ++i) {
      v[i] = *(const float4*)(src + lane * 4 + 256 * i);
      ss += v[i].x * v[i].x + v[i].y * v[i].y + v[i].z * v[i].z + v[i].w * v[i].w;
    }
#pragma unroll
    for (int o = 32; o > 0; o >>= 1) ss += __shfl_xor(ss, o, 64);
    const float rs = rsqrtf(ss * (1.f / DM) + EPSF);
#pragma unroll
    for (int i = 0; i < 4; ++i) {
      const int cidx = lane * 4 + 256 * i;
      const float4 g = *(const float4*)(p.final_g + cidx);
      float4 o4;
      o4.x = v[i].x * rs * g.x; o4.y = v[i].y * rs * g.y; o4.z = v[i].z * rs * g.z; o4.w = v[i].w * rs * g.w;
      *(float4*)(p.out + (size_t)r * DM + cidx) = o4;
    }
  }
}

__global__ void __launch_bounds__(512, 2) mega_kernel(Params p_unused) {
  __shared__ __attribute__((aligned(16))) unsigned char smem[163840];
  cg::grid_group grid = cg::this_grid();
  unsigned char* hs = smem + hidx_() * 81920;
  if (threadIdx.x < 4) ((unsigned*)(smem + 163824))[threadIdx.x] = 0u;
  __syncthreads();
  phase_mod(*kparams(), hs);
  grid.sync();
  XcdBarrier xb = xcd_barrier_post(kparams()->BAR, (volatile LAS unsigned*)(smem + 163824));
#pragma unroll 1
  for (int l = 0; l < NLAYER; ++l) {
    phase_norm1(*kparams(), l, hs);
    xcd_barrier(xb);
    phase_gemm_in(*kparams(), l, smem, hs);
    xcd_barrier(xb);
    phase_prep(*kparams(), l, hs, smem);
    xcd_barrier(xb);
    phase_mlstm_scan(*kparams());
    xcd_barrier(xb);
    phase_mix(*kparams(), l, hs, smem);
    xcd_barrier(xb);
    phase_gemm_resid(*kparams(), l, kparams()->U, DM, kparams()->Wb_out, 2, l == NLAYER - 1, smem);
    xcd_barrier(xb);
    phase_norm2(*kparams(), l);
    xcd_barrier(xb);
    phase_gemm_ff1(*kparams(), l == NLAYER - 1, smem);
    xcd_barrier(xb);
    phase_gemm_resid(*kparams(), l, kparams()->H, DFF, kparams()->Wb_ff2, 5, l == NLAYER - 1, smem);
    xcd_barrier(xb);
  }
  phase_final(*kparams());
}

extern "C" void kernel_launch(void* const* d_in, const int* in_sizes, int n_in, void* d_out, int out_size, void* d_ws, size_t ws_size,
                              hipStream_t stream) {
  static int grid_blocks = 0;
  if (!grid_blocks) {
    int dev = 0, cus = 0, per_cu = 0;
    hipGetDevice(&dev);
    hipDeviceGetAttribute(&cus, hipDeviceAttributeMultiprocessorCount, dev);
    hipOccupancyMaxActiveBlocksPerMultiprocessor(&per_cu, mega_kernel, 512, 0);
    if (per_cu > 1) per_cu = 1;
    if (per_cu < 1) per_cu = 1;
    grid_blocks = cus * per_cu;
  }
  Params p{};
  const float* const* in = (const float* const*)d_in;
  p.x = in[0]; p.c = in[1]; p.ctx = in[2]; p.c_ctx = in[3]; p.w_mod = in[4]; p.b_mod = in[5]; p.w_in = in[6];
  p.g_q = in[7]; p.w_uq = in[8]; p.g_kv = in[9]; p.w_ukv = in[10]; p.gate_bias = in[11];
  p.conv_w = in[12]; p.conv_b = in[13]; p.w_a = in[14]; p.b_a = in[15]; p.w_x = in[16]; p.b_x = in[17]; p.lam = in[18];
  p.w_out = in[19]; p.w_ff1 = in[20]; p.w_ff2 = in[21]; p.final_g = in[22];
  p.out = (float*)d_out;
  unsigned char* ws = (unsigned char*)d_ws;
  size_t off = 0;
  auto take = [&](size_t bytes) { unsigned char* r = ws + off; off += (bytes + 255) & ~(size_t)255; return r; };
  p.Wb_in = (bf16_t*)take((size_t)2048 * 1024 * 2);
  p.Wb_uq = (bf16_t*)take((size_t)768 * 256 * 2);
  p.Wb_ukv = (bf16_t*)take((size_t)1024 * 128 * 2);
  p.Wb_out = (bf16_t*)take((size_t)1024 * 1024 * 2);
  p.Wb_ff1 = (bf16_t*)take((size_t)4096 * 1024 * 2);
  p.Wb_ff2 = (bf16_t*)take((size_t)4096 * 1024 * 2);
  p.Wb_lru = (bf16_t*)take((size_t)4 * 256 * 64 * 2);
  p.MOD = (float*)take((size_t)4 * 5 * 6144 * 4);
  p.X = (float*)take((size_t)NTOK * DM * 4);
  p.U = (bf16_t*)take((size_t)NTOK * DM * 2);
  p.H = (bf16_t*)take((size_t)NTOK * DFF * 2);
  p.Z = p.H;
  p.Qb = p.Z + (size_t)NTOK * ZW;
  p.Kb = p.Qb + (size_t)16 * TP * 192;
  p.Vt = p.Kb + (size_t)16 * TP * 192;
  p.ZGt = (float*)take((size_t)NTOK * 16 * 4);
  p.AU = (bf16_t*)take((size_t)4 * NTOK * 256 * 2);
  p.AGG = (float*)take((size_t)136 * 2 * 2 * 256 * 4);
  p.CST = (float*)take((size_t)16 * 34 * 2 * CREC * 4);
  p.XS = (float*)take((size_t)NTOK * 256 * 4);
  p.CTR = (unsigned*)take(256);
  p.BAR = (unsigned*)take((size_t)XCD_BAR_WORDS * 4);
  if (off > ws_size) fprintf(stderr, "workspace too small: need %zu have %zu\n", off, ws_size);
  void* args[] = {&p};
  hipError_t e = hipLaunchCooperativeKernel((void*)mega_kernel, dim3(grid_blocks), dim3(512), args, 0, stream);
  if (e != hipSuccess) fprintf(stderr, "cooperative launch failed: %s (grid %d)\n", hipGetErrorString(e), grid_blocks);
}
```

```cpp
#include <hip/hip_runtime.h>
#include <hip/hip_cooperative_groups.h>
#include <cstdio>
namespace cg = cooperative_groups;

#define DI __device__ __forceinline__
typedef unsigned short bf16_t;
typedef __attribute__((ext_vector_type(8))) short bf16x8;
typedef __attribute__((ext_vector_type(16))) float f32x16;
typedef __attribute__((ext_vector_type(4))) unsigned u32x4;
typedef __bf16 bf16v2_t __attribute__((ext_vector_type(2)));
typedef float f32v2_t __attribute__((ext_vector_type(2)));

#define NB 4
#define TL 4096
#define TC 256
#define TP 4352
#define NTOK 17408
#define DM 1024
#define DFF 4096
#define ZW 2048
#define NLAYER 4
#define EPSF 1e-6f
#define ZQ 0
#define ZKV 256
#define ZKR 384
#define ZG 448
#define ZMQ 512
#define ZMK 768
#define ZMV 1024
#define ZMO 1280
#define ZLX 1536
#define ZLG 1792
#define LDT 72
#define CREC 4224
#define QSCALE (0.07216878364870322f * 1.4426950408889634f)

struct Params {
  const float *x, *c, *ctx, *c_ctx, *w_mod, *b_mod, *w_in, *g_q, *w_uq, *g_kv, *w_ukv, *gate_bias;
  const float *conv_w, *conv_b, *w_a, *b_a, *w_x, *b_x, *lam, *w_out, *w_ff1, *w_ff2, *final_g;
  float* out;
  bf16_t *Wb_in, *Wb_uq, *Wb_ukv, *Wb_out, *Wb_ff1, *Wb_ff2, *Wb_lru;
  float* MOD;
  float* X;
  bf16_t* U;
  bf16_t* Z;
  bf16_t* Qb;
  bf16_t* Kb;
  bf16_t* Vt;
  bf16_t* H;
  float* ZGt;
  bf16_t* AU;
  float* AGG;
  float* CST;
  float* XS;
  unsigned* CTR;
  unsigned* BAR;
};

typedef const __attribute__((address_space(4))) Params CParamsT;
typedef CParamsT& CPARAMS;
__device__ __forceinline__ CParamsT* kparams() {
  CParamsT* q = (CParamsT*)__builtin_amdgcn_kernarg_segment_ptr();
  asm volatile("" : "+s"(q));
  return q;
}

DI int tfull_() { int t = threadIdx.x; asm volatile("" : "+v"(t)); return t; }
DI int tidx_() { return tfull_() & 255; }
DI int hidx_() { return tfull_() >> 8; }
DI int rbidx_() { int t = blockIdx.x; asm volatile("" : "+s"(t)); return t; }
DI int bidx_() { return rbidx_() * 2 + hidx_(); }
#define VGRID ((int)gridDim.x * 2)
DI unsigned pack2(float a, float b) {
  f32v2_t v = {a, b};
  bf16v2_t r = __builtin_convertvector(v, bf16v2_t);
  return __builtin_bit_cast(unsigned, r);
}
DI bf16_t f2bf(float a) { return (bf16_t)(pack2(a, 0.f) & 0xffffu); }
DI float bf2f(bf16_t v) { return __uint_as_float(((unsigned)v) << 16); }
DI float bflo(unsigned u) { return __uint_as_float(u << 16); }
DI float bfhi(unsigned u) { return __uint_as_float(u & 0xffff0000u); }
DI f32x16 mfma(bf16x8 a, bf16x8 b, f32x16 c) { return __builtin_amdgcn_mfma_f32_32x32x16_bf16(a, b, c, 0, 0, 0); }
DI f32x16 zero16() { f32x16 z;
#pragma unroll
  for (int i = 0; i < 16; ++i) z[i] = 0.f; return z; }
DI float ex2(float x) { return __builtin_amdgcn_exp2f(x); }
DI float fexp(float x) { return __builtin_amdgcn_exp2f(x * 1.4426950408889634f); }
DI float sigmoidf_(float x) { return 1.f / (1.f + fexp(-x)); }
DI float xhalf(float v) { return __shfl_xor(v, 32, 64); }
DI bf16x8 ldfrag(const bf16_t* p) { return *(const bf16x8*)p; }
DI bf16x8 pack8(float a0, float a1, float a2, float a3, float a4, float a5, float a6, float a7) {
  uint4 u; u.x = pack2(a0, a1); u.y = pack2(a2, a3); u.z = pack2(a4, a5); u.w = pack2(a6, a7);
  return __builtin_bit_cast(bf16x8, u);
}
DI int crow(int i, int hh) { return (i & 3) + 8 * (i >> 2) + 4 * hh; }
DI int permk(int t) { return (t & ~12) | ((t & 4) << 1) | ((t & 8) >> 1); }

#define XB_TMO      128
#define XB_XCNT(j)  (256  + 64 * (j))
#define XB_XSUB(j)  (1280 + 64 * (j))
#define XB_XGEN(j)  (2304 + 64 * (j))
#define XB_TOP      3328
#define XB_TOPGEN   3392
#define XCD_BAR_WORDS 3456
#define XB_SPIN_CAP (1u << 18)
#define LAS __attribute__((address_space(3)))

__device__ __forceinline__ unsigned xb_ld(unsigned* p)              { return __hip_atomic_load(p, __ATOMIC_RELAXED, __HIP_MEMORY_SCOPE_AGENT); }
__device__ __forceinline__ unsigned xb_add(unsigned* p, unsigned v) { return __hip_atomic_fetch_add(p, v, __ATOMIC_RELAXED, __HIP_MEMORY_SCOPE_AGENT); }
__device__ __forceinline__ unsigned xb_xcc_id() { return (unsigned)__builtin_amdgcn_s_getreg((3 << 11) | 20) & 0xFu; }
#define XB_SPIN(cond, bar) do { unsigned _sp = 0; while (cond) { __builtin_amdgcn_s_sleep(1); \
    if ((++_sp & 255u) == 0u) { if (xb_ld(&(bar)[XB_TMO])) break; if (_sp > XB_SPIN_CAP) { atomicAdd(&(bar)[XB_TMO], 1u); break; } } } } while (0)

struct XcdBarrier {
    unsigned* bar; unsigned x;
    volatile LAS unsigned* st;
};

__device__ __forceinline__ XcdBarrier xcd_barrier_post(unsigned* bar, volatile LAS unsigned* st) {
    XcdBarrier b; b.bar = bar; b.x = xb_xcc_id(); b.st = st;
    if (threadIdx.x == 0) (void)xb_add(&bar[XB_XCNT(b.x)], 1u);
    return b;
}
__device__ __forceinline__ void xcd_barrier_complete(unsigned* bar, unsigned x, unsigned& nloc, unsigned& nx) {
    const unsigned G = gridDim.x * gridDim.y * gridDim.z;
    unsigned sum, cnt, mine, sp = 0u;
    for (;;) {
        sum = 0u; cnt = 0u; mine = 0u;
#pragma unroll
        for (unsigned j = 0; j < 16; ++j) { const unsigned c = xb_ld(&bar[XB_XCNT(j)]); sum += c; cnt += (c > 0u) ? 1u : 0u; mine = (j == x) ? c : mine; }
        if (sum == G) break;
        __builtin_amdgcn_s_sleep(1);
        if ((++sp & 255u) == 0u) { if (xb_ld(&bar[XB_TMO])) break; if (sp > XB_SPIN_CAP) { atomicAdd(&bar[XB_TMO], 1u); break; } }
    }
    nloc = mine > 0u ? mine : 1u; nx = cnt > 0u ? cnt : 1u;
}

__device__ __forceinline__ void xcd_barrier(const XcdBarrier& b) {
    asm volatile("s_waitcnt vmcnt(0)" ::: "memory");
    __syncthreads();
    if (threadIdx.x == 0) {
        unsigned* bar = b.bar;
        __builtin_amdgcn_s_waitcnt(0);
        unsigned nloc = b.st[0], nx = b.st[1];
        if (nloc == 0u) { xcd_barrier_complete(bar, b.x, nloc, nx); b.st[0] = nloc; b.st[1] = nx; }
        const unsigned old = xb_add(&bar[XB_XSUB(b.x)], 1u);
        const unsigned gen = old / nloc;
        if (old + 1u == (gen + 1u) * nloc) {
            __builtin_amdgcn_fence(__ATOMIC_RELEASE, "agent");
            asm volatile("s_waitcnt vmcnt(0)" ::: "memory");
            const unsigned og = xb_add(&bar[XB_TOP], 1u);
            const unsigned tg = og / nx;
            if (og + 1u == (tg + 1u) * nx) xb_add(&bar[XB_TOPGEN], 1u);
            else XB_SPIN(xb_ld(&bar[XB_TOPGEN]) == tg, bar);
            __builtin_amdgcn_fence(__ATOMIC_ACQUIRE, "agent");
            xb_add(&bar[XB_XGEN(b.x)], 1u);
            asm volatile("s_waitcnt vmcnt(0)" ::: "memory");
        } else {
            XB_SPIN(xb_ld(&bar[XB_XGEN(b.x)]) == gen, bar);
            __builtin_amdgcn_fence(__ATOMIC_ACQUIRE, "agent");
            asm volatile("s_waitcnt vmcnt(0)" ::: "memory");
        }
    }
    __syncthreads();
}


template <class Epi>
DI void gemm128(const bf16_t* __restrict__ A, int lda, const bf16_t* __restrict__ B, int ldb, int K, bf16_t* sm, Epi&& epi) {
  const int tid = tidx_(), lane = tid & 63, w = tid >> 6, wp = w >> 1, wq = w & 1, l32 = lane & 31, hh = lane >> 5;
  bf16_t* sA = sm;
  bf16_t* sB = sm + 2 * 128 * LDT;
  f32x16 acc[2][2];
#pragma unroll
  for (int i = 0; i < 2; ++i)
#pragma unroll
    for (int j = 0; j < 2; ++j) acc[i][j] = zero16();
  const int lrow = tid >> 3, kc = (tid & 7) * 8;
  const bf16_t* gA = A + (size_t)lrow * lda + kc;
  const bf16_t* gB = B + (size_t)lrow * ldb + kc;
  u32x4 ra[4], rb[4];
#pragma unroll
  for (int i = 0; i < 4; ++i) {
    ra[i] = *(const u32x4*)(gA + (size_t)(32 * i) * lda);
    rb[i] = *(const u32x4*)(gB + (size_t)(32 * i) * ldb);
  }
#pragma unroll
  for (int i = 0; i < 4; ++i) {
    *(u32x4*)(sA + (lrow + 32 * i) * LDT + kc) = ra[i];
    *(u32x4*)(sB + (lrow + 32 * i) * LDT + kc) = rb[i];
  }
  __syncthreads();
  const int KT = K >> 6;
#pragma unroll 1
  for (int kt = 0; kt < KT; ++kt) {
    const int cur = kt & 1;
    if (kt + 1 < KT) {
#pragma unroll
      for (int i = 0; i < 4; ++i) {
        ra[i] = *(const u32x4*)(gA + (size_t)(32 * i) * lda + (kt + 1) * 64);
        rb[i] = *(const u32x4*)(gB + (size_t)(32 * i) * ldb + (kt + 1) * 64);
      }
    }
    const bf16_t* cA = sA + cur * 128 * LDT + (64 * wp + l32) * LDT + 8 * hh;
    const bf16_t* cB = sB + cur * 128 * LDT + (64 * wq + l32) * LDT + 8 * hh;
#pragma unroll
    for (int ks = 0; ks < 4; ++ks) {
      bf16x8 a0 = ldfrag(cA + ks * 16), a1 = ldfrag(cA + 32 * LDT + ks * 16);
      bf16x8 b0 = ldfrag(cB + ks * 16), b1 = ldfrag(cB + 32 * LDT + ks * 16);
      acc[0][0] = mfma(a0, b0, acc[0][0]);
      acc[0][1] = mfma(a0, b1, acc[0][1]);
      acc[1][0] = mfma(a1, b0, acc[1][0]);
      acc[1][1] = mfma(a1, b1, acc[1][1]);
    }
    if (kt + 1 < KT) {
      const int nx = cur ^ 1;
#pragma unroll
      for (int i = 0; i < 4; ++i) {
        *(u32x4*)(sA + nx * 128 * LDT + (lrow + 32 * i) * LDT + kc) = ra[i];
        *(u32x4*)(sB + nx * 128 * LDT + (lrow + 32 * i) * LDT + kc) = rb[i];
      }
    }
    __syncthreads();
  }
  epi(acc);
}

template <class CM>
DI void transpose_tile(const float* __restrict__ src, int ld_src, int k0, int n0, bf16_t* __restrict__ dst, int ld_dst,
                       const float* __restrict__ sc, float* smf, CM cm) {
  const int tid = tidx_();
  __syncthreads();
  {
    const int nl = tid & 63, kp = tid >> 6;
    const int sn = cm(n0 + nl);
#pragma unroll
    for (int kk = 0; kk < 16; ++kk) {
      const int k = kp * 16 + kk;
      float v = 0.f;
      if (sn >= 0) {
        v = src[(size_t)(k0 + k) * ld_src + sn];
        if (sc) v *= sc[k0 + k];
      }
      smf[nl * 65 + k] = v;
    }
  }
  __syncthreads();
  {
    const int nl = tid >> 2, ks = (tid & 3) * 16;
    const float* r = smf + nl * 65 + ks;
    uint4 u0, u1;
    u0.x = pack2(r[0], r[1]); u0.y = pack2(r[2], r[3]); u0.z = pack2(r[4], r[5]); u0.w = pack2(r[6], r[7]);
    u1.x = pack2(r[8], r[9]); u1.y = pack2(r[10], r[11]); u1.z = pack2(r[12], r[13]); u1.w = pack2(r[14], r[15]);
    bf16_t* d = dst + (size_t)(n0 + nl) * ld_dst + k0 + ks;
    *(uint4*)d = u0;
    *(uint4*)(d + 8) = u1;
  }
}

DI int mod_stream(int row) { const int b = row / TP; return (row - b * TP) < TC ? 4 : b; }

DI void phase_mod(CPARAMS p, unsigned char* smem) {
  float* cs = (float*)smem;
  float* red = cs + 5 * 1024;
  const int tid = tidx_();
  if (bidx_() == 0 && tid < 16) p.CTR[tid] = 0u;
  if (rbidx_() == 0) for (int i = tfull_(); i < XCD_BAR_WORDS; i += 512) p.BAR[i] = 0u;
  bool loaded = false;
  for (int item = bidx_(); item < NLAYER * 96; item += VGRID) {
    if (!loaded) {
      for (int i = tid; i < 5 * 1024; i += 256) {
        const float v = i < 4096 ? p.c[i] : p.c_ctx[i - 4096];
        cs[i] = v * sigmoidf_(v);
      }
      loaded = true;
    }
    __syncthreads();
    const int l = item / 96, cch = item % 96;
    const int col = cch * 64 + (tid & 63), part = tid >> 6;
    const float* wm = p.w_mod + (size_t)l * DM * 6144 + col;
    float a0 = 0.f, a1 = 0.f, a2 = 0.f, a3 = 0.f, a4 = 0.f;
#pragma unroll 16
    for (int k = part * 256; k < part * 256 + 256; ++k) {
      const float wv = wm[(size_t)k * 6144];
      a0 += cs[k] * wv; a1 += cs[1024 + k] * wv; a2 += cs[2048 + k] * wv; a3 += cs[3072 + k] * wv; a4 += cs[4096 + k] * wv;
    }
    float* rr = red + part * 320 + (tid & 63);
    rr[0] = a0; rr[64] = a1; rr[128] = a2; rr[192] = a3; rr[256] = a4;
    __syncthreads();
    for (int i = tid; i < 320; i += 256) {
      const int s = i >> 6, cl = i & 63;
      const float v = red[i] + red[320 + i] + red[640 + i] + red[960 + i] + p.b_mod[l * 6144 + cch * 64 + cl];
      p.MOD[((size_t)l * 5 + s) * 6144 + cch * 64 + cl] = v;
    }
  }
}

#define WC_IN 512
#define WC_UQ 48
#define WC_UKV 32
#define WC_OUT 256
#define WC_FF1 1024
#define WC_FF2 1024
#define WC_LRU 16
#define WC_TOTAL (WC_IN + WC_UQ + WC_UKV + WC_OUT + WC_FF1 + WC_FF2 + WC_LRU)
DI void wconv_item(CPARAMS p, int l, int it, float* smf) {
  if (it < WC_IN) {
    const int nt = it >> 4, kt = it & 15;
    transpose_tile(p.w_in + (size_t)l * DM * 2000, 2000, kt * 64, nt * 64, p.Wb_in, DM, nullptr, smf, [](int j) {
      if (j < 448) return j;
      if (j < 464) return 1472 + (j - 448);
      if (j < 512) return -1;
      if (j < 1536) return 448 + (j - 512);
      return 1488 + (j - 1536);
    });
    return;
  }
  it -= WC_IN;
  if (it < WC_UQ) {
    const int nt = it >> 2, kt = it & 3;
    transpose_tile(p.w_uq + (size_t)l * 256 * 768, 768, kt * 64, nt * 64, p.Wb_uq, 256, p.g_q + l * 256, smf, [](int j) {
      if (j < 512) return (j >> 7) * 192 + (j & 127);
      const int r = j - 512;
      return (r >> 6) * 192 + 128 + (r & 63);
    });
    return;
  }
  it -= WC_UQ;
  if (it < WC_UKV) {
    const int nt = it >> 1, kt = it & 1;
    transpose_tile(p.w_ukv + (size_t)l * 128 * 1024, 1024, kt * 64, nt * 64, p.Wb_ukv, 128, p.g_kv + l * 128, smf, [](int j) {
      if (j < 512) return (j >> 7) * 256 + (j & 127);
      const int r = j - 512;
      return (r >> 7) * 256 + 128 + (r & 127);
    });
    return;
  }
  it -= WC_UKV;
  if (it < WC_OUT) {
    const int nt = it >> 4, kt = it & 15;
    transpose_tile(p.w_out + (size_t)l * DM * DM, DM, kt * 64, nt * 64, p.Wb_out, DM, nullptr, smf, [](int j) { return j; });
    return;
  }
  it -= WC_OUT;
  if (it < WC_FF1) {
    const int nt = it >> 4, kt = it & 15;
    transpose_tile(p.w_ff1 + (size_t)l * DM * DFF, DFF, kt * 64, nt * 64, p.Wb_ff1, DM, nullptr, smf, [](int j) { return j; });
    return;
  }
  it -= WC_FF1;
  if (it < WC_FF2) {
    const int nt = it >> 6, kt = it & 63;
    transpose_tile(p.w_ff2 + (size_t)l * DFF * DM, DM, kt * 64, nt * 64, p.Wb_ff2, DFF, nullptr, smf, [](int j) { return j; });
    return;
  }
  it -= WC_FF2;
  {
    const int g = it >> 2, which = it & 3, d = which >> 1;
    const float* src = ((which & 1) ? p.w_x : p.w_a) + ((size_t)((l * 2 + d) * 4 + g)) * 4096;
    transpose_tile(src, 64, 0, 0, p.Wb_lru + (size_t)(g * 256 + which * 64) * 64, 64, nullptr, smf, [](int j) { return j; });
  }
}

template <int NR>
DI void norm_rows(CPARAMS p, int l, int which  , int row0, bool from_input) {
  const int lane = tidx_() & 63;
  float4 v[NR][4];
  float ss[NR];
  int sidx[NR];
#pragma unroll
  for (int r = 0; r < NR; ++r) {
    const int row = row0 + r;
    const int b = row / TP, pos = row - b * TP;
    sidx[r] = pos < TC ? 4 : b;
    const float* src;
    if (from_input) src = pos < TC ? p.ctx + ((size_t)b * TC + pos) * DM : p.x + ((size_t)b * TL + (pos - TC)) * DM;
    else src = p.X + (size_t)row * DM;
#pragma unroll
    for (int i = 0; i < 4; ++i) v[r][i] = *(const float4*)(src + lane * 4 + 256 * i);
  }
#pragma unroll
  for (int r = 0; r < NR; ++r) {
    float a = 0.f;
#pragma unroll
    for (int i = 0; i < 4; ++i) a += v[r][i].x * v[r][i].x + v[r][i].y * v[r][i].y + v[r][i].z * v[r][i].z + v[r][i].w * v[r][i].w;
    ss[r] = a;
  }
#pragma unroll
  for (int o = 32; o > 0; o >>= 1)
#pragma unroll
    for (int r = 0; r < NR; ++r) ss[r] += __shfl_xor(ss[r], o, 64);
#pragma unroll
  for (int r = 0; r < NR; ++r) {
    const int row = row0 + r;
    const float rs = rsqrtf(ss[r] * (1.f / DM) + EPSF);
    const float* md = p.MOD + ((size_t)l * 5 + sidx[r]) * 6144 + which * 3072;
#pragma unroll
    for (int i = 0; i < 4; ++i) {
      const int cidx = lane * 4 + 256 * i;
      if (from_input) *(float4*)(p.X + (size_t)row * DM + cidx) = v[r][i];
      const float4 sh = *(const float4*)(md + cidx);
      const float4 sc = *(const float4*)(md + 1024 + cidx);
      uint2 o;
      o.x = pack2(v[r][i].x * rs * (1.f + sc.x) + sh.x, v[r][i].y * rs * (1.f + sc.y) + sh.y);
      o.y = pack2(v[r][i].z * rs * (1.f + sc.z) + sh.z, v[r][i].w * rs * (1.f + sc.w) + sh.w);
      *(uint2*)(p.U + (size_t)row * DM + cidx) = o;
    }
  }
}
DI void norm_all_rows(CPARAMS p, int l, int which, bool from_input) {
  const int gw = bidx_() * 4 + (tidx_() >> 6), nw = VGRID * 4;
  int r = (int)((long)NTOK * gw / nw);
  const int rend = (int)((long)NTOK * (gw + 1) / nw);
  for (; r + 4 <= rend; r += 4) norm_rows<4>(p, l, which, r, from_input);
  for (; r < rend; ++r) norm_rows<1>(p, l, which, r, from_input);
}

#define WC_EARLY (WC_IN + WC_UQ + WC_UKV)
#define WC_LATE (WC_OUT + WC_FF1 + WC_FF2)
DI void phase_norm1(CPARAMS p, int l, unsigned char* smem) {
  for (int it = bidx_(); it < WC_EARLY + WC_LRU; it += VGRID) wconv_item(p, l, it < WC_EARLY ? it : it + WC_LATE, (float*)smem);
  norm_all_rows(p, l, 0, l == 0);
}
DI void phase_norm2(CPARAMS p, int l) { norm_all_rows(p, l, 1, false); }

namespace pg8 {
#define PG8_LAS __attribute__((address_space(3)))
typedef float f32x4 __attribute__((ext_vector_type(4)));
constexpr int BM = 256, BK = 64, HALF = 128, HTB = HALF * BK * 2  , STAGE_BYTES = 8 * HTB;
__device__ __forceinline__ int lds_byte(int r, int c) { const int st = (r >> 4) * 2 + (c >> 5), rr = r & 15, cc = c & 31, ob = rr * 64 + cc * 2; return st * 1024 + (ob ^ (((ob >> 9) & 1) << 5)); }
__device__ __forceinline__ void stage_rc(int b, int& R, int& C) { const int st = b / 1024, sb = b % 1024, swz = sb ^ (((sb >> 9) & 1) << 5); R = (st >> 1) * 16 + swz / 64; C = (st & 1) * 32 + (swz % 64) / 2; }
__device__ __forceinline__ int perm32(int rho) { const int n = rho >> 4, i = rho & 15; return 8 * (i >> 2) + 4 * n + (i & 3); }
struct Unit { int pm, pn, kq; };
struct Gemm { const bf16_t* A; const bf16_t* Bt; int K, ld; };
template <class Epi, class Sched>
__device__ __forceinline__ void gemm_phase(PG8_LAS unsigned char* lds, const Gemm g, const Sched& S, const Epi& E) {
    const int tid = tfull_(), wid = __builtin_amdgcn_readfirstlane(tid >> 6), lane = tid & 63, wr = wid >> 2, wc = wid & 3, fr = lane & 15, fq = lane >> 4;
    const int K = g.ld, nt = g.K / BK;
    unsigned voffA[2], voffB[2];
#pragma unroll
    for (int i = 0; i < 2; ++i) { int R, C; stage_rc(tid * 16 + i * 8192, R, C); const int Rb = Epi::PERM ? ((R & ~31) + perm32(R & 31)) : R;
        voffA[i] = (unsigned)(R * K + C) * 2u; voffB[i] = (unsigned)(Rb * K + C) * 2u; }
    const size_t kstep = (size_t)(BK * 2);
    const size_t hstep = (size_t)HALF * K * 2;
    const size_t tstep = 2 * hstep;
    const unsigned ldsw = (unsigned)wid * 1024u;
    const int aoff = lds_byte(wr * 64 + fr, fq * 8), boff = lds_byte(wc * 32 + fr, fq * 8);
#define PG8_SA(b, h) (((b) * 2 + (h)) * HTB)
#define PG8_SB(b, h) ((4 + (b) * 2 + (h)) * HTB)
#define PG8_STAGE(bufoff, gbase, voff) do { _Pragma("unroll") for (int _i = 0; _i < 2; ++_i) \
        __builtin_amdgcn_global_load_lds((const unsigned*)((const char*)(gbase) + (voff)[_i]), (PG8_LAS unsigned*)(lds + (bufoff) + ldsw + _i * 8192), 16, 0, 0); } while (0)
#define PG8_LDA(dst, b, h) do { _Pragma("unroll") for (int m = 0; m < 4; ++m) _Pragma("unroll") for (int k = 0; k < 2; ++k) dst[m][k] = *(const PG8_LAS bf16x8*)(lds + PG8_SA(b, h) + aoff + m * 2048 + k * 1024); } while (0)
#define PG8_LDB(dst, b, h) do { _Pragma("unroll") for (int n = 0; n < 2; ++n) _Pragma("unroll") for (int k = 0; k < 2; ++k) dst[n][k] = *(const PG8_LAS bf16x8*)(lds + PG8_SB(b, h) + boff + n * 2048 + k * 1024); } while (0)
#define PG8_MMA(ai, bj, At, Bt) do { __builtin_amdgcn_s_setprio(1); _Pragma("unroll") for (int m = 0; m < 4; ++m) _Pragma("unroll") for (int n = 0; n < 2; ++n) _Pragma("unroll") for (int k = 0; k < 2; ++k) \
        acc[ai][bj][m][n] = __builtin_amdgcn_mfma_f32_16x16x32_bf16(Bt[n][k], At[m][k], acc[ai][bj][m][n], 0, 0, 0); __builtin_amdgcn_s_setprio(0); } while (0)
#define PG8_WAIT_V(n) asm volatile("s_waitcnt vmcnt(" #n ")" ::: "memory")
#define PG8_WAIT_L(n) asm volatile("s_waitcnt lgkmcnt(" #n ")" ::: "memory")
#define PG8_BAR __builtin_amdgcn_s_barrier()
#define PG8_SCHED __builtin_amdgcn_sched_barrier(0)
    Unit cur, nxt; int ui = 0;
    if (!S.next(0, cur)) return;
    f32x4 acc[2][2][4][2];
#pragma unroll
    for (int a = 0; a < 2; ++a)
#pragma unroll
        for (int b = 0; b < 2; ++b)
#pragma unroll
            for (int m = 0; m < 4; ++m)
#pragma unroll
                for (int n = 0; n < 2; ++n) acc[a][b][m][n] = (f32x4){0.f, 0.f, 0.f, 0.f};
    bf16x8 At[4][2], B0[2][2], B1[2][2];
    const size_t kqstep = (size_t)g.K * 2;
    const char* cA = (const char*)g.A + (size_t)cur.pm * tstep + (size_t)cur.kq * kqstep; const char* cB = (const char*)g.Bt + (size_t)cur.pn * tstep + (size_t)cur.kq * kqstep;
    S.a_ready(cur);
    PG8_STAGE(PG8_SB(0, 0), cB, voffB); PG8_STAGE(PG8_SA(0, 0), cA, voffA); PG8_STAGE(PG8_SB(0, 1), cB + hstep, voffB); PG8_STAGE(PG8_SA(0, 1), cA + hstep, voffA);
    if (wr == 1) PG8_BAR;
    PG8_WAIT_V(4); PG8_BAR;
    PG8_STAGE(PG8_SB(1, 0), cB + kstep, voffB); PG8_STAGE(PG8_SA(1, 0), cA + kstep, voffA); PG8_STAGE(PG8_SB(1, 1), cB + hstep + kstep, voffB);
    PG8_WAIT_V(6); PG8_BAR;
    for (;;) {
        const bool has_next = S.next(ui + 1, nxt);
        const char* nA = has_next ? (const char*)g.A + (size_t)nxt.pm * tstep + (size_t)nxt.kq * kqstep : cA; const char* nB = has_next ? (const char*)g.Bt + (size_t)nxt.pn * tstep + (size_t)nxt.kq * kqstep : cB;
        for (int t = 0; t < nt; t += 2) {
            const bool last = (t == nt - 2);
            const char* a1 = cA + (size_t)(t + 1) * kstep;
            const char* a2 = last ? nA : cA + (size_t)(t + 2) * kstep; const char* b2 = last ? nB : cB + (size_t)(t + 2) * kstep;
            const char* a3 = a2 + kstep; const char* b3 = b2 + kstep;
            if (last && has_next) S.a_ready(nxt);
            PG8_LDB(B0, 0, 0); PG8_SCHED; PG8_LDA(At, 0, 0); PG8_STAGE(PG8_SA(1, 1), a1 + hstep, voffA);
            PG8_WAIT_L(8); PG8_BAR; PG8_WAIT_L(0); PG8_MMA(0, 0, At, B0); PG8_BAR; PG8_SCHED;
            PG8_LDB(B1, 0, 1); PG8_STAGE(PG8_SB(0, 0), b2, voffB);
            PG8_BAR; PG8_WAIT_L(0); PG8_MMA(0, 1, At, B1); PG8_BAR;
            PG8_LDA(At, 0, 1); PG8_STAGE(PG8_SA(0, 0), a2, voffA);
            PG8_BAR; PG8_WAIT_L(0); PG8_MMA(1, 0, At, B0); PG8_BAR; PG8_SCHED;
            PG8_STAGE(PG8_SB(0, 1), b2 + hstep, voffB);
            PG8_WAIT_V(6); PG8_BAR; PG8_MMA(1, 1, At, B1); PG8_BAR;
            PG8_LDB(B0, 1, 0); PG8_SCHED; PG8_LDA(At, 1, 0); PG8_STAGE(PG8_SA(0, 1), a2 + hstep, voffA);
            PG8_WAIT_L(8); PG8_BAR; PG8_WAIT_L(0); PG8_MMA(0, 0, At, B0); PG8_BAR; PG8_SCHED;
            PG8_LDB(B1, 1, 1); PG8_STAGE(PG8_SB(1, 0), b3, voffB);
            PG8_BAR; PG8_WAIT_L(0); PG8_MMA(0, 1, At, B1); PG8_BAR;
            PG8_LDA(At, 1, 1); PG8_STAGE(PG8_SA(1, 0), a3, voffA);
            PG8_BAR; PG8_WAIT_L(0); PG8_MMA(1, 0, At, B0); PG8_BAR; PG8_SCHED;
            PG8_STAGE(PG8_SB(1, 1), b3 + hstep, voffB);
            PG8_WAIT_V(6); PG8_BAR; PG8_MMA(1, 1, At, B1); PG8_BAR;
        }
            if constexpr (!Epi::AFTER_DRAIN) { E(acc, cur, wr, wc, fr, fq); S.done(cur); }
            if (!has_next) break;
#pragma unroll
        for (int a = 0; a < 2; ++a)
#pragma unroll
            for (int b = 0; b < 2; ++b)
#pragma unroll
                for (int m = 0; m < 4; ++m)
#pragma unroll
                    for (int n = 0; n < 2; ++n) acc[a][b][m][n] = (f32x4){0.f, 0.f, 0.f, 0.f};
        cur = nxt; cA = nA; cB = nB; ++ui;
    }
    PG8_WAIT_V(0);
    if (wr == 0) PG8_BAR;
    PG8_BAR;
    if constexpr (Epi::AFTER_DRAIN) { E.fused(acc, cur, wr, wc, fr, fq, lds, wid, lane); S.done(cur); }
#undef PG8_SA
#undef PG8_SB
#undef PG8_STAGE
#undef PG8_LDA
#undef PG8_LDB
#undef PG8_MMA
#undef PG8_WAIT_V
#undef PG8_WAIT_L
#undef PG8_BAR
#undef PG8_SCHED
}
}

DI int xcd_order() { const int b = rbidx_(), g8 = (int)gridDim.x >> 3; return (b & 7) * g8 + (b >> 3); }

struct UnitOrder {
  int nunits, G, c, mode, nK, skipctx;
  DI bool next(int i, pg8::Unit& u) const {
    const int L = i * G + c;
    if (L >= nunits) return false;
    if (mode == 0) { u.pm = L >> 3; u.pn = L & 7; u.kq = 0; }
    else if (mode == 1) { const int g = L >> 5, j = L & 31; u.pm = (g >> 1) * 4 + (j >> 3); u.pn = (g & 1) * 8 + (j & 7); u.kq = 0; }
    else { u.kq = L % nK; const int t = L / nK; u.pn = t & 3; u.pm = t >> 2; }
    if (skipctx) u.pm += (u.pm >> 4) + 1;
    return true;
  }
  DI void a_ready(const pg8::Unit&) const {}
  DI void done(const pg8::Unit&) const {}
};

struct EpiIn {
  static constexpr bool PERM = true, AFTER_DRAIN = false;
  bf16_t* Z; float* ZGt; const float* gbias;
  DI void operator()(const pg8::f32x4 (&acc)[2][2][4][2], const pg8::Unit& u, int wr, int wc, int fr, int fq) const {
    const int row0 = u.pm * 256 + wr * 64 + fr, col0 = u.pn * 256 + wc * 32 + 8 * fq;
#pragma unroll
    for (int ai = 0; ai < 2; ++ai)
#pragma unroll
      for (int m = 0; m < 4; ++m) {
        const int row = row0 + ai * 128 + m * 16;
        bf16_t* rowp = Z + (size_t)row * ZW + col0;
#pragma unroll
        for (int bj = 0; bj < 2; ++bj) {
          const pg8::f32x4 v0 = acc[ai][bj][m][0], v1 = acc[ai][bj][m][1];
          u32x4 w; w[0] = pack2(v0[0], v0[1]); w[1] = pack2(v0[2], v0[3]); w[2] = pack2(v1[0], v1[1]); w[3] = pack2(v1[2], v1[3]);
          *(u32x4*)(rowp + bj * 128) = w;
          const int c = col0 + bj * 128;
          if (c >= ZG && c < ZG + 16) {
            float* gp = ZGt + (size_t)row * 16 + (c - ZG);
            const float* gb = gbias + (c - ZG);
            *(float4*)gp = make_float4(v0[0] + gb[0], v0[1] + gb[1], v0[2] + gb[2], v0[3] + gb[3]);
            *(float4*)(gp + 4) = make_float4(v1[0] + gb[4], v1[1] + gb[5], v1[2] + gb[6], v1[3] + gb[7]);
          }
        }
      }
  }
};

struct EpiFf1 {
  static constexpr bool PERM = true, AFTER_DRAIN = false;
  bf16_t* H;
  DI void operator()(const pg8::f32x4 (&acc)[2][2][4][2], const pg8::Unit& u, int wr, int wc, int fr, int fq) const {
    const int row0 = u.pm * 256 + wr * 64 + fr, col0 = u.pn * 256 + wc * 32 + 8 * fq;
#pragma unroll
    for (int ai = 0; ai < 2; ++ai)
#pragma unroll
      for (int m = 0; m < 4; ++m) {
        bf16_t* rowp = H + (size_t)(row0 + ai * 128 + m * 16) * DFF + col0;
#pragma unroll
        for (int bj = 0; bj < 2; ++bj) {
          pg8::f32x4 v0 = acc[ai][bj][m][0], v1 = acc[ai][bj][m][1];
#pragma unroll
          for (int j = 0; j < 4; ++j) { const float a = fmaxf(v0[j], 0.f), b = fmaxf(v1[j], 0.f); v0[j] = a * a; v1[j] = b * b; }
          u32x4 w; w[0] = pack2(v0[0], v0[1]); w[1] = pack2(v0[2], v0[3]); w[2] = pack2(v1[0], v1[1]); w[3] = pack2(v1[2], v1[3]);
          *(u32x4*)(rowp + bj * 128) = w;
        }
      }
  }
};

struct EpiResid {
  static constexpr bool PERM = false, AFTER_DRAIN = false;
  float* X; const float* gate_l;
  DI void operator()(const pg8::f32x4 (&acc)[2][2][4][2], const pg8::Unit& u, int wr, int wc, int fr, int fq) const {
    const int row0 = u.pm * 256 + wr * 64 + fr, col0 = u.pn * 256 + wc * 32 + 4 * fq;
    const float* gate = gate_l + (size_t)mod_stream(u.pm * 256) * 6144;
    pg8::f32x4 gv[2][2];
#pragma unroll
    for (int bj = 0; bj < 2; ++bj)
#pragma unroll
      for (int n = 0; n < 2; ++n) gv[bj][n] = *(const pg8::f32x4*)(gate + col0 + bj * 128 + n * 16);
#pragma unroll
    for (int ai = 0; ai < 2; ++ai)
#pragma unroll
      for (int m = 0; m < 4; ++m) {
        float* rowp = X + (size_t)(row0 + ai * 128 + m * 16) * DM + col0;
#pragma unroll
        for (int bj = 0; bj < 2; ++bj)
#pragma unroll
          for (int n = 0; n < 2; ++n) {
            pg8::f32x4* xp = (pg8::f32x4*)(rowp + bj * 128 + n * 16);
            *xp = *xp + gv[bj][n] * acc[ai][bj][m][n];
          }
        asm volatile("" ::: "memory");
      }
  }
};

DI void phase_gemm_in(CPARAMS p, int l, unsigned char* smem, unsigned char* hs) {
  pg8::Gemm g; g.A = p.U; g.Bt = p.Wb_in; g.K = DM; g.ld = DM;
  UnitOrder S; S.nunits = 68 * 8; S.G = (int)gridDim.x; S.c = xcd_order(); S.mode = 0; S.nK = 1; S.skipctx = 0;
  EpiIn E; E.Z = p.Z; E.ZGt = p.ZGt; E.gbias = p.gate_bias + l * 16;
  pg8::gemm_phase((PG8_LAS unsigned char*)smem, g, S, E);
  const int G = (int)gridDim.x, rounds = (544 + G - 1) / G, busy = 544 - (rounds - 1) * G;
  const int nfree = G - busy;
  __syncthreads();
  if (nfree > 0) {
    if (S.c >= busy) {
      const int hv = (S.c - busy) * 2 + hidx_(), nh = nfree * 2;
      for (int it = hv; it < WC_LATE; it += nh) wconv_item(p, l, WC_EARLY + it, (float*)hs);
    }
  } else {
    for (int it = bidx_(); it < WC_LATE; it += VGRID) wconv_item(p, l, WC_EARLY + it, (float*)hs);
  }
}
DI void phase_gemm_ff1(CPARAMS p, int skipctx, unsigned char* smem) {
  pg8::Gemm g; g.A = p.U; g.Bt = p.Wb_ff1; g.K = DM; g.ld = DM;
  UnitOrder S; S.nunits = (skipctx ? 64 : 68) * 16; S.G = (int)gridDim.x; S.c = xcd_order(); S.mode = 1; S.nK = 1; S.skipctx = skipctx;
  EpiFf1 E; E.H = p.H;
  pg8::gemm_phase((PG8_LAS unsigned char*)smem, g, S, E);
}
DI void phase_gemm_resid_left(CPARAMS p, int l, const bf16_t* A, int K, const bf16_t* Wt, int gate_chunk, int first_tile, int ntiles, int skipctx, unsigned char* smem);
DI void phase_gemm_resid(CPARAMS p, int l, const bf16_t* A, int K, const bf16_t* Wt, int gate_chunk, int skipctx, unsigned char* smem) {
  const int G = (int)gridDim.x;
  const int ntiles = skipctx ? 256 : 272;
  const int whole = (ntiles / G) * G;
  pg8::Gemm g; g.A = A; g.Bt = Wt; g.K = K; g.ld = K;
  UnitOrder S; S.nunits = whole; S.G = G; S.c = xcd_order(); S.mode = 2; S.nK = 1; S.skipctx = skipctx;
  EpiResid E; E.X = p.X; E.gate_l = p.MOD + (size_t)l * 5 * 6144 + gate_chunk * 1024;
  pg8::gemm_phase((PG8_LAS unsigned char*)smem, g, S, E);
  __syncthreads();
  phase_gemm_resid_left(p, l, A, K, Wt, gate_chunk, whole, ntiles, skipctx, smem);
}

template <class Epi>
DI void gemm256s(const bf16_t* __restrict__ A, int lda, const bf16_t* __restrict__ B, int ldb, int kt0, int kt1, bf16_t* sm, Epi&& epi) {
  const int tid = tfull_(), lane = tid & 63, w = tid >> 6, wp = w >> 2, wq = w & 3, l32 = lane & 31, hh = lane >> 5;
  bf16_t* sA = sm;
  bf16_t* sB = sm + 2 * 256 * LDT;
  f32x16 acc[4][2];
#pragma unroll
  for (int i = 0; i < 4; ++i)
#pragma unroll
    for (int j = 0; j < 2; ++j) acc[i][j] = zero16();
  const int lrow = tid >> 3, kc = (tid & 7) * 8;
  const bf16_t* gA = A + (size_t)lrow * lda + kc;
  const bf16_t* gB = B + (size_t)lrow * ldb + kc;
  u32x4 ra[4], rb[4];
#pragma unroll
  for (int i = 0; i < 4; ++i) {
    ra[i] = *(const u32x4*)(gA + (size_t)(64 * i) * lda + kt0 * 64);
    rb[i] = *(const u32x4*)(gB + (size_t)(64 * i) * ldb + kt0 * 64);
  }
#pragma unroll
  for (int i = 0; i < 4; ++i) {
    *(u32x4*)(sA + (lrow + 64 * i) * LDT + kc) = ra[i];
    *(u32x4*)(sB + (lrow + 64 * i) * LDT + kc) = rb[i];
  }
  __syncthreads();
#pragma unroll 1
  for (int kt = kt0; kt < kt1; ++kt) {
    const int cur = (kt - kt0) & 1;
    if (kt + 1 < kt1) {
#pragma unroll
      for (int i = 0; i < 4; ++i) {
        ra[i] = *(const u32x4*)(gA + (size_t)(64 * i) * lda + (kt + 1) * 64);
        rb[i] = *(const u32x4*)(gB + (size_t)(64 * i) * ldb + (kt + 1) * 64);
      }
    }
    const bf16_t* cA = sA + cur * 256 * LDT + (128 * wp + l32) * LDT + 8 * hh;
    const bf16_t* cB = sB + cur * 256 * LDT + (64 * wq + l32) * LDT + 8 * hh;
#pragma unroll
    for (int ks = 0; ks < 4; ++ks) {
      const bf16x8 b0 = ldfrag(cB + ks * 16), b1 = ldfrag(cB + 32 * LDT + ks * 16);
#pragma unroll
      for (int mi = 0; mi < 4; ++mi) {
        const bf16x8 a = ldfrag(cA + mi * 32 * LDT + ks * 16);
        acc[mi][0] = mfma(a, b0, acc[mi][0]);
        acc[mi][1] = mfma(a, b1, acc[mi][1]);
      }
    }
    if (kt + 1 < kt1) {
      const int nx = cur ^ 1;
#pragma unroll
      for (int i = 0; i < 4; ++i) {
        *(u32x4*)(sA + nx * 256 * LDT + (lrow + 64 * i) * LDT + kc) = ra[i];
        *(u32x4*)(sB + nx * 256 * LDT + (lrow + 64 * i) * LDT + kc) = rb[i];
      }
    }
    __syncthreads();
  }
  epi(acc);
}

DI void phase_gemm_resid_left(CPARAMS p, int l, const bf16_t* A, int K, const bf16_t* Wt, int gate_chunk, int first_tile, int ntiles, int skipctx, unsigned char* smem) {
  const int tid = tfull_(), lane = tid & 63, w = tid >> 6, wp = w >> 2, wq = w & 3, l32 = lane & 31, hh = lane >> 5;
  const int KT = K >> 6;
  const long total = (long)(ntiles - first_tile) * KT;
  const int vb = xcd_order();
  long u = total * vb / (int)gridDim.x;
  const long uend = total * (vb + 1) / (int)gridDim.x;
  while (u < uend) {
    const int trel = (int)(u / KT), kt0 = (int)(u - (long)trel * KT);
    const int kt1 = (int)((uend - (long)trel * KT) < KT ? (uend - (long)trel * KT) : KT);
    const int tile = first_tile + trel;
    int mt = tile >> 2; const int nt = tile & 3;
    if (skipctx) mt += (mt >> 4) + 1;
    const int s = mod_stream(mt * 256);
    const float* gate = p.MOD + ((size_t)l * 5 + s) * 6144 + gate_chunk * 1024;
    gemm256s(A + (size_t)mt * 256 * K, K, Wt + (size_t)nt * 256 * K, K, kt0, kt1, (bf16_t*)smem, [&](f32x16 (&acc)[4][2]) {
#pragma unroll
      for (int mi = 0; mi < 4; ++mi)
#pragma unroll
        for (int ni = 0; ni < 2; ++ni) {
          const int col = nt * 256 + 64 * wq + 32 * ni + l32;
          const float g = gate[col];
#pragma unroll
          for (int i = 0; i < 16; ++i) {
            const int row = mt * 256 + 128 * wp + 32 * mi + crow(i, hh);
            unsafeAtomicAdd(p.X + (size_t)row * DM + col, g * acc[mi][ni][i]);
          }
        }
    });
    u += kt1 - kt0;
  }
}

DI void mla_krope_item(CPARAMS p, int mt, unsigned char* smem) {
  const int tid = tidx_(), lane = tid & 63, w = tid >> 6, wp = w >> 1, wq = w & 1, l32 = lane & 31, hh = lane >> 5;
  float* rsq = (float*)(smem + 73728);
  float* rskv = rsq + 128;
  const int row0 = mt * 128;
  const int b = row0 / TP, pos0 = row0 - b * TP;
  const bool latent = pos0 >= TC;
  __syncthreads();
  {
    const int tok = tid >> 1, half = tid & 1;
    const bf16_t* zr = p.Z + (size_t)(row0 + tok) * ZW;
    const int pos = pos0 + tok;
    const int t_lat = pos - TC;
    const float coord = half == 0 ? (float)(t_lat >> 6) : (float)(t_lat & 63);
    u32x4 x1v[2], x2v[2], o1v[2], o2v[2];
    x1v[0] = *(const u32x4*)(zr + ZKR + 16 * half); x1v[1] = *(const u32x4*)(zr + ZKR + 16 * half + 8);
    x2v[0] = *(const u32x4*)(zr + ZKR + 32 + 16 * half); x2v[1] = *(const u32x4*)(zr + ZKR + 32 + 16 * half + 8);
#pragma unroll
    for (int q = 0; q < 2; ++q)
#pragma unroll
      for (int jj = 0; jj < 4; ++jj) {
        const unsigned a1 = x1v[q][jj], a2 = x2v[q][jj];
        float cs0 = 1.f, sn0 = 0.f, cs1 = 1.f, sn1 = 0.f;
        if (latent) {
          const int j = 8 * q + 2 * jj;
          const float ang0 = coord * ex2(-(float)j * (13.287712379549449f / 16.f));
          const float ang1 = coord * ex2(-(float)(j + 1) * (13.287712379549449f / 16.f));
          cs0 = __cosf(ang0); sn0 = __sinf(ang0); cs1 = __cosf(ang1); sn1 = __sinf(ang1);
        }
        const float p0 = bflo(a1), p1 = bfhi(a1), r0 = bflo(a2), r1 = bfhi(a2);
        o1v[q][jj] = pack2(p0 * cs0 - r0 * sn0, p1 * cs1 - r1 * sn1);
        o2v[q][jj] = pack2(p0 * sn0 + r0 * cs0, p1 * sn1 + r1 * cs1);
      }
#pragma unroll
    for (int hd = 0; hd < 4; ++hd) {
      bf16_t* kd = p.Kb + ((size_t)(b * 4 + hd) * TP + pos) * 192 + 128 + 16 * half;
      *(u32x4*)(kd) = o1v[0];
      *(u32x4*)(kd + 8) = o1v[1];
      *(u32x4*)(kd + 32) = o2v[0];
      *(u32x4*)(kd + 40) = o2v[1];
    }
  }
  (void)rsq; (void)rskv; (void)wp; (void)wq; (void)l32; (void)hh;
}

DI void mla_q_item(CPARAMS p, int mt, int nt, unsigned char* smem) {
  const int tid = tidx_(), lane = tid & 63, w = tid >> 6, wp = w >> 1, wq = w & 1, l32 = lane & 31, hh = lane >> 5;
  float* rsq = (float*)(smem + 73728);
  float* rskv = rsq + 128;
  const int row0 = mt * 128;
  const int b = row0 / TP, pos0 = row0 - b * TP;
  const bool latent = pos0 >= TC;
  __syncthreads();
  {
    const int tok = tid >> 1, half = tid & 1;
    const bf16_t* zr = p.Z + (size_t)(row0 + tok) * ZW;
    float ss = 0.f;
#pragma unroll
    for (int i = 0; i < 16; ++i) {
      const uint4 u = *(const uint4*)(zr + ZQ + 128 * half + 8 * i);
      float a;
      a = bflo(u.x); ss += a * a; a = bfhi(u.x); ss += a * a; a = bflo(u.y); ss += a * a; a = bfhi(u.y); ss += a * a;
      a = bflo(u.z); ss += a * a; a = bfhi(u.z); ss += a * a; a = bflo(u.w); ss += a * a; a = bfhi(u.w); ss += a * a;
    }
    ss += __shfl_xor(ss, 1, 64);
    if (half == 0) rsq[tok] = rsqrtf(ss * (1.f / 256.f) + EPSF);
  }
  __syncthreads();
  {
    gemm128(p.Z + (size_t)row0 * ZW + ZQ, ZW, p.Wb_uq + (size_t)nt * 128 * 256, 256, 256, (bf16_t*)smem, [&](f32x16 (&acc)[2][2]) {
      {
        const int hd = nt < 4 ? nt : 2 * (nt - 4) + wq;
#pragma unroll
        for (int mi = 0; mi < 2; ++mi)
#pragma unroll
          for (int ni = 0; ni < 2; ++ni) {
            const int d = nt < 4 ? 64 * wq + 32 * ni + l32 : 128 + 32 * ni + l32;
#pragma unroll
            for (int i = 0; i < 16; ++i) {
              const int rl = 64 * wp + 32 * mi + crow(i, hh);
              p.Qb[((size_t)(b * 4 + hd) * TP + pos0 + rl) * 192 + d] = f2bf(acc[mi][ni][i] * rsq[rl] * QSCALE);
            }
          }
      }
    });
  }
  (void)latent; (void)rskv;
}

DI void mla_kv_item(CPARAMS p, int mt, int nt, unsigned char* smem) {
  const int tid = tidx_(), lane = tid & 63, w = tid >> 6, wp = w >> 1, wq = w & 1, l32 = lane & 31, hh = lane >> 5;
  float* rsq = (float*)(smem + 73728);
  float* rskv = rsq + 128;
  const int row0 = mt * 128;
  const int b = row0 / TP, pos0 = row0 - b * TP;
  const bool latent = pos0 >= TC;
  __syncthreads();
  {
    const int tok = tid >> 1, half = tid & 1;
    const bf16_t* zr = p.Z + (size_t)(row0 + tok) * ZW;
    float s2 = 0.f;
#pragma unroll
    for (int i = 0; i < 8; ++i) {
      const uint4 u = *(const uint4*)(zr + ZKV + 64 * half + 8 * i);
      float a;
      a = bflo(u.x); s2 += a * a; a = bfhi(u.x); s2 += a * a; a = bflo(u.y); s2 += a * a; a = bfhi(u.y); s2 += a * a;
      a = bflo(u.z); s2 += a * a; a = bfhi(u.z); s2 += a * a; a = bflo(u.w); s2 += a * a; a = bfhi(u.w); s2 += a * a;
    }
    s2 += __shfl_xor(s2, 1, 64);
    if (half == 0) rskv[tok] = rsqrtf(s2 * (1.f / 128.f) + EPSF);
  }
  __syncthreads();
  {
    gemm128(p.Z + (size_t)row0 * ZW + ZKV, ZW, p.Wb_ukv + (size_t)nt * 128 * 128, 128, 128, (bf16_t*)smem, [&](f32x16 (&acc)[2][2]) {
      if (nt < 4) {
#pragma unroll
        for (int mi = 0; mi < 2; ++mi)
#pragma unroll
          for (int ni = 0; ni < 2; ++ni) {
            const int d = 64 * wq + 32 * ni + l32;
#pragma unroll
            for (int i = 0; i < 16; ++i) {
              const int rl = 64 * wp + 32 * mi + crow(i, hh);
              p.Kb[((size_t)(b * 4 + nt) * TP + pos0 + rl) * 192 + d] = f2bf(acc[mi][ni][i] * rskv[rl]);
            }
          }
      } else {
        const int hd = nt - 4;
#pragma unroll
        for (int mi = 0; mi < 2; ++mi)
#pragma unroll
          for (int ni = 0; ni < 2; ++ni) {
            const int dv = 64 * wq + 32 * ni + l32;
            bf16_t* vd = p.Vt + ((size_t)(b * 4 + hd) * 128 + dv) * TP + pos0;
#pragma unroll
            for (int g = 0; g < 4; ++g) {
              const int rl = 64 * wp + 32 * mi + 8 * g + 4 * hh;
              const int ppos = 64 * wp + 32 * mi + 16 * (g >> 1) + 8 * hh + 4 * (g & 1);
              uint2 o;
              o.x = pack2(acc[mi][ni][4 * g] * rskv[rl], acc[mi][ni][4 * g + 1] * rskv[rl + 1]);
              o.y = pack2(acc[mi][ni][4 * g + 2] * rskv[rl + 2], acc[mi][ni][4 * g + 3] * rskv[rl + 3]);
              *(uint2*)(vd + ppos) = o;
            }
          }
      }
    });
  }
  (void)latent; (void)rsq;
}

DI void attn_item(CPARAMS p, int b, int hd, int q0, int nkt, unsigned char* smem) {
  const int tid = tidx_(), lane = tid & 63, w = tid >> 6, l32 = lane & 31, hh = lane >> 5;
  bf16_t* sK = (bf16_t*)smem;
  bf16_t* sV = sK + 2 * 64 * 200;
  const size_t bh = (size_t)(b * 4 + hd);
  bf16x8 qf[12];
  {
    const bf16_t* Qg = p.Qb + (bh * TP + q0 + 32 * w + l32) * 192 + 8 * hh;
#pragma unroll
    for (int ks = 0; ks < 12; ++ks) qf[ks] = ldfrag(Qg + 16 * ks);
    if (q0 >= TC) {
      const int t_lat = q0 - TC + 32 * w + l32;
#pragma unroll
      for (int kq = 0; kq < 2; ++kq) {
        const float coord = kq == 0 ? (float)(t_lat >> 6) : (float)(t_lat & 63);
        const u32x4 a1 = __builtin_bit_cast(u32x4, qf[8 + kq]), a2 = __builtin_bit_cast(u32x4, qf[10 + kq]);
        u32x4 n1, n2;
#pragma unroll
        for (int jj = 0; jj < 4; ++jj) {
          const int j = 8 * hh + 2 * jj;
          const float ang0 = coord * ex2(-(float)j * (13.287712379549449f / 16.f));
          const float ang1 = coord * ex2(-(float)(j + 1) * (13.287712379549449f / 16.f));
          const float cs0 = __cosf(ang0), sn0 = __sinf(ang0), cs1 = __cosf(ang1), sn1 = __sinf(ang1);
          const float p0 = bflo(a1[jj]), p1 = bfhi(a1[jj]), r0 = bflo(a2[jj]), r1 = bfhi(a2[jj]);
          n1[jj] = pack2(p0 * cs0 - r0 * sn0, p1 * cs1 - r1 * sn1);
          n2[jj] = pack2(p0 * sn0 + r0 * cs0, p1 * sn1 + r1 * cs1);
        }
        qf[8 + kq] = __builtin_bit_cast(bf16x8, n1);
        qf[10 + kq] = __builtin_bit_cast(bf16x8, n2);
      }
    }
  }
  const bf16_t* Kg = p.Kb + bh * TP * 192;
  const bf16_t* Vg = p.Vt + bh * 128 * TP;
  typedef __attribute__((address_space(3))) unsigned lds_u32;
  const int hoff = hidx_();
  const int w8 = __builtin_amdgcn_readfirstlane(w + 4 * hoff);
  lds_u32* sKl = (lds_u32*)sK;
  lds_u32* sVl = (lds_u32*)sV;
#define ATT_LOAD_K(T)                                                                             \
  _Pragma("unroll") for (int i = 0; i < 4; ++i) {                                                 \
    const int ch = w8 + 8 * i;                                                                    \
    if (ch < 25) {                                                                                \
      const int ob = ch * 1024 + lane * 16, row = ob / 400, cb = ob - row * 400;                  \
      const bf16_t* sp = Kg + (size_t)(T) * (64 * 192) + (cb < 384 ? row * 192 + (cb >> 1) : 0);  \
      __builtin_amdgcn_global_load_lds((const unsigned*)sp, sKl + ((T) & 1) * 6400 + ch * 256, 16, 0, 0); \
    }                                                                                             \
  }
#define ATT_LOAD_V(T)                                                                             \
  _Pragma("unroll") for (int i = 0; i < 3; ++i) {                                                 \
    const int ch = w8 + 8 * i;                                                                    \
    if (ch < 18) {                                                                                \
      const int ob = ch * 1024 + lane * 16, row = ob / 144, cb = ob - row * 144;                  \
      const bf16_t* sp = Vg + 64 * (T) + (cb < 128 ? (size_t)row * TP + (cb >> 1) : 0);          \
      __builtin_amdgcn_global_load_lds((const unsigned*)sp, sVl + ((T) & 1) * 4608 + ch * 256, 16, 0, 0); \
    }                                                                                             \
  }
#define ATT_RD1(D, A, OFF) asm volatile("ds_read_b128 %0, %1 offset:%2" : "=v"(D) : "v"(A), "n"(OFF))
#define ATT_RD4(F, A, O0, O1, O2, O3) do { ATT_RD1(F[0], A, O0); ATT_RD1(F[1], A, O1); ATT_RD1(F[2], A, O2); ATT_RD1(F[3], A, O3); } while (0)
#define ATT_RD2(F, A, O0, O1) do { ATT_RD1(F[0], A, O0); ATT_RD1(F[1], A, O1); } while (0)
#define ATT_WAIT2(F, N) asm volatile("s_waitcnt lgkmcnt(%2)" : "+v"(F[0]), "+v"(F[1]) : "n"(N))
#define ATT_WAIT4(F, N) asm volatile("s_waitcnt lgkmcnt(%4)" : "+v"(F[0]), "+v"(F[1]), "+v"(F[2]), "+v"(F[3]) : "n"(N))
  const unsigned kaddr0 = (unsigned)(size_t)(sK + l32 * 200 + 8 * hh);
  const unsigned vaddr0 = (unsigned)(size_t)(sV + l32 * LDT + 8 * hh);
  __syncthreads();
  ATT_LOAD_K(0);
  asm volatile("s_waitcnt vmcnt(0)" ::: "memory");
  for (int i = tfull_(); i < 2 * 18432 / 16; i += 512) ((u32x4*)sV)[i] = (u32x4){0u, 0u, 0u, 0u};
  f32x16 o[4];
#pragma unroll
  for (int i = 0; i < 4; ++i) o[i] = zero16();
  f32x16 sX = zero16(), sY = zero16();
  bf16x8 pX[2], pY[2];
  pX[0] = (bf16x8){0, 0, 0, 0, 0, 0, 0, 0}; pX[1] = pX[0]; pY[0] = pX[0]; pY[1] = pX[0];
  float m = -1e30f, lsum = 0.f;
  __syncthreads();
#define ATT_EXP2(SV, J0, J1) { SV[J0] = ex2(SV[J0] - m); SV[J1] = ex2(SV[J1] - m); ps += SV[J0] + SV[J1]; }
#define ATT_QK(F, G, SO_) { SO_ = mfma(F[0], qf[2 * (G)], SO_); SO_ = mfma(F[1], qf[2 * (G) + 1], SO_); }
#define ATT_PV(F, P_, PI_) { o[2 * ((P_) & 1)] = mfma(F[0], PI_[(P_) >> 1], o[2 * ((P_) & 1)]); o[2 * ((P_) & 1) + 1] = mfma(F[1], PI_[(P_) >> 1], o[2 * ((P_) & 1) + 1]); }
#define ATT_RDK(F, G, KB) ATT_RD2(F, kaddr, (KB) * 12800 + 64 * (G), (KB) * 12800 + 64 * (G) + 32)
#define ATT_RDV(F, P_, KB) ATT_RD2(F, vaddr, 2 * ((P_) & 1) * 4608 + (KB) * 64 + ((P_) >> 1) * 32, (2 * ((P_) & 1) + 1) * 4608 + (KB) * 64 + ((P_) >> 1) * 32)
#define ATT_STEP(J, KB, SI, SO, PI, PO)                                                                           \
  {                                                                                                               \
    const int jj = (J), T = jj >> 1;                                                                              \
    if ((KB) == 0) {                                                                                              \
      if (T + 1 < nkt) { ATT_LOAD_K(T + 1); }                                                                     \
      if (T < nkt) { ATT_LOAD_V(T); }                                                                             \
    }                                                                                                             \
    const unsigned kaddr = kaddr0 + (T & 1) * 25600, vaddr = vaddr0 + ((T + 1) & 1) * 18432;                      \
    const bool valid = jj >= 1 && jj <= 2 * nkt;                                                                  \
    float tmax = SI[0];                                                                                           \
    _Pragma("unroll") for (int q = 1; q < 16; ++q) tmax = fmaxf(tmax, SI[q]);                                     \
    tmax = fmaxf(tmax, xhalf(tmax));                                                                              \
    const bool need = valid && (tmax > m + 8.f);                                                                  \
    const float mn = need ? tmax : m;                                                                             \
    const float alpha = ex2(m - mn);                                                                              \
    m = mn;                                                                                                       \
    float ps = 0.f;                                                                                               \
    SO = zero16();                                                                                                \
    bf16x8 fa[2], fb[2], fc[2];                                                                                   \
    ATT_RDK(fa, 0, KB); ATT_RDK(fb, 1, KB);                                                                       \
    ATT_RDK(fc, 2, KB); ATT_WAIT2(fa, 4); ATT_QK(fa, 0, SO); ATT_EXP2(SI, 0, 1);                                      \
    ATT_RDK(fa, 3, KB); ATT_WAIT2(fb, 4); ATT_QK(fb, 1, SO); ATT_EXP2(SI, 2, 3);                                      \
    ATT_RDK(fb, 4, KB); ATT_WAIT2(fc, 4); ATT_QK(fc, 2, SO); ATT_EXP2(SI, 4, 5);                                      \
    ATT_RDK(fc, 5, KB); ATT_WAIT2(fa, 4); ATT_QK(fa, 3, SO); ATT_EXP2(SI, 6, 7);                                      \
    ATT_RDV(fa, 0, KB); ATT_WAIT2(fb, 4); ATT_QK(fb, 4, SO); ATT_EXP2(SI, 8, 9);                                      \
    ATT_RDV(fb, 1, KB); ATT_WAIT2(fc, 4); ATT_QK(fc, 5, SO); ATT_EXP2(SI, 10, 11);                                    \
    ATT_RDV(fc, 2, KB); ATT_WAIT2(fa, 4); ATT_PV(fa, 0, PI); ATT_EXP2(SI, 12, 13);                                    \
    ATT_RDV(fa, 3, KB); ATT_WAIT2(fb, 4); ATT_PV(fb, 1, PI); ATT_EXP2(SI, 14, 15);                                    \
    ATT_WAIT2(fc, 2); ATT_PV(fc, 2, PI);                                                                              \
    if (valid) {                                                                                                  \
      PO[0] = pack8(SI[0], SI[1], SI[2], SI[3], SI[4], SI[5], SI[6], SI[7]);                                      \
      PO[1] = pack8(SI[8], SI[9], SI[10], SI[11], SI[12], SI[13], SI[14], SI[15]);                                \
      lsum = lsum * alpha + ps;                                                                                   \
    }                                                                                                             \
    ATT_WAIT2(fa, 0); ATT_PV(fa, 3, PI);                                                                              \
    if (__builtin_amdgcn_ballot_w64(need) != 0ull) {                                                              \
      _Pragma("unroll") for (int dt = 0; dt < 4; ++dt)                                                            \
        _Pragma("unroll") for (int q = 0; q < 16; ++q) o[dt][q] *= alpha;                                         \
    }                                                                                                             \
    if ((KB) == 1) {                                                                                              \
      asm volatile("s_waitcnt vmcnt(0)" ::: "memory");                                                            \
      __syncthreads();                                                                                            \
    }                                                                                                             \
  }
#pragma unroll 1
  for (int j = 0; j <= 2 * nkt; j += 2) {
    ATT_STEP(j, 0, sX, sY, pX, pY);
    ATT_STEP(j + 1, 1, sY, sX, pY, pX);
  }
#undef ATT_STEP
#undef ATT_EXP2
#undef ATT_QK
#undef ATT_PV
#undef ATT_RDK
#undef ATT_RDV
#undef ATT_LOAD_K
#undef ATT_LOAD_V
#undef ATT_RD1
#undef ATT_RD4
#undef ATT_RD2
#undef ATT_WAIT2
#undef ATT_WAIT4
  lsum += xhalf(lsum);
  const float inv = 1.f / lsum;
  bf16_t* od = p.U + ((size_t)b * TP + q0 + 32 * w + l32) * DM + hd * 128 + 4 * hh;
#pragma unroll
  for (int dt = 0; dt < 4; ++dt)
#pragma unroll
    for (int g = 0; g < 4; ++g) {
      uint2 u;
      u.x = pack2(o[dt][4 * g] * inv, o[dt][4 * g + 1] * inv);
      u.y = pack2(o[dt][4 * g + 2] * inv, o[dt][4 * g + 3] * inv);
      *(uint2*)(od + 32 * dt + 8 * g) = u;
    }
}

DI float masked_sum128(const float* v, int lo, int hi, float& total) {
  float acc = 0.f, tot = 0.f;
#pragma unroll 8
  for (int u4 = 0; u4 < 32; ++u4) {
    const float4 x = *(const float4*)(v + 4 * u4);
    const int u = 4 * u4;
    tot += (x.x + x.y) + (x.z + x.w);
    acc += ((u >= lo && u <= hi) ? x.x : 0.f) + ((u + 1 >= lo && u + 1 <= hi) ? x.y : 0.f)
         + ((u + 2 >= lo && u + 2 <= hi) ? x.z : 0.f) + ((u + 3 >= lo && u + 3 <= hi) ? x.w : 0.f);
  }
  total = tot;
  return acc;
}
DI float masked_max128(const float* v, int lo, int hi) {
  float acc = -1e30f;
#pragma unroll 8
  for (int u4 = 0; u4 < 32; ++u4) {
    const float4 x = *(const float4*)(v + 4 * u4);
    const int u = 4 * u4;
    acc = fmaxf(acc, fmaxf(fmaxf((u >= lo && u <= hi) ? x.x : -1e30f, (u + 1 >= lo && u + 1 <= hi) ? x.y : -1e30f),
                           fmaxf((u + 2 >= lo && u + 2 <= hi) ? x.z : -1e30f, (u + 3 >= lo && u + 3 <= hi) ? x.w : -1e30f)));
  }
  return acc;
}
DI float log_sigmoid_(float x) { return fminf(x, 0.f) - log1pf(fexp(-fabsf(x))); }

DI void mlstm_local_item(CPARAMS p, int bh, int ck, unsigned char* smem) {
  const int tid = tidx_(), lane = tid & 63, w = tid >> 6, l32 = lane & 31, hh = lane >> 5;
  const int b = bh >> 2, hd = bh & 3;
  bf16_t* sKt = (bf16_t*)smem;
  bf16_t* sVf = sKt + 64 * 136;
  bf16_t* sVb = sVf + 64 * 136;
  float* slf = (float*)(sVb + 64 * 136);
  float* sg = slf + 256;
  float* sw = sg + 256;
  float* snp = sw + 256;
  const int row0 = b * TP + ck * 128;
  const int dir = tid >> 7, tok = tid & 127;
  __syncthreads();
  const float* zg = p.ZGt + (size_t)(row0 + tok) * 16;
  const float ipre = zg[dir * 8 + hd];
  slf[dir * 128 + tok] = log_sigmoid_(zg[dir * 8 + 4 + hd]);
  __syncthreads();
  const int plo = dir == 0 ? 0 : tok, phi = dir == 0 ? tok : 127;
  float tot;
  const float bc = masked_sum128(slf + dir * 128, plo, phi, tot);
  const float g = tot - bc + ipre;
  sg[dir * 128 + tok] = g;
  __syncthreads();
  const float mloc = masked_max128(sg + dir * 128, 0, 127);
  sw[dir * 128 + tok] = fexp(g - mloc);
  __syncthreads();
#pragma unroll
  for (int i = 0; i < 4; ++i) {
    const int c = tid + 256 * i, tk = c >> 3, f8 = (c & 7) * 8;
    const bf16_t* zr = p.Z + (size_t)(row0 + tk) * ZW + 64 * hd + f8;
    const uint4 ku = *(const uint4*)(zr + ZMK);
    const uint4 vu = *(const uint4*)(zr + ZMV);
    const unsigned kk[4] = {ku.x, ku.y, ku.z, ku.w}, vv[4] = {vu.x, vu.y, vu.z, vu.w};
    const float wf = sw[tk], wb = sw[128 + tk];
#pragma unroll
    for (int e = 0; e < 4; ++e) {
      sKt[(f8 + 2 * e) * 136 + tk] = (bf16_t)(kk[e] & 0xffffu);
      sKt[(f8 + 2 * e + 1) * 136 + tk] = (bf16_t)(kk[e] >> 16);
      const float v0 = bflo(vv[e]), v1 = bfhi(vv[e]);
      sVf[(f8 + 2 * e) * 136 + tk] = f2bf(v0 * wf);
      sVf[(f8 + 2 * e + 1) * 136 + tk] = f2bf(v1 * wf);
      sVb[(f8 + 2 * e) * 136 + tk] = f2bf(v0 * wb);
      sVb[(f8 + 2 * e + 1) * 136 + tk] = f2bf(v1 * wb);
    }
  }
  __syncthreads();
  const int mi = w >> 1, ni = w & 1;
#pragma unroll
  for (int d = 0; d < 2; ++d) {
    const bf16_t* sV = d ? sVb : sVf;
    f32x16 acc = zero16();
#pragma unroll
    for (int ks = 0; ks < 8; ++ks)
      acc = mfma(ldfrag(sV + (32 * mi + l32) * 136 + 16 * ks + 8 * hh), ldfrag(sKt + (32 * ni + l32) * 136 + 16 * ks + 8 * hh), acc);
    float* rec = p.CST + ((size_t)(bh * 34 + ck) * 2 + d) * CREC;
#pragma unroll
    for (int i = 0; i < 16; ++i) rec[(32 * mi + crow(i, hh)) * 64 + 32 * ni + l32] = acc[i];
  }
  {
    const int dk = tid & 63, part = tid >> 6;
    float nf = 0.f, nb = 0.f;
    for (int s = part * 32; s < part * 32 + 32; ++s) {
      const float kv = bf2f(sKt[dk * 136 + s]);
      nf += sw[s] * kv; nb += sw[128 + s] * kv;
    }
    snp[(part * 2 + 0) * 64 + dk] = nf;
    snp[(part * 2 + 1) * 64 + dk] = nb;
  }
  __syncthreads();
  if (tid < 128) {
    const int d = tid >> 6, dk = tid & 63;
    float* rec = p.CST + ((size_t)(bh * 34 + ck) * 2 + d) * CREC;
    rec[4096 + dk] = snp[(0 * 2 + d) * 64 + dk] + snp[(1 * 2 + d) * 64 + dk] + snp[(2 * 2 + d) * 64 + dk] + snp[(3 * 2 + d) * 64 + dk];
  }
  if (tok == 0) {
    float* rec = p.CST + ((size_t)(bh * 34 + ck) * 2 + dir) * CREC;
    rec[4160] = mloc;
    rec[4161] = tot;
  }
}

DI void phase_mlstm_scan(CPARAMS p) {
  const int total = 32 * 4096;
  for (int idx = bidx_() * 256 + tidx_(); idx < total; idx += VGRID * 256) {
    const int combo = idx >> 12, e = idx & 4095;
    const int bh = combo >> 1, d = combo & 1;
    const bool has2 = e < 64;
    const int e2 = has2 ? 4096 + e : e;
    float* base = p.CST + ((size_t)(bh * 34) * 2 + d) * CREC;
    float loc[34], loc2[34], mloc[34], tot[34];
#pragma unroll
    for (int ck = 0; ck < 34; ++ck) {
      const float* rec = base + (size_t)ck * 2 * CREC;
      loc[ck] = rec[e]; loc2[ck] = rec[e2]; mloc[ck] = rec[4160]; tot[ck] = rec[4161];
    }
    float st = 0.f, st2 = 0.f, m = 0.f;
#pragma unroll
    for (int step = 0; step < 34; ++step) {
      const int ck = d == 0 ? step : (step < 2 ? 1 - step : 35 - step);
      float* rec = base + (size_t)ck * 2 * CREC;
      rec[e] = st;
      if (has2) rec[e2] = st2;
      if (e == 0) rec[4162] = m;
      const float mn = fmaxf(tot[ck] + m, mloc[ck]);
      const float wo = fexp(tot[ck] + m - mn), wl = fexp(mloc[ck] - mn);
      st = wo * st + wl * loc[ck];
      st2 = wo * st2 + wl * loc2[ck];
      m = mn;
    }
  }
}

DI void mlstm_out_item(CPARAMS p, int bh, int ck, unsigned char* smem) {
  const int tid = tidx_(), lane = tid & 63, w = tid >> 6, l32 = lane & 31, hh = lane >> 5;
  const int b = bh >> 2, hd = bh & 3;
  bf16_t* sK = (bf16_t*)smem;
  bf16_t* sVt = sK + 128 * LDT;
  bf16_t* sC = sVt + 64 * 136;
  float* slf = (float*)(sC + 2 * 64 * LDT);
  float* sb = slf + 256;
  float* se = sb + 256;
  float* sM = se + 256;
  float* sn = sM + 256;
  const int row0 = b * TP + ck * 128;
  const float* rec0 = p.CST + ((size_t)(bh * 34 + ck) * 2) * CREC;
  __syncthreads();
  {
    const int dir = tid >> 7, tok = tid & 127;
    const float* zg = p.ZGt + (size_t)(row0 + tok) * 16;
    const float ipre = zg[dir * 8 + hd];
    slf[dir * 128 + tok] = log_sigmoid_(zg[dir * 8 + 4 + hd]);
#pragma unroll
    for (int i = 0; i < 4; ++i) {
      const int c = tid + 256 * i, tk = c >> 3, f8 = (c & 7) * 8;
      const bf16_t* zr = p.Z + (size_t)(row0 + tk) * ZW + 64 * hd + f8;
      *(uint4*)(sK + tk * LDT + f8) = *(const uint4*)(zr + ZMK);
      const uint4 vu = *(const uint4*)(zr + ZMV);
      const unsigned vv[4] = {vu.x, vu.y, vu.z, vu.w};
      const int pk = permk(tk);
#pragma unroll
      for (int e = 0; e < 4; ++e) {
        sVt[(f8 + 2 * e) * 136 + pk] = (bf16_t)(vv[e] & 0xffffu);
        sVt[(f8 + 2 * e + 1) * 136 + pk] = (bf16_t)(vv[e] >> 16);
      }
    }
#pragma unroll
    for (int d = 0; d < 2; ++d) {
      const int dv = tid >> 2, dk0 = (tid & 3) * 16;
      const float* src = rec0 + (size_t)d * CREC + dv * 64 + dk0;
      const float4 f0 = *(const float4*)(src), f1 = *(const float4*)(src + 4), f2 = *(const float4*)(src + 8), f3 = *(const float4*)(src + 12);
      bf16_t* dd = sC + d * 64 * LDT + dv * LDT + dk0;
      *(uint4*)dd = make_uint4(pack2(f0.x, f0.y), pack2(f0.z, f0.w), pack2(f1.x, f1.y), pack2(f1.z, f1.w));
      *(uint4*)(dd + 8) = make_uint4(pack2(f2.x, f2.y), pack2(f2.z, f2.w), pack2(f3.x, f3.y), pack2(f3.z, f3.w));
    }
    if (tid < 128) sn[tid] = rec0[(size_t)(tid >> 6) * CREC + 4096 + (tid & 63)];
    __syncthreads();
    const int plo = dir == 0 ? 0 : tok, phi = dir == 0 ? tok : 127;
    float tot_unused;
    const float bc = masked_sum128(slf + dir * 128, plo, phi, tot_unused);
    sb[dir * 128 + tok] = bc;
    se[dir * 128 + tok] = ipre - bc;
    __syncthreads();
    const float cm = masked_max128(se + dir * 128, plo, phi);
    const float mprev = rec0[(size_t)dir * CREC + 4162];
    sM[dir * 128 + tok] = fmaxf(mprev, cm);
    __syncthreads();
  }
  const int tq = 32 * w + l32;
  bf16x8 qf[4];
  {
    const bf16_t* qg = p.Z + (size_t)(row0 + tq) * ZW + ZMQ + 64 * hd + 8 * hh;
#pragma unroll
    for (int ks = 0; ks < 4; ++ks) qf[ks] = ldfrag(qg + 16 * ks);
  }
  f32x16 hs[2];
  hs[0] = zero16(); hs[1] = zero16();
#pragma unroll
  for (int d = 0; d < 2; ++d) {
    const float mprev = rec0[(size_t)d * CREC + 4162];
    const float Mt = sM[d * 128 + tq], bt = sb[d * 128 + tq];
    const float winter = fexp(mprev - Mt) * 0.125f;
    float qn = 0.f;
#pragma unroll
    for (int ks = 0; ks < 4; ++ks) {
      const uint4 qu = __builtin_bit_cast(uint4, qf[ks]);
      const float* nn = sn + d * 64 + 16 * ks + 8 * hh;
      qn += bflo(qu.x) * nn[0] + bfhi(qu.x) * nn[1] + bflo(qu.y) * nn[2] + bfhi(qu.y) * nn[3]
          + bflo(qu.z) * nn[4] + bfhi(qu.z) * nn[5] + bflo(qu.w) * nn[6] + bfhi(qu.w) * nn[7];
    }
    qn += xhalf(qn);
    f32x16 num[2];
#pragma unroll
    for (int dt = 0; dt < 2; ++dt) {
      f32x16 a = zero16();
#pragma unroll
      for (int ks = 0; ks < 4; ++ks) a = mfma(ldfrag(sC + d * 64 * LDT + (32 * dt + l32) * LDT + 16 * ks + 8 * hh), qf[ks], a);
#pragma unroll
      for (int i = 0; i < 16; ++i) a[i] *= winter;
      num[dt] = a;
    }
    float den = 0.f;
#pragma unroll
    for (int kb = 0; kb < 4; ++kb) {
      const bool active = d == 0 ? (kb <= w) : (kb >= w);
      if (active) {
        f32x16 s = zero16();
#pragma unroll
        for (int ks = 0; ks < 4; ++ks) s = mfma(ldfrag(sK + (32 * kb + l32) * LDT + 16 * ks + 8 * hh), qf[ks], s);
#pragma unroll
        for (int g = 0; g < 4; ++g) {
          const float4 e4 = *(const float4*)(se + d * 128 + 32 * kb + 8 * g + 4 * hh);
          const float ee[4] = {e4.x, e4.y, e4.z, e4.w};
#pragma unroll
          for (int j = 0; j < 4; ++j) {
            const int sidx = 32 * kb + 8 * g + 4 * hh + j;
            const bool ok = d == 0 ? (sidx <= tq) : (sidx >= tq);
            const float arg = ok ? (ee[j] - Mt) : -1e30f;
            const float pv = s[4 * g + j] * (0.125f * fexp(arg));
            s[4 * g + j] = pv;
            den += pv;
          }
        }
#pragma unroll
        for (int s2 = 0; s2 < 2; ++s2) {
          const bf16x8 pb = pack8(s[8 * s2], s[8 * s2 + 1], s[8 * s2 + 2], s[8 * s2 + 3], s[8 * s2 + 4], s[8 * s2 + 5], s[8 * s2 + 6], s[8 * s2 + 7]);
#pragma unroll
          for (int dt = 0; dt < 2; ++dt) num[dt] = mfma(ldfrag(sVt + (32 * dt + l32) * 136 + 32 * kb + 16 * s2 + 8 * hh), pb, num[dt]);
        }
      }
    }
    den += xhalf(den);
    den += winter * qn;
    const float dn = fmaxf(fabsf(den), fexp(-(bt + Mt)));
    const float inv = 1.f / dn;
#pragma unroll
    for (int dt = 0; dt < 2; ++dt)
#pragma unroll
      for (int i = 0; i < 16; ++i) hs[dt][i] += num[dt][i] * inv;
  }
  float ss = 0.f;
#pragma unroll
  for (int dt = 0; dt < 2; ++dt)
#pragma unroll
    for (int i = 0; i < 16; ++i) ss += hs[dt][i] * hs[dt][i];
  ss += xhalf(ss);
  const float rs = rsqrtf(ss * (1.f / 64.f) + EPSF);
  const bf16_t* og = p.Z + (size_t)(row0 + tq) * ZW + ZMO + 64 * hd + 4 * hh;
  bf16_t* od = p.U + (size_t)(row0 + tq) * DM + 512 + 64 * hd + 4 * hh;
#pragma unroll
  for (int dt = 0; dt < 2; ++dt)
#pragma unroll
    for (int g = 0; g < 4; ++g) {
      const uint2 ou = *(const uint2*)(og + 32 * dt + 8 * g);
      uint2 r;
      r.x = pack2(sigmoidf_(bflo(ou.x)) * hs[dt][4 * g] * rs, sigmoidf_(bfhi(ou.x)) * hs[dt][4 * g + 1] * rs);
      r.y = pack2(sigmoidf_(bflo(ou.y)) * hs[dt][4 * g + 2] * rs, sigmoidf_(bfhi(ou.y)) * hs[dt][4 * g + 3] * rs);
      *(uint2*)(od + 32 * dt + 8 * g) = r;
    }
}

DI void lru_local_item(CPARAMS p, int l, int mt, int gd0, unsigned char* smem) {
  const int tid = tidx_(), lane = tid & 63, w = tid >> 6, l32 = lane & 31, hh = lane >> 5;
  bf16_t* sX = (bf16_t*)smem;
  bf16_t* sW = sX + 128 * LDT;
  float* sAa = (float*)smem;
  float* sUu = sAa + 128 * 64;
  const int row0 = mt * 128;
  const int b = row0 / TP, pos0 = row0 - b * TP;
  const int seg_lo = pos0 < TC ? 0 : TC, seg_hi = pos0 < TC ? TC : TP;
  {
    const int gd = gd0;
    const int g = gd >> 1, d = gd & 1;
    __syncthreads();
    {
      const int c8 = (tid & 7) * 8, ch0 = 64 * g + c8;
      float cw[4][8], cb[8];
#pragma unroll
      for (int e = 0; e < 8; ++e) {
        cb[e] = p.conv_b[l * 256 + ch0 + e];
#pragma unroll
        for (int j = 0; j < 4; ++j) cw[j][e] = p.conv_w[(l * 4 + j) * 256 + ch0 + e];
      }
#pragma unroll
      for (int i = 0; i < 4; ++i) {
        const int tk = (tid >> 3) + 32 * i;
        float a[8];
#pragma unroll
        for (int e = 0; e < 8; ++e) a[e] = cb[e];
#pragma unroll
        for (int j = 0; j < 4; ++j) {
          const int ps = pos0 + tk + j - 2;
          const bool inr = ps >= seg_lo && ps < seg_hi;
          const int psc = inr ? ps : pos0 + tk;
          u32x4 u = *(const u32x4*)(p.Z + (size_t)(b * TP + psc) * ZW + ZLX + ch0);
          u[0] = inr ? u[0] : 0u; u[1] = inr ? u[1] : 0u; u[2] = inr ? u[2] : 0u; u[3] = inr ? u[3] : 0u;
          a[0] += bflo(u[0]) * cw[j][0]; a[1] += bfhi(u[0]) * cw[j][1]; a[2] += bflo(u[1]) * cw[j][2]; a[3] += bfhi(u[1]) * cw[j][3];
          a[4] += bflo(u[2]) * cw[j][4]; a[5] += bfhi(u[2]) * cw[j][5]; a[6] += bflo(u[3]) * cw[j][6]; a[7] += bfhi(u[3]) * cw[j][7];
        }
        u32x4 o;
        o[0] = pack2(a[0], a[1]); o[1] = pack2(a[2], a[3]); o[2] = pack2(a[4], a[5]); o[3] = pack2(a[6], a[7]);
        *(u32x4*)(sX + tk * LDT + c8) = o;
        {
          float* xg = p.XS + (size_t)(row0 + tk) * 256 + ch0;
          *(float4*)xg = make_float4(a[0], a[1], a[2], a[3]);
          *(float4*)(xg + 4) = make_float4(a[4], a[5], a[6], a[7]);
        }
      }
#pragma unroll
      for (int i = 0; i < 4; ++i) {
        const int c = tid + 256 * i, r = c >> 3, k8 = (c & 7) * 8;
        *(u32x4*)(sW + r * LDT + k8) = *(const u32x4*)(p.Wb_lru + (size_t)(g * 256 + d * 128 + r) * 64 + k8);
      }
    }
    __syncthreads();
    f32x16 acc[4];
#pragma unroll
    for (int nt = 0; nt < 4; ++nt) acc[nt] = zero16();
#pragma unroll
    for (int ks = 0; ks < 4; ++ks) {
      const bf16x8 a = ldfrag(sX + (32 * w + l32) * LDT + 16 * ks + 8 * hh);
#pragma unroll
      for (int nt = 0; nt < 4; ++nt) acc[nt] = mfma(a, ldfrag(sW + (32 * nt + l32) * LDT + 16 * ks + 8 * hh), acc[nt]);
    }
    __syncthreads();
#pragma unroll
    for (int pt = 0; pt < 2; ++pt) {
      const int chl = 32 * pt + l32, ch = 64 * g + chl;
      const float ba = p.b_a[(l * 2 + d) * 256 + ch], bx = p.b_x[(l * 2 + d) * 256 + ch];
      const float lm = p.lam[(l * 2 + d) * 256 + ch];
      const float spl = fmaxf(-lm, 0.f) + log1pf(fexp(-fabsf(lm)));
#pragma unroll
      for (int i = 0; i < 16; ++i) {
        const int tk = 32 * w + crow(i, hh);
        const float r = sigmoidf_(acc[pt][i] + ba), ig = sigmoidf_(acc[2 + pt][i] + bx);
        const float la = -8.f * r * spl;
        const float a = fexp(la);
        const float u = sqrtf(-expm1f(2.f * la)) * ig * p.XS[(size_t)(row0 + tk) * 256 + ch];
        sAa[tk * 64 + chl] = a;
        sUu[tk * 64 + chl] = u;
      }
    }
    __syncthreads();
    const int chl = tid & 63, sg = tid >> 6;
    {
      float P = 1.f, hv = 0.f;
      float av[32], uv[32];
#pragma unroll
      for (int s = 0; s < 32; ++s) {
        const int tk = d == 0 ? 32 * sg + s : 32 * sg + 31 - s;
        av[s] = sAa[tk * 64 + chl]; uv[s] = sUu[tk * 64 + chl];
      }
#pragma unroll
      for (int s = 0; s < 32; ++s) {
        hv = av[s] * hv + uv[s]; P *= av[s];
        av[s] = P; uv[s] = hv;
      }
#pragma unroll
      for (int s = 0; s < 32; ++s) {
        const int tk = d == 0 ? 32 * sg + s : 32 * sg + 31 - s;
        sAa[tk * 64 + chl] = av[s]; sUu[tk * 64 + chl] = uv[s];
      }
    }
    __syncthreads();
    {
      float cP = 1.f, cH = 0.f;
#pragma unroll
      for (int q = 0; q < 4; ++q) {
        const int sq = d == 0 ? q : 3 - q;
        const bool before = d == 0 ? (sq < sg) : (sq > sg);
        const int tl = d == 0 ? 32 * sq + 31 : 32 * sq;
        const float Pr = sAa[tl * 64 + chl], Hr = sUu[tl * 64 + chl];
        const float Pq = before ? Pr : 1.f, Hq = before ? Hr : 0.f;
        cH = Pq * cH + Hq; cP *= Pq;
      }
      bf16_t* auH = p.AU + ((size_t)(d * 2 + 0) * NTOK + row0) * 256 + 64 * g + chl;
      bf16_t* auP = p.AU + ((size_t)(d * 2 + 1) * NTOK + row0) * 256 + 64 * g + chl;
      float Pl = 1.f, Hl = 0.f;
#pragma unroll
      for (int s = 0; s < 32; ++s) {
        const int tk = d == 0 ? 32 * sg + s : 32 * sg + 31 - s;
        const float pa = sAa[tk * 64 + chl], hu = sUu[tk * 64 + chl];
        Pl = pa * cP;
        Hl = hu + pa * cH;
        auH[(size_t)tk * 256] = f2bf(Hl);
        auP[(size_t)tk * 256] = f2bf(Pl);
      }
      const bool lastseg = d == 0 ? (sg == 3) : (sg == 0);
      if (lastseg) {
        float* ag = p.AGG + ((size_t)(mt * 2 + d) * 2) * 256 + 64 * g + chl;
        ag[0] = Pl; ag[256] = Hl;
      }
    }
  }
}

DI float gelu_tanh_(float x) {
  const float y = 0.7978845608028654f * (x + 0.044715f * x * x * x);
  const float t = 1.f - 2.f / (fexp(2.f * y) + 1.f);
  return 0.5f * x * (1.f + t);
}

DI void lru_out_item(CPARAMS p, int mt, unsigned char* smem) {
  const int tid = tidx_();
  float* scf = (float*)smem;
  float* scb = scf + 256;
  const int row0 = mt * 128;
  const int b = row0 / TP;
  const int tl = mt - b * 34;
  __syncthreads();
  {
    const int ch = tid;
    float cf = 0.f, cb = 0.f;
    {
      float av[34], hv[34];
#pragma unroll
      for (int j = 0; j < 34; ++j) {
        const float* ag = p.AGG + ((size_t)((b * 34 + j) * 2 + 0) * 2) * 256 + ch;
        av[j] = ag[0]; hv[j] = ag[256];
      }
#pragma unroll
      for (int j = 0; j < 34; ++j) asm volatile("" : "+v"(av[j]), "+v"(hv[j]));
#pragma unroll
      for (int j = 0; j < 34; ++j) {
        const float ae = j < tl ? av[j] : 1.f, he = j < tl ? hv[j] : 0.f;
        cf = ae * cf + he;
      }
    }
    {
      float av[34], hv[34];
#pragma unroll
      for (int j = 0; j < 34; ++j) {
        const float* ag = p.AGG + ((size_t)((b * 34 + j) * 2 + 1) * 2) * 256 + ch;
        av[j] = ag[0]; hv[j] = ag[256];
      }
#pragma unroll
      for (int j = 0; j < 34; ++j) asm volatile("" : "+v"(av[j]), "+v"(hv[j]));
#pragma unroll
      for (int step = 0; step < 34; ++step) {
        const int j = step < 2 ? 1 - step : 35 - step;
        const bool before = tl < 2 ? (j < 2 && j > tl) : (j < 2 || j > tl);
        const float ae = before ? av[j] : 1.f, he = before ? hv[j] : 0.f;
        cb = ae * cb + he;
      }
    }
    scf[ch] = cf; scb[ch] = cb;
  }
  __syncthreads();
  const int c8 = (tid & 31) * 8;
  float cf[8], cb[8];
#pragma unroll
  for (int e = 0; e < 8; ++e) { cf[e] = scf[c8 + e]; cb[e] = scb[c8 + e]; }
#pragma unroll 4
  for (int i = 0; i < 16; ++i) {
    const int t = (tid >> 5) + 8 * i;
    const size_t ro = (size_t)(row0 + t) * 256 + c8;
    const u32x4 hf = *(const u32x4*)(p.AU + (size_t)0 * NTOK * 256 + ro);
    const u32x4 pf = *(const u32x4*)(p.AU + (size_t)1 * NTOK * 256 + ro);
    const u32x4 hb = *(const u32x4*)(p.AU + (size_t)2 * NTOK * 256 + ro);
    const u32x4 pb = *(const u32x4*)(p.AU + (size_t)3 * NTOK * 256 + ro);
    const u32x4 gz = *(const u32x4*)(p.Z + (size_t)(row0 + t) * ZW + ZLG + c8);
    u32x4 o;
#pragma unroll
    for (int q = 0; q < 4; ++q) {
      const float h0 = bflo(hf[q]) + bflo(pf[q]) * cf[2 * q] + bflo(hb[q]) + bflo(pb[q]) * cb[2 * q];
      const float h1 = bfhi(hf[q]) + bfhi(pf[q]) * cf[2 * q + 1] + bfhi(hb[q]) + bfhi(pb[q]) * cb[2 * q + 1];
      o[q] = pack2(gelu_tanh_(bflo(gz[q])) * h0, gelu_tanh_(bfhi(gz[q])) * h1);
    }
    *(u32x4*)(p.U + (size_t)(row0 + t) * DM + 768 + c8) = o;
  }
}

DI int next_item(unsigned* ctr, unsigned char* smem_full) {
  int* slot = (int*)(smem_full + 163808);
  __syncthreads();
  if (tfull_() == 0) *slot = (int)atomicAdd(ctr, 2u);
  __syncthreads();
  return *slot + hidx_();
}
DI void phase_prep(CPARAMS p, int l, unsigned char* smem, unsigned char* smem_full) {
  unsigned* ctr = p.CTR + 2 * l;
  for (;;) {
    int it = next_item(ctr, smem_full);
    if (it >= 1088 + 544 + 816 + 1088 + 136) break;
    if (it < 1088) { lru_local_item(p, l, it >> 3, it & 7, smem); continue; }
    it -= 1088;
    if (it < 544) { mlstm_local_item(p, it / 34, it % 34, smem); continue; }
    it -= 544;
    if (it < 816) { const int qmt = it / 6; if (l < NLAYER - 1 || (qmt % 34) >= 2) mla_q_item(p, qmt, it % 6, smem); continue; }
    it -= 816;
    if (it < 1088) { mla_kv_item(p, it >> 3, it & 7, smem); continue; }
    it -= 1088;
    mla_krope_item(p, it, smem);
  }
}
DI void phase_mix(CPARAMS p, int l, unsigned char* smem, unsigned char* smem_full) {
  for (int a = bidx_(); a < 512; a += VGRID) {
    const int rb = a >> 1, x = rb & 7, j = ((rb >> 3) << 1) | (a & 1);
    const int bh = 2 * x + (j >> 5), qt = j & 31;
    attn_item(p, bh >> 2, bh & 3, TC + 128 * qt, 68, smem_full);
  }
  unsigned* ctr = p.CTR + 2 * l + 1;
  if (l == NLAYER - 1) {
    for (;;) {
      const int it = next_item(ctr, smem_full);
      if (it >= 512 + 128) break;
      if (it < 512) mlstm_out_item(p, it >> 5, 2 + (it & 31), smem);
      else { const int t = it - 512; lru_out_item(p, (t >> 5) * 34 + 2 + (t & 31), smem); }
    }
    return;
  }
  for (;;) {
    const int it = next_item(ctr, smem_full);
    if (it >= 32 + 544 + 136) break;
    if (it < 32) { const int bh = it >> 1, qt = it & 1; attn_item(p, bh >> 2, bh & 3, 128 * qt, 4, smem_full); }
    else if (it < 576) { const int j = it - 32; mlstm_out_item(p, j / 34, j % 34, smem); }
    else lru_out_item(p, it - 576, smem);
  }
}
DI void phase_final(CPARAMS p) {
  const int lane = tidx_() & 63, w = tidx_() >> 6;
  for (int it = bidx_(); it < NB * TL / 4; it += VGRID) {
    const int r = it * 4 + w;
    const int b = r >> 12, t = r & 4095;
    const float* src = p.X + ((size_t)b * TP + TC + t) * DM;
    float4 v[4];
    float ss = 0.f;
#pragma unroll
    for (int i = 0; i < 4; ++i) {
      v[i] = *(const float4*)(src + lane * 4 + 256 * i);
      ss += v[i].x * v[i].x + v[i].y * v[i].y + v[i].z * v[i].z + v[i].w * v[i].w;
    }
#pragma unroll
    for (int o = 32; o > 0; o >>= 1) ss += __shfl_xor(ss, o, 64);
    const float rs = rsqrtf(ss * (1.f / DM) + EPSF);
#pragma unroll
    for (int i = 0; i < 4; ++i) {
      const int cidx = lane * 4 + 256 * i;
      const float4 g = *(const float4*)(p.final_g + cidx);
      float4 o4;
      o4.x = v[i].x * rs * g.x; o4.y = v[i].y * rs * g.y; o4.z = v[i].z * rs * g.z; o4.w = v[i].w * rs * g.w;
      *(float4*)(p.out + (size_t)r * DM + cidx) = o4;
    }
  }
}

__global__ void __launch_bounds__(512, 2) mega_kernel(Params p_unused) {
  __shared__ __attribute__((aligned(16))) unsigned char smem[163840];
  cg::grid_group grid = cg::this_grid();
  unsigned char* hs = smem + hidx_() * 81920;
  if (threadIdx.x < 4) ((unsigned*)(smem + 163824))[threadIdx.x] = 0u;
  __syncthreads();
  phase_mod(*kparams(), hs);
  grid.sync();
  XcdBarrier xb = xcd_barrier_post(kparams()->BAR, (volatile LAS unsigned*)(smem + 163824));
#pragma unroll 1
  for (int l = 0; l < NLAYER; ++l) {
    phase_norm1(*kparams(), l, hs);
    xcd_barrier(xb);
    phase_gemm_in(*kparams(), l, smem, hs);
    xcd_barrier(xb);
    phase_prep(*kparams(), l, hs, smem);
    xcd_barrier(xb);
    phase_mlstm_scan(*kparams());
    xcd_barrier(xb);
    phase_mix(*kparams(), l, hs, smem);
    xcd_barrier(xb);
    phase_gemm_resid(*kparams(), l, kparams()->U, DM, kparams()->Wb_out, 2, l == NLAYER - 1, smem);
    xcd_barrier(xb);
    phase_norm2(*kparams(), l);
    xcd_barrier(xb);
    phase_gemm_ff1(*kparams(), l == NLAYER - 1, smem);
    xcd_barrier(xb);
    phase_gemm_resid(*kparams(), l, kparams()->H, DFF, kparams()->Wb_ff2, 5, l == NLAYER - 1, smem);
    xcd_barrier(xb);
  }
  phase_final(*kparams());
}

extern "C" void kernel_launch(void* const* d_in, const int* in_sizes, int n_in, void* d_out, int out_size, void* d_ws, size_t ws_size,
                              hipStream_t stream) {
  static int grid_blocks = 0;
  if (!grid_blocks) {
    int dev = 0, cus = 0, per_cu = 0;
    hipGetDevice(&dev);
    hipDeviceGetAttribute(&cus, hipDeviceAttributeMultiprocessorCount, dev);
    hipOccupancyMaxActiveBlocksPerMultiprocessor(&per_cu, mega_kernel, 512, 0);
    if (per_cu > 1) per_cu = 1;
    if (per_cu < 1) per_cu = 1;
    grid_blocks = cus * per_cu;
  }
  Params p{};
  const float* const* in = (const float* const*)d_in;
  p.x = in[0]; p.c = in[1]; p.ctx = in[2]; p.c_ctx = in[3]; p.w_mod = in[4]; p.b_mod = in[5]; p.w_in = in[6];
  p.g_q = in[7]; p.w_uq = in[8]; p.g_kv = in[9]; p.w_ukv = in[10]; p.gate_bias = in[11];
  p.conv_w = in[12]; p.conv_b = in[13]; p.w_a = in[14]; p.b_a = in[15]; p.w_x = in[16]; p.b_x = in[17]; p.lam = in[18];
  p.w_out = in[19]; p.w_ff1 = in[20]; p.w_ff2 = in[21]; p.final_g = in[22];
  p.out = (float*)d_out;
  unsigned char* ws = (unsigned char*)d_ws;
  size_t off = 0;
  auto take = [&](size_t bytes) { unsigned char* r = ws + off; off += (bytes + 255) & ~(size_t)255; return r; };
  p.Wb_in = (bf16_t*)take((size_t)2048 * 1024 * 2);
  p.Wb_uq = (bf16_t*)take((size_t)768 * 256 * 2);
  p.Wb_ukv = (bf16_t*)take((size_t)1024 * 128 * 2);
  p.Wb_out = (bf16_t*)take((size_t)1024 * 1024 * 2);
  p.Wb_ff1 = (bf16_t*)take((size_t)4096 * 1024 * 2);
  p.Wb_ff2 = (bf16_t*)take((size_t)4096 * 1024 * 2);
  p.Wb_lru = (bf16_t*)take((size_t)4 * 256 * 64 * 2);
  p.MOD = (float*)take((size_t)4 * 5 * 6144 * 4);
  p.X = (float*)take((size_t)NTOK * DM * 4);
  p.U = (bf16_t*)take((size_t)NTOK * DM * 2);
  p.H = (bf16_t*)take((size_t)NTOK * DFF * 2);
  p.Z = p.H;
  p.Qb = p.Z + (size_t)NTOK * ZW;
  p.Kb = p.Qb + (size_t)16 * TP * 192;
  p.Vt = p.Kb + (size_t)16 * TP * 192;
  p.ZGt = (float*)take((size_t)NTOK * 16 * 4);
  p.AU = (bf16_t*)take((size_t)4 * NTOK * 256 * 2);
  p.AGG = (float*)take((size_t)136 * 2 * 2 * 256 * 4);
  p.CST = (float*)take((size_t)16 * 34 * 2 * CREC * 4);
  p.XS = (float*)take((size_t)NTOK * 256 * 4);
  p.CTR = (unsigned*)take(256);
  p.BAR = (unsigned*)take((size_t)XCD_BAR_WORDS * 4);
  if (off > ws_size) fprintf(stderr, "workspace too small: need %zu have %zu\n", off, ws_size);
  void* args[] = {&p};
  hipError_t e = hipLaunchCooperativeKernel((void*)mega_kernel, dim3(grid_blocks), dim3(512), args, 0, stream);
  if (e != hipSuccess) fprintf(stderr, "cooperative launch failed: %s (grid %d)\n", hipGetErrorString(e), grid_blocks);
}
```

```cpp
#include <hip/hip_runtime.h>
#include <hip/hip_cooperative_groups.h>
#include <cstdio>
namespace cg = cooperative_groups;

#define DI __device__ __forceinline__
typedef unsigned short bf16_t;
typedef __attribute__((ext_vector_type(8))) short bf16x8;
typedef __attribute__((ext_vector_type(16))) float f32x16;
typedef __attribute__((ext_vector_type(4))) unsigned u32x4;
typedef __bf16 bf16v2_t __attribute__((ext_vector_type(2)));
typedef float f32v2_t __attribute__((ext_vector_type(2)));

#define NB 4
#define TL 4096
#define TC 256
#define TP 4352
#define NTOK 17408
#define DM 1024
#define DFF 4096
#define ZW 2048
#define NLAYER 4
#define EPSF 1e-6f
#define ZQ 0
#define ZKV 256
#define ZKR 384
#define ZG 448
#define ZMQ 512
#define ZMK 768
#define ZMV 1024
#define ZMO 1280
#define ZLX 1536
#define ZLG 1792
#define LDT 72
#define CREC 4224
#define QSCALE (0.07216878364870322f * 1.4426950408889634f)

struct Params {
  const float *x, *c, *ctx, *c_ctx, *w_mod, *b_mod, *w_in, *g_q, *w_uq, *g_kv, *w_ukv, *gate_bias;
  const float *conv_w, *conv_b, *w_a, *b_a, *w_x, *b_x, *lam, *w_out, *w_ff1, *w_ff2, *final_g;
  float* out;
  bf16_t *Wb_in, *Wb_uq, *Wb_ukv, *Wb_out, *Wb_ff1, *Wb_ff2, *Wb_lru;
  float* MOD;
  float* X;
  bf16_t* U;
  bf16_t* Z;
  bf16_t* Qb;
  bf16_t* Kb;
  bf16_t* Vt;
  bf16_t* H;
  float* ZGt;
  bf16_t* AU;
  float* AGG;
  float* CST;
  float* XS;
  unsigned* CTR;
  unsigned* BAR;
};

typedef const __attribute__((address_space(4))) Params CParamsT;
typedef CParamsT& CPARAMS;
__device__ __forceinline__ CParamsT* kparams() {
  CParamsT* q = (CParamsT*)__builtin_amdgcn_kernarg_segment_ptr();
  asm volatile("" : "+s"(q));
  return q;
}

DI int tfull_() { int t = threadIdx.x; asm volatile("" : "+v"(t)); return t; }
DI int tidx_() { return tfull_() & 255; }
DI int hidx_() { return tfull_() >> 8; }
DI int rbidx_() { int t = blockIdx.x; asm volatile("" : "+s"(t)); return t; }
DI int bidx_() { return rbidx_() * 2 + hidx_(); }
#define VGRID ((int)gridDim.x * 2)
DI unsigned pack2(float a, float b) {
  f32v2_t v = {a, b};
  bf16v2_t r = __builtin_convertvector(v, bf16v2_t);
  return __builtin_bit_cast(unsigned, r);
}
DI bf16_t f2bf(float a) { return (bf16_t)(pack2(a, 0.f) & 0xffffu); }
DI float bf2f(bf16_t v) { return __uint_as_float(((unsigned)v) << 16); }
DI float bflo(unsigned u) { return __uint_as_float(u << 16); }
DI float bfhi(unsigned u) { return __uint_as_float(u & 0xffff0000u); }
DI f32x16 mfma(bf16x8 a, bf16x8 b, f32x16 c) { return __builtin_amdgcn_mfma_f32_32x32x16_bf16(a, b, c, 0, 0, 0); }
DI f32x16 zero16() { f32x16 z;
#pragma unroll
  for (int i = 0; i < 16; ++i) z[i] = 0.f; return z; }
DI float ex2(float x) { return __builtin_amdgcn_exp2f(x); }
DI float fexp(float x) { return __builtin_amdgcn_exp2f(x * 1.4426950408889634f); }
DI float sigmoidf_(float x) { return 1.f / (1.f + fexp(-x)); }
DI float xhalf(float v) { return __shfl_xor(v, 32, 64); }
DI bf16x8 ldfrag(const bf16_t* p) { return *(const bf16x8*)p; }
DI bf16x8 pack8(float a0, float a1, float a2, float a3, float a4, float a5, float a6, float a7) {
  uint4 u; u.x = pack2(a0, a1); u.y = pack2(a2, a3); u.z = pack2(a4, a5); u.w = pack2(a6, a7);
  return __builtin_bit_cast(bf16x8, u);
}
DI int crow(int i, int hh) { return (i & 3) + 8 * (i >> 2) + 4 * hh; }
DI int permk(int t) { return (t & ~12) | ((t & 4) << 1) | ((t & 8) >> 1); }

#define XB_TMO      128
#define XB_XCNT(j)  (256  + 64 * (j))
#define XB_XSUB(j)  (1280 + 64 * (j))
#define XB_XGEN(j)  (2304 + 64 * (j))
#define XB_TOP      3328
#define XB_TOPGEN   3392
#define XCD_BAR_WORDS 3456
#define XB_SPIN_CAP (1u << 18)
#define LAS __attribute__((address_space(3)))

__device__ __forceinline__ unsigned xb_ld(unsigned* p)              { return __hip_atomic_load(p, __ATOMIC_RELAXED, __HIP_MEMORY_SCOPE_AGENT); }
__device__ __forceinline__ unsigned xb_add(unsigned* p, unsigned v) { return __hip_atomic_fetch_add(p, v, __ATOMIC_RELAXED, __HIP_MEMORY_SCOPE_AGENT); }
__device__ __forceinline__ unsigned xb_xcc_id() { return (unsigned)__builtin_amdgcn_s_getreg((3 << 11) | 20) & 0xFu; }
#define XB_SPIN(cond, bar) do { unsigned _sp = 0; while (cond) { __builtin_amdgcn_s_sleep(1); \
    if ((++_sp & 255u) == 0u) { if (xb_ld(&(bar)[XB_TMO])) break; if (_sp > XB_SPIN_CAP) { atomicAdd(&(bar)[XB_TMO], 1u); break; } } } } while (0)

struct XcdBarrier {
    unsigned* bar; unsigned x;
    volatile LAS unsigned* st;
};

__device__ __forceinline__ XcdBarrier xcd_barrier_post(unsigned* bar, volatile LAS unsigned* st) {
    XcdBarrier b; b.bar = bar; b.x = xb_xcc_id(); b.st = st;
    if (threadIdx.x == 0) (void)xb_add(&bar[XB_XCNT(b.x)], 1u);
    return b;
}
__device__ __forceinline__ void xcd_barrier_complete(unsigned* bar, unsigned x, unsigned& nloc, unsigned& nx) {
    const unsigned G = gridDim.x * gridDim.y * gridDim.z;
    unsigned sum, cnt, mine, sp = 0u;
    for (;;) {
        sum = 0u; cnt = 0u; mine = 0u;
#pragma unroll
        for (unsigned j = 0; j < 16; ++j) { const unsigned c = xb_ld(&bar[XB_XCNT(j)]); sum += c; cnt += (c > 0u) ? 1u : 0u; mine = (j == x) ? c : mine; }
        if (sum == G) break;
        __builtin_amdgcn_s_sleep(1);
        if ((++sp & 255u) == 0u) { if (xb_ld(&bar[XB_TMO])) break; if (sp > XB_SPIN_CAP) { atomicAdd(&bar[XB_TMO], 1u); break; } }
    }
    nloc = mine > 0u ? mine : 1u; nx = cnt > 0u ? cnt : 1u;
}

__device__ __forceinline__ void xcd_barrier(const XcdBarrier& b) {
    asm volatile("s_waitcnt vmcnt(0)" ::: "memory");
    __syncthreads();
    if (threadIdx.x == 0) {
        unsigned* bar = b.bar;
        __builtin_amdgcn_s_waitcnt(0);
        unsigned nloc = b.st[0], nx = b.st[1];
        if (nloc == 0u) { xcd_barrier_complete(bar, b.x, nloc, nx); b.st[0] = nloc; b.st[1] = nx; }
        const unsigned old = xb_add(&bar[XB_XSUB(b.x)], 1u);
        const unsigned gen = old / nloc;
        if (old + 1u == (gen + 1u) * nloc) {
            __builtin_amdgcn_fence(__ATOMIC_RELEASE, "agent");
            asm volatile("s_waitcnt vmcnt(0)" ::: "memory");
            const unsigned og = xb_add(&bar[XB_TOP], 1u);
            const unsigned tg = og / nx;
            if (og + 1u == (tg + 1u) * nx) xb_add(&bar[XB_TOPGEN], 1u);
            else XB_SPIN(xb_ld(&bar[XB_TOPGEN]) == tg, bar);
            __builtin_amdgcn_fence(__ATOMIC_ACQUIRE, "agent");
            xb_add(&bar[XB_XGEN(b.x)], 1u);
            asm volatile("s_waitcnt vmcnt(0)" ::: "memory");
        } else {
            XB_SPIN(xb_ld(&bar[XB_XGEN(b.x)]) == gen, bar);
            __builtin_amdgcn_fence(__ATOMIC_ACQUIRE, "agent");
            asm volatile("s_waitcnt vmcnt(0)" ::: "memory");
        }
    }
    __syncthreads();
}


template <class Epi>
DI void gemm128(const bf16_t* __restrict__ A, int lda, const bf16_t* __restrict__ B, int ldb, int K, bf16_t* sm, Epi&& epi) {
  const int tid = tidx_(), lane = tid & 63, w = tid >> 6, wp = w >> 1, wq = w & 1, l32 = lane & 31, hh = lane >> 5;
  bf16_t* sA = sm;
  bf16_t* sB = sm + 2 * 128 * LDT;
  f32x16 acc[2][2];
#pragma unroll
  for (int i = 0; i < 2; ++i)
#pragma unroll
    for (int j = 0; j < 2; ++j) acc[i][j] = zero16();
  const int lrow = tid >> 3, kc = (tid & 7) * 8;
  const bf16_t* gA = A + (size_t)lrow * lda + kc;
  const bf16_t* gB = B + (size_t)lrow * ldb + kc;
  u32x4 ra[4], rb[4];
#pragma unroll
  for (int i = 0; i < 4; ++i) {
    ra[i] = *(const u32x4*)(gA + (size_t)(32 * i) * lda);
    rb[i] = *(const u32x4*)(gB + (size_t)(32 * i) * ldb);
  }
#pragma unroll
  for (int i = 0; i < 4; ++i) {
    *(u32x4*)(sA + (lrow + 32 * i) * LDT + kc) = ra[i];
    *(u32x4*)(sB + (lrow + 32 * i) * LDT + kc) = rb[i];
  }
  __syncthreads();
  const int KT = K >> 6;
#pragma unroll 1
  for (int kt = 0; kt < KT; ++kt) {
    const int cur = kt & 1;
    if (kt + 1 < KT) {
#pragma unroll
      for (int i = 0; i < 4; ++i) {
        ra[i] = *(const u32x4*)(gA + (size_t)(32 * i) * lda + (kt + 1) * 64);
        rb[i] = *(const u32x4*)(gB + (size_t)(32 * i) * ldb + (kt + 1) * 64);
      }
    }
    const bf16_t* cA = sA + cur * 128 * LDT + (64 * wp + l32) * LDT + 8 * hh;
    const bf16_t* cB = sB + cur * 128 * LDT + (64 * wq + l32) * LDT + 8 * hh;
#pragma unroll
    for (int ks = 0; ks < 4; ++ks) {
      bf16x8 a0 = ldfrag(cA + ks * 16), a1 = ldfrag(cA + 32 * LDT + ks * 16);
      bf16x8 b0 = ldfrag(cB + ks * 16), b1 = ldfrag(cB + 32 * LDT + ks * 16);
      acc[0][0] = mfma(a0, b0, acc[0][0]);
      acc[0][1] = mfma(a0, b1, acc[0][1]);
      acc[1][0] = mfma(a1, b0, acc[1][0]);
      acc[1][1] = mfma(a1, b1, acc[1][1]);
    }
    if (kt + 1 < KT) {
      const int nx = cur ^ 1;
#pragma unroll
      for (int i = 0; i < 4; ++i) {
        *(u32x4*)(sA + nx * 128 * LDT + (lrow + 32 * i) * LDT + kc) = ra[i];
        *(u32x4*)(sB + nx * 128 * LDT + (lrow + 32 * i) * LDT + kc) = rb[i];
      }
    }
    __syncthreads();
  }
  epi(acc);
}

template <class CM>
DI void transpose_tile(const float* __restrict__ src, int ld_src, int k0, int n0, bf16_t* __restrict__ dst, int ld_dst,
                       const float* __restrict__ sc, float* smf, CM cm) {
  const int tid = tidx_();
  __syncthreads();
  {
    const int nl = tid & 63, kp = tid >> 6;
    const int sn = cm(n0 + nl);
#pragma unroll
    for (int kk = 0; kk < 16; ++kk) {
      const int k = kp * 16 + kk;
      float v = 0.f;
      if (sn >= 0) {
        v = src[(size_t)(k0 + k) * ld_src + sn];
        if (sc) v *= sc[k0 + k];
      }
      smf[nl * 65 + k] = v;
    }
  }
  __syncthreads();
  {
    const int nl = tid >> 2, ks = (tid & 3) * 16;
    const float* r = smf + nl * 65 + ks;
    uint4 u0, u1;
    u0.x = pack2(r[0], r[1]); u0.y = pack2(r[2], r[3]); u0.z = pack2(r[4], r[5]); u0.w = pack2(r[6], r[7]);
    u1.x = pack2(r[8], r[9]); u1.y = pack2(r[10], r[11]); u1.z = pack2(r[12], r[13]); u1.w = pack2(r[14], r[15]);
    bf16_t* d = dst + (size_t)(n0 + nl) * ld_dst + k0 + ks;
    *(uint4*)d = u0;
    *(uint4*)(d + 8) = u1;
  }
}

DI int mod_stream(int row) { const int b = row / TP; return (row - b * TP) < TC ? 4 : b; }

DI void phase_mod(CPARAMS p, unsigned char* smem) {
  float* cs = (float*)smem;
  float* red = cs + 5 * 1024;
  const int tid = tidx_();
  if (bidx_() == 0 && tid < 16) p.CTR[tid] = 0u;
  if (rbidx_() == 0) for (int i = tfull_(); i < XCD_BAR_WORDS; i += 512) p.BAR[i] = 0u;
  bool loaded = false;
  for (int item = bidx_(); item < NLAYER * 96; item += VGRID) {
    if (!loaded) {
      for (int i = tid; i < 5 * 1024; i += 256) {
        const float v = i < 4096 ? p.c[i] : p.c_ctx[i - 4096];
        cs[i] = v * sigmoidf_(v);
      }
      loaded = true;
    }
    __syncthreads();
    const int l = item / 96, cch = item % 96;
    const int col = cch * 64 + (tid & 63), part = tid >> 6;
    const float* wm = p.w_mod + (size_t)l * DM * 6144 + col;
    float a0 = 0.f, a1 = 0.f, a2 = 0.f, a3 = 0.f, a4 = 0.f;
#pragma unroll 16
    for (int k = part * 256; k < part * 256 + 256; ++k) {
      const float wv = wm[(size_t)k * 6144];
      a0 += cs[k] * wv; a1 += cs[1024 + k] * wv; a2 += cs[2048 + k] * wv; a3 += cs[3072 + k] * wv; a4 += cs[4096 + k] * wv;
    }
    float* rr = red + part * 320 + (tid & 63);
    rr[0] = a0; rr[64] = a1; rr[128] = a2; rr[192] = a3; rr[256] = a4;
    __syncthreads();
    for (int i = tid; i < 320; i += 256) {
      const int s = i >> 6, cl = i & 63;
      const float v = red[i] + red[320 + i] + red[640 + i] + red[960 + i] + p.b_mod[l * 6144 + cch * 64 + cl];
      p.MOD[((size_t)l * 5 + s) * 6144 + cch * 64 + cl] = v;
    }
  }
}

#define WC_IN 512
#define WC_UQ 48
#define WC_UKV 32
#define WC_OUT 256
#define WC_FF1 1024
#define WC_FF2 1024
#define WC_LRU 16
#define WC_TOTAL (WC_IN + WC_UQ + WC_UKV + WC_OUT + WC_FF1 + WC_FF2 + WC_LRU)
DI void wconv_item(CPARAMS p, int l, int it, float* smf) {
  if (it < WC_IN) {
    const int nt = it >> 4, kt = it & 15;
    transpose_tile(p.w_in + (size_t)l * DM * 2000, 2000, kt * 64, nt * 64, p.Wb_in, DM, nullptr, smf, [](int j) {
      if (j < 448) return j;
      if (j < 464) return 1472 + (j - 448);
      if (j < 512) return -1;
      if (j < 1536) return 448 + (j - 512);
      return 1488 + (j - 1536);
    });
    return;
  }
  it -= WC_IN;
  if (it < WC_UQ) {
    const int nt = it >> 2, kt = it & 3;
    transpose_tile(p.w_uq + (size_t)l * 256 * 768, 768, kt * 64, nt * 64, p.Wb_uq, 256, p.g_q + l * 256, smf, [](int j) {
      if (j < 512) return (j >> 7) * 192 + (j & 127);
      const int r = j - 512;
      return (r >> 6) * 192 + 128 + (r & 63);
    });
    return;
  }
  it -= WC_UQ;
  if (it < WC_UKV) {
    const int nt = it >> 1, kt = it & 1;
    transpose_tile(p.w_ukv + (size_t)l * 128 * 1024, 1024, kt * 64, nt * 64, p.Wb_ukv, 128, p.g_kv + l * 128, smf, [](int j) {
      if (j < 512) return (j >> 7) * 256 + (j & 127);
      const int r = j - 512;
      return (r >> 7) * 256 + 128 + (r & 127);
    });
    return;
  }
  it -= WC_UKV;
  if (it < WC_OUT) {
    const int nt = it >> 4, kt = it & 15;
    transpose_tile(p.w_out + (size_t)l * DM * DM, DM, kt * 64, nt * 64, p.Wb_out, DM, nullptr, smf, [](int j) { return j; });
    return;
  }
  it -= WC_OUT;
  if (it < WC_FF1) {
    const int nt = it >> 4, kt = it & 15;
    transpose_tile(p.w_ff1 + (size_t)l * DM * DFF, DFF, kt * 64, nt * 64, p.Wb_ff1, DM, nullptr, smf, [](int j) { return j; });
    return;
  }
  it -= WC_FF1;
  if (it < WC_FF2) {
    const int nt = it >> 6, kt = it & 63;
    transpose_tile(p.w_ff2 + (size_t)l * DFF * DM, DM, kt * 64, nt * 64, p.Wb_ff2, DFF, nullptr, smf, [](int j) { return j; });
    return;
  }
  it -= WC_FF2;
  {
    const int g = it >> 2, which = it & 3, d = which >> 1;
    const float* src = ((which & 1) ? p.w_x : p.w_a) + ((size_t)((l * 2 + d) * 4 + g)) * 4096;
    transpose_tile(src, 64, 0, 0, p.Wb_lru + (size_t)(g * 256 + which * 64) * 64, 64, nullptr, smf, [](int j) { return j; });
  }
}

template <int NR>
DI void norm_rows(CPARAMS p, int l, int which  , int row0, bool from_input) {
  const int lane = tidx_() & 63;
  float4 v[NR][4];
  float ss[NR];
  int sidx[NR];
#pragma unroll
  for (int r = 0; r < NR; ++r) {
    const int row = row0 + r;
    const int b = row / TP, pos = row - b * TP;
    sidx[r] = pos < TC ? 4 : b;
    const float* src;
    if (from_input) src = pos < TC ? p.ctx + ((size_t)b * TC + pos) * DM : p.x + ((size_t)b * TL + (pos - TC)) * DM;
    else src = p.X + (size_t)row * DM;
#pragma unroll
    for (int i = 0; i < 4; ++i) v[r][i] = *(const float4*)(src + lane * 4 + 256 * i);
  }
#pragma unroll
  for (int r = 0; r < NR; ++r) {
    float a = 0.f;
#pragma unroll
    for (int i = 0; i < 4; ++i) a += v[r][i].x * v[r][i].x + v[r][i].y * v[r][i].y + v[r][i].z * v[r][i].z + v[r][i].w * v[r][i].w;
    ss[r] = a;
  }
#pragma unroll
  for (int o = 32; o > 0; o >>= 1)
#pragma unroll
    for (int r = 0; r < NR; ++r) ss[r] += __shfl_xor(ss[r], o, 64);
#pragma unroll
  for (int r = 0; r < NR; ++r) {
    const int row = row0 + r;
    const float rs = rsqrtf(ss[r] * (1.f / DM) + EPSF);
    const float* md = p.MOD + ((size_t)l * 5 + sidx[r]) * 6144 + which * 3072;
#pragma unroll
    for (int i = 0; i < 4; ++i) {
      const int cidx = lane * 4 + 256 * i;
      if (from_input) *(float4*)(p.X + (size_t)row * DM + cidx) = v[r][i];
      const float4 sh = *(const float4*)(md + cidx);
      const float4 sc = *(const float4*)(md + 1024 + cidx);
      uint2 o;
      o.x = pack2(v[r][i].x * rs * (1.f + sc.x) + sh.x, v[r][i].y * rs * (1.f + sc.y) + sh.y);
      o.y = pack2(v[r][i].z * rs * (1.f + sc.z) + sh.z, v[r][i].w * rs * (1.f + sc.w) + sh.w);
      *(uint2*)(p.U + (size_t)row * DM + cidx) = o;
    }
  }
}
DI void norm_all_rows(CPARAMS p, int l, int which, bool from_input) {
  const int gw = bidx_() * 4 + (tidx_() >> 6), nw = VGRID * 4;
  int r = (int)((long)NTOK * gw / nw);
  const int rend = (int)((long)NTOK * (gw + 1) / nw);
  for (; r + 4 <= rend; r += 4) norm_rows<4>(p, l, which, r, from_input);
  for (; r < rend; ++r) norm_rows<1>(p, l, which, r, from_input);
}

#define WC_EARLY (WC_IN + WC_UQ + WC_UKV)
#define WC_LATE (WC_OUT + WC_FF1 + WC_FF2)
DI void phase_norm1(CPARAMS p, int l, unsigned char* smem) {
  for (int it = bidx_(); it < WC_EARLY + WC_LRU; it += VGRID) wconv_item(p, l, it < WC_EARLY ? it : it + WC_LATE, (float*)smem);
  norm_all_rows(p, l, 0, l == 0);
}
DI void phase_norm2(CPARAMS p, int l) { norm_all_rows(p, l, 1, false); }

namespace pg8 {
#define PG8_LAS __attribute__((address_space(3)))
typedef float f32x4 __attribute__((ext_vector_type(4)));
constexpr int BM = 256, BK = 64, HALF = 128, HTB = HALF * BK * 2  , STAGE_BYTES = 8 * HTB;
__device__ __forceinline__ int lds_byte(int r, int c) { const int st = (r >> 4) * 2 + (c >> 5), rr = r & 15, cc = c & 31, ob = rr * 64 + cc * 2; return st * 1024 + (ob ^ (((ob >> 9) & 1) << 5)); }
__device__ __forceinline__ void stage_rc(int b, int& R, int& C) { const int st = b / 1024, sb = b % 1024, swz = sb ^ (((sb >> 9) & 1) << 5); R = (st >> 1) * 16 + swz / 64; C = (st & 1) * 32 + (swz % 64) / 2; }
__device__ __forceinline__ int perm32(int rho) { const int n = rho >> 4, i = rho & 15; return 8 * (i >> 2) + 4 * n + (i & 3); }
struct Unit { int pm, pn, kq; };
struct Gemm { const bf16_t* A; const bf16_t* Bt; int K, ld; };
template <class Epi, class Sched>
__device__ __forceinline__ void gemm_phase(PG8_LAS unsigned char* lds, const Gemm g, const Sched& S, const Epi& E) {
    const int tid = tfull_(), wid = __builtin_amdgcn_readfirstlane(tid >> 6), lane = tid & 63, wr = wid >> 2, wc = wid & 3, fr = lane & 15, fq = lane >> 4;
    const int K = g.ld, nt = g.K / BK;
    unsigned voffA[2], voffB[2];
#pragma unroll
    for (int i = 0; i < 2; ++i) { int R, C; stage_rc(tid * 16 + i * 8192, R, C); const int Rb = Epi::PERM ? ((R & ~31) + perm32(R & 31)) : R;
        voffA[i] = (unsigned)(R * K + C) * 2u; voffB[i] = (unsigned)(Rb * K + C) * 2u; }
    const size_t kstep = (size_t)(BK * 2);
    const size_t hstep = (size_t)HALF * K * 2;
    const size_t tstep = 2 * hstep;
    const unsigned ldsw = (unsigned)wid * 1024u;
    const int aoff = lds_byte(wr * 64 + fr, fq * 8), boff = lds_byte(wc * 32 + fr, fq * 8);
#define PG8_SA(b, h) (((b) * 2 + (h)) * HTB)
#define PG8_SB(b, h) ((4 + (b) * 2 + (h)) * HTB)
#define PG8_STAGE(bufoff, gbase, voff) do { _Pragma("unroll") for (int _i = 0; _i < 2; ++_i) \
        __builtin_amdgcn_global_load_lds((const unsigned*)((const char*)(gbase) + (voff)[_i]), (PG8_LAS unsigned*)(lds + (bufoff) + ldsw + _i * 8192), 16, 0, 0); } while (0)
#define PG8_LDA(dst, b, h) do { _Pragma("unroll") for (int m = 0; m < 4; ++m) _Pragma("unroll") for (int k = 0; k < 2; ++k) dst[m][k] = *(const PG8_LAS bf16x8*)(lds + PG8_SA(b, h) + aoff + m * 2048 + k * 1024); } while (0)
#define PG8_LDB(dst, b, h) do { _Pragma("unroll") for (int n = 0; n < 2; ++n) _Pragma("unroll") for (int k = 0; k < 2; ++k) dst[n][k] = *(const PG8_LAS bf16x8*)(lds + PG8_SB(b, h) + boff + n * 2048 + k * 1024); } while (0)
#define PG8_MMA(ai, bj, At, Bt) do { __builtin_amdgcn_s_setprio(1); _Pragma("unroll") for (int m = 0; m < 4; ++m) _Pragma("unroll") for (int n = 0; n < 2; ++n) _Pragma("unroll") for (int k = 0; k < 2; ++k) \
        acc[ai][bj][m][n] = __builtin_amdgcn_mfma_f32_16x16x32_bf16(Bt[n][k], At[m][k], acc[ai][bj][m][n], 0, 0, 0); __builtin_amdgcn_s_setprio(0); } while (0)
#define PG8_WAIT_V(n) asm volatile("s_waitcnt vmcnt(" #n ")" ::: "memory")
#define PG8_WAIT_L(n) asm volatile("s_waitcnt lgkmcnt(" #n ")" ::: "memory")
#define PG8_BAR __builtin_amdgcn_s_barrier()
#define PG8_SCHED __builtin_amdgcn_sched_barrier(0)
    Unit cur, nxt; int ui = 0;
    if (!S.next(0, cur)) return;
    f32x4 acc[2][2][4][2];
#pragma unroll
    for (int a = 0; a < 2; ++a)
#pragma unroll
        for (int b = 0; b < 2; ++b)
#pragma unroll
            for (int m = 0; m < 4; ++m)
#pragma unroll
                for (int n = 0; n < 2; ++n) acc[a][b][m][n] = (f32x4){0.f, 0.f, 0.f, 0.f};
    bf16x8 At[4][2], B0[2][2], B1[2][2];
    const size_t kqstep = (size_t)g.K * 2;
    const char* cA = (const char*)g.A + (size_t)cur.pm * tstep + (size_t)cur.kq * kqstep; const char* cB = (const char*)g.Bt + (size_t)cur.pn * tstep + (size_t)cur.kq * kqstep;
    S.a_ready(cur);
    PG8_STAGE(PG8_SB(0, 0), cB, voffB); PG8_STAGE(PG8_SA(0, 0), cA, voffA); PG8_STAGE(PG8_SB(0, 1), cB + hstep, voffB); PG8_STAGE(PG8_SA(0, 1), cA + hstep, voffA);
    if (wr == 1) PG8_BAR;
    PG8_WAIT_V(4); PG8_BAR;
    PG8_STAGE(PG8_SB(1, 0), cB + kstep, voffB); PG8_STAGE(PG8_SA(1, 0), cA + kstep, voffA); PG8_STAGE(PG8_SB(1, 1), cB + hstep + kstep, voffB);
    PG8_WAIT_V(6); PG8_BAR;
    for (;;) {
        const bool has_next = S.next(ui + 1, nxt);
        const char* nA = has_next ? (const char*)g.A + (size_t)nxt.pm * tstep + (size_t)nxt.kq * kqstep : cA; const char* nB = has_next ? (const char*)g.Bt + (size_t)nxt.pn * tstep + (size_t)nxt.kq * kqstep : cB;
        for (int t = 0; t < nt; t += 2) {
            const bool last = (t == nt - 2);
            const char* a1 = cA + (size_t)(t + 1) * kstep;
            const char* a2 = last ? nA : cA + (size_t)(t + 2) * kstep; const char* b2 = last ? nB : cB + (size_t)(t + 2) * kstep;
            const char* a3 = a2 + kstep; const char* b3 = b2 + kstep;
            if (last && has_next) S.a_ready(nxt);
            PG8_LDB(B0, 0, 0); PG8_SCHED; PG8_LDA(At, 0, 0); PG8_STAGE(PG8_SA(1, 1), a1 + hstep, voffA);
            PG8_WAIT_L(8); PG8_BAR; PG8_WAIT_L(0); PG8_MMA(0, 0, At, B0); PG8_BAR; PG8_SCHED;
            PG8_LDB(B1, 0, 1); PG8_STAGE(PG8_SB(0, 0), b2, voffB);
            PG8_BAR; PG8_WAIT_L(0); PG8_MMA(0, 1, At, B1); PG8_BAR;
            PG8_LDA(At, 0, 1); PG8_STAGE(PG8_SA(0, 0), a2, voffA);
            PG8_BAR; PG8_WAIT_L(0); PG8_MMA(1, 0, At, B0); PG8_BAR; PG8_SCHED;
            PG8_STAGE(PG8_SB(0, 1), b2 + hstep, voffB);
            PG8_WAIT_V(6); PG8_BAR; PG8_MMA(1, 1, At, B1); PG8_BAR;
            PG8_LDB(B0, 1, 0); PG8_SCHED; PG8_LDA(At, 1, 0); PG8_STAGE(PG8_SA(0, 1), a2 + hstep, voffA);
            PG8_WAIT_L(8); PG8_BAR; PG8_WAIT_L(0); PG8_MMA(0, 0, At, B0); PG8_BAR; PG8_SCHED;
            PG8_LDB(B1, 1, 1); PG8_STAGE(PG8_SB(1, 0), b3, voffB);
            PG8_BAR; PG8_WAIT_L(0); PG8_MMA(0, 1, At, B1); PG8_BAR;
            PG8_LDA(At, 1, 1); PG8_STAGE(PG8_SA(1, 0), a3, voffA);
            PG8_BAR; PG8_WAIT_L(0); PG8_MMA(1, 0, At, B0); PG8_BAR; PG8_SCHED;
            PG8_STAGE(PG8_SB(1, 1), b3 + hstep, voffB);
            PG8_WAIT_V(6); PG8_BAR; PG8_MMA(1, 1, At, B1); PG8_BAR;
        }
            if constexpr (!Epi::AFTER_DRAIN) { E(acc, cur, wr, wc, fr, fq); S.done(cur); }
            if (!has_next) break;
#pragma unroll
        for (int a = 0; a < 2; ++a)
#pragma unroll
            for (int b = 0; b < 2; ++b)
#pragma unroll
                for (int m = 0; m < 4; ++m)
#pragma unroll
                    for (int n = 0; n < 2; ++n) acc[a][b][m][n] = (f32x4){0.f, 0.f, 0.f, 0.f};
        cur = nxt; cA = nA; cB = nB; ++ui;
    }
    PG8_WAIT_V(0);
    if (wr == 0) PG8_BAR;
    PG8_BAR;
    if constexpr (Epi::AFTER_DRAIN) { E.fused(acc, cur, wr, wc, fr, fq, lds, wid, lane); S.done(cur); }
#undef PG8_SA
#undef PG8_SB
#undef PG8_STAGE
#undef PG8_LDA
#undef PG8_LDB
#undef PG8_MMA
#undef PG8_WAIT_V
#undef PG8_WAIT_L
#undef PG8_BAR
#undef PG8_SCHED
}
}

DI int xcd_order() { const int b = rbidx_(), g8 = (int)gridDim.x >> 3; return (b & 7) * g8 + (b >> 3); }

struct UnitOrder {
  int nunits, G, c, mode, nK, skipctx;
  DI bool next(int i, pg8::Unit& u) const {
    const int L = i * G + c;
    if (L >= nunits) return false;
    if (mode == 0) { u.pm = L >> 3; u.pn = L & 7; u.kq = 0; }
    else if (mode == 1) { const int g = L >> 5, j = L & 31; u.pm = (g >> 1) * 4 + (j >> 3); u.pn = (g & 1) * 8 + (j & 7); u.kq = 0; }
    else { u.kq = L % nK; const int t = L / nK; u.pn = t & 3; u.pm = t >> 2; }
    if (skipctx) u.pm += (u.pm >> 4) + 1;
    return true;
  }
  DI void a_ready(const pg8::Unit&) const {}
  DI void done(const pg8::Unit&) const {}
};

struct EpiIn {
  static constexpr bool PERM = true, AFTER_DRAIN = false;
  bf16_t* Z; float* ZGt; const float* gbias;
  DI void operator()(const pg8::f32x4 (&acc)[2][2][4][2], const pg8::Unit& u, int wr, int wc, int fr, int fq) const {
    const int row0 = u.pm * 256 + wr * 64 + fr, col0 = u.pn * 256 + wc * 32 + 8 * fq;
    const float4 gb0 = *(const float4*)(gbias + 8 * (fq & 1)), gb1 = *(const float4*)(gbias + 8 * (fq & 1) + 4);
#pragma unroll
    for (int ai = 0; ai < 2; ++ai)
#pragma unroll
      for (int m = 0; m < 4; ++m) {
        const int row = row0 + ai * 128 + m * 16;
        bf16_t* rowp = Z + (size_t)row * ZW + col0;
#pragma unroll
        for (int bj = 0; bj < 2; ++bj) {
          const pg8::f32x4 v0 = acc[ai][bj][m][0], v1 = acc[ai][bj][m][1];
          u32x4 w; w[0] = pack2(v0[0], v0[1]); w[1] = pack2(v0[2], v0[3]); w[2] = pack2(v1[0], v1[1]); w[3] = pack2(v1[2], v1[3]);
          *(u32x4*)(rowp + bj * 128) = w;
          const int c = col0 + bj * 128;
          if (c >= ZG && c < ZG + 16) {
            float* gp = ZGt + (size_t)row * 16 + (c - ZG);
            *(float4*)gp = make_float4(v0[0] + gb0.x, v0[1] + gb0.y, v0[2] + gb0.z, v0[3] + gb0.w);
            *(float4*)(gp + 4) = make_float4(v1[0] + gb1.x, v1[1] + gb1.y, v1[2] + gb1.z, v1[3] + gb1.w);
          }
        }
      }
  }
};

struct EpiFf1 {
  static constexpr bool PERM = true, AFTER_DRAIN = false;
  bf16_t* H;
  DI void operator()(const pg8::f32x4 (&acc)[2][2][4][2], const pg8::Unit& u, int wr, int wc, int fr, int fq) const {
    const int row0 = u.pm * 256 + wr * 64 + fr, col0 = u.pn * 256 + wc * 32 + 8 * fq;
#pragma unroll
    for (int ai = 0; ai < 2; ++ai)
#pragma unroll
      for (int m = 0; m < 4; ++m) {
        bf16_t* rowp = H + (size_t)(row0 + ai * 128 + m * 16) * DFF + col0;
#pragma unroll
        for (int bj = 0; bj < 2; ++bj) {
          pg8::f32x4 v0 = acc[ai][bj][m][0], v1 = acc[ai][bj][m][1];
#pragma unroll
          for (int j = 0; j < 4; ++j) { const float a = fmaxf(v0[j], 0.f), b = fmaxf(v1[j], 0.f); v0[j] = a * a; v1[j] = b * b; }
          u32x4 w; w[0] = pack2(v0[0], v0[1]); w[1] = pack2(v0[2], v0[3]); w[2] = pack2(v1[0], v1[1]); w[3] = pack2(v1[2], v1[3]);
          *(u32x4*)(rowp + bj * 128) = w;
        }
      }
  }
};

struct EpiResid {
  static constexpr bool PERM = false, AFTER_DRAIN = false;
  float* X; const float* gate_l;
  DI void operator()(const pg8::f32x4 (&acc)[2][2][4][2], const pg8::Unit& u, int wr, int wc, int fr, int fq) const {
    const int row0 = u.pm * 256 + wr * 64 + fr, col0 = u.pn * 256 + wc * 32 + 4 * fq;
    const float* gate = gate_l + (size_t)mod_stream(u.pm * 256) * 6144;
    pg8::f32x4 gv[2][2];
#pragma unroll
    for (int bj = 0; bj < 2; ++bj)
#pragma unroll
      for (int n = 0; n < 2; ++n) gv[bj][n] = *(const pg8::f32x4*)(gate + col0 + bj * 128 + n * 16);
#pragma unroll
    for (int ai = 0; ai < 2; ++ai)
#pragma unroll
      for (int m = 0; m < 4; ++m) {
        float* rowp = X + (size_t)(row0 + ai * 128 + m * 16) * DM + col0;
#pragma unroll
        for (int bj = 0; bj < 2; ++bj)
#pragma unroll
          for (int n = 0; n < 2; ++n) {
            pg8::f32x4* xp = (pg8::f32x4*)(rowp + bj * 128 + n * 16);
            *xp = *xp + gv[bj][n] * acc[ai][bj][m][n];
          }
        asm volatile("" ::: "memory");
      }
  }
};

DI void phase_gemm_in(CPARAMS p, int l, unsigned char* smem, unsigned char* hs) {
  pg8::Gemm g; g.A = p.U; g.Bt = p.Wb_in; g.K = DM; g.ld = DM;
  UnitOrder S; S.nunits = 68 * 8; S.G = (int)gridDim.x; S.c = xcd_order(); S.mode = 0; S.nK = 1; S.skipctx = 0;
  EpiIn E; E.Z = p.Z; E.ZGt = p.ZGt; E.gbias = p.gate_bias + l * 16;
  pg8::gemm_phase((PG8_LAS unsigned char*)smem, g, S, E);
  const int G = (int)gridDim.x, rounds = (544 + G - 1) / G, busy = 544 - (rounds - 1) * G;
  const int nfree = G - busy;
  __syncthreads();
  if (nfree > 0) {
    if (S.c >= busy) {
      const int hv = (S.c - busy) * 2 + hidx_(), nh = nfree * 2;
      for (int it = hv; it < WC_LATE; it += nh) wconv_item(p, l, WC_EARLY + it, (float*)hs);
    }
  } else {
    for (int it = bidx_(); it < WC_LATE; it += VGRID) wconv_item(p, l, WC_EARLY + it, (float*)hs);
  }
}
DI void phase_gemm_ff1(CPARAMS p, int skipctx, unsigned char* smem) {
  pg8::Gemm g; g.A = p.U; g.Bt = p.Wb_ff1; g.K = DM; g.ld = DM;
  UnitOrder S; S.nunits = (skipctx ? 64 : 68) * 16; S.G = (int)gridDim.x; S.c = xcd_order(); S.mode = 1; S.nK = 1; S.skipctx = skipctx;
  EpiFf1 E; E.H = p.H;
  pg8::gemm_phase((PG8_LAS unsigned char*)smem, g, S, E);
}
DI void phase_gemm_resid_left(CPARAMS p, int l, const bf16_t* A, int K, const bf16_t* Wt, int gate_chunk, int first_tile, int ntiles, int skipctx, unsigned char* smem);
DI void phase_gemm_resid(CPARAMS p, int l, const bf16_t* A, int K, const bf16_t* Wt, int gate_chunk, int skipctx, unsigned char* smem) {
  const int G = (int)gridDim.x;
  const int ntiles = skipctx ? 256 : 272;
  const int whole = (ntiles / G) * G;
  pg8::Gemm g; g.A = A; g.Bt = Wt; g.K = K; g.ld = K;
  UnitOrder S; S.nunits = whole; S.G = G; S.c = xcd_order(); S.mode = 2; S.nK = 1; S.skipctx = skipctx;
  EpiResid E; E.X = p.X; E.gate_l = p.MOD + (size_t)l * 5 * 6144 + gate_chunk * 1024;
  pg8::gemm_phase((PG8_LAS unsigned char*)smem, g, S, E);
  __syncthreads();
  phase_gemm_resid_left(p, l, A, K, Wt, gate_chunk, whole, ntiles, skipctx, smem);
}

template <class Epi>
DI void gemm256s(const bf16_t* __restrict__ A, int lda, const bf16_t* __restrict__ B, int ldb, int kt0, int kt1, bf16_t* sm, Epi&& epi) {
  const int tid = tfull_(), lane = tid & 63, w = tid >> 6, wp = w >> 2, wq = w & 3, l32 = lane & 31, hh = lane >> 5;
  bf16_t* sA = sm;
  bf16_t* sB = sm + 2 * 256 * LDT;
  f32x16 acc[4][2];
#pragma unroll
  for (int i = 0; i < 4; ++i)
#pragma unroll
    for (int j = 0; j < 2; ++j) acc[i][j] = zero16();
  const int lrow = tid >> 3, kc = (tid & 7) * 8;
  const bf16_t* gA = A + (size_t)lrow * lda + kc;
  const bf16_t* gB = B + (size_t)lrow * ldb + kc;
  u32x4 ra[4], rb[4];
#pragma unroll
  for (int i = 0; i < 4; ++i) {
    ra[i] = *(const u32x4*)(gA + (size_t)(64 * i) * lda + kt0 * 64);
    rb[i] = *(const u32x4*)(gB + (size_t)(64 * i) * ldb + kt0 * 64);
  }
#pragma unroll
  for (int i = 0; i < 4; ++i) {
    *(u32x4*)(sA + (lrow + 64 * i) * LDT + kc) = ra[i];
    *(u32x4*)(sB + (lrow + 64 * i) * LDT + kc) = rb[i];
  }
  __syncthreads();
#pragma unroll 1
  for (int kt = kt0; kt < kt1; ++kt) {
    const int cur = (kt - kt0) & 1;
    if (kt + 1 < kt1) {
#pragma unroll
      for (int i = 0; i < 4; ++i) {
        ra[i] = *(const u32x4*)(gA + (size_t)(64 * i) * lda + (kt + 1) * 64);
        rb[i] = *(const u32x4*)(gB + (size_t)(64 * i) * ldb + (kt + 1) * 64);
      }
    }
    const bf16_t* cA = sA + cur * 256 * LDT + (128 * wp + l32) * LDT + 8 * hh;
    const bf16_t* cB = sB + cur * 256 * LDT + (64 * wq + l32) * LDT + 8 * hh;
#pragma unroll
    for (int ks = 0; ks < 4; ++ks) {
      const bf16x8 b0 = ldfrag(cB + ks * 16), b1 = ldfrag(cB + 32 * LDT + ks * 16);
#pragma unroll
      for (int mi = 0; mi < 4; ++mi) {
        const bf16x8 a = ldfrag(cA + mi * 32 * LDT + ks * 16);
        acc[mi][0] = mfma(a, b0, acc[mi][0]);
        acc[mi][1] = mfma(a, b1, acc[mi][1]);
      }
    }
    if (kt + 1 < kt1) {
      const int nx = cur ^ 1;
#pragma unroll
      for (int i = 0; i < 4; ++i) {
        *(u32x4*)(sA + nx * 256 * LDT + (lrow + 64 * i) * LDT + kc) = ra[i];
        *(u32x4*)(sB + nx * 256 * LDT + (lrow + 64 * i) * LDT + kc) = rb[i];
      }
    }
    __syncthreads();
  }
  epi(acc);
}

DI void phase_gemm_resid_left(CPARAMS p, int l, const bf16_t* A, int K, const bf16_t* Wt, int gate_chunk, int first_tile, int ntiles, int skipctx, unsigned char* smem) {
  const int tid = tfull_(), lane = tid & 63, w = tid >> 6, wp = w >> 2, wq = w & 3, l32 = lane & 31, hh = lane >> 5;
  const int KT = K >> 6;
  const long total = (long)(ntiles - first_tile) * KT;
  const int vb = xcd_order();
  long u = total * vb / (int)gridDim.x;
  const long uend = total * (vb + 1) / (int)gridDim.x;
  while (u < uend) {
    const int trel = (int)(u / KT), kt0 = (int)(u - (long)trel * KT);
    const int kt1 = (int)((uend - (long)trel * KT) < KT ? (uend - (long)trel * KT) : KT);
    const int tile = first_tile + trel;
    int mt = tile >> 2; const int nt = tile & 3;
    if (skipctx) mt += (mt >> 4) + 1;
    const int s = mod_stream(mt * 256);
    const float* gate = p.MOD + ((size_t)l * 5 + s) * 6144 + gate_chunk * 1024;
    gemm256s(A + (size_t)mt * 256 * K, K, Wt + (size_t)nt * 256 * K, K, kt0, kt1, (bf16_t*)smem, [&](f32x16 (&acc)[4][2]) {
#pragma unroll
      for (int mi = 0; mi < 4; ++mi)
#pragma unroll
        for (int ni = 0; ni < 2; ++ni) {
          const int col = nt * 256 + 64 * wq + 32 * ni + l32;
          const float g = gate[col];
#pragma unroll
          for (int i = 0; i < 16; ++i) {
            const int row = mt * 256 + 128 * wp + 32 * mi + crow(i, hh);
            unsafeAtomicAdd(p.X + (size_t)row * DM + col, g * acc[mi][ni][i]);
          }
        }
    });
    u += kt1 - kt0;
  }
}

DI void mla_krope_item(CPARAMS p, int mt, unsigned char* smem) {
  const int tid = tidx_(), lane = tid & 63, w = tid >> 6, wp = w >> 1, wq = w & 1, l32 = lane & 31, hh = lane >> 5;
  float* rsq = (float*)(smem + 73728);
  float* rskv = rsq + 128;
  const int row0 = mt * 128;
  const int b = row0 / TP, pos0 = row0 - b * TP;
  const bool latent = pos0 >= TC;
  __syncthreads();
  {
    const int tok = tid >> 1, half = tid & 1;
    const bf16_t* zr = p.Z + (size_t)(row0 + tok) * ZW;
    const int pos = pos0 + tok;
    const int t_lat = pos - TC;
    const float coord = half == 0 ? (float)(t_lat >> 6) : (float)(t_lat & 63);
    u32x4 x1v[2], x2v[2], o1v[2], o2v[2];
    x1v[0] = *(const u32x4*)(zr + ZKR + 16 * half); x1v[1] = *(const u32x4*)(zr + ZKR + 16 * half + 8);
    x2v[0] = *(const u32x4*)(zr + ZKR + 32 + 16 * half); x2v[1] = *(const u32x4*)(zr + ZKR + 32 + 16 * half + 8);
#pragma unroll
    for (int q = 0; q < 2; ++q)
#pragma unroll
      for (int jj = 0; jj < 4; ++jj) {
        const unsigned a1 = x1v[q][jj], a2 = x2v[q][jj];
        float cs0 = 1.f, sn0 = 0.f, cs1 = 1.f, sn1 = 0.f;
        if (latent) {
          const int j = 8 * q + 2 * jj;
          const float ang0 = coord * ex2(-(float)j * (13.287712379549449f / 16.f));
          const float ang1 = coord * ex2(-(float)(j + 1) * (13.287712379549449f / 16.f));
          cs0 = __cosf(ang0); sn0 = __sinf(ang0); cs1 = __cosf(ang1); sn1 = __sinf(ang1);
        }
        const float p0 = bflo(a1), p1 = bfhi(a1), r0 = bflo(a2), r1 = bfhi(a2);
        o1v[q][jj] = pack2(p0 * cs0 - r0 * sn0, p1 * cs1 - r1 * sn1);
        o2v[q][jj] = pack2(p0 * sn0 + r0 * cs0, p1 * sn1 + r1 * cs1);
      }
#pragma unroll
    for (int hd = 0; hd < 4; ++hd) {
      bf16_t* kd = p.Kb + ((size_t)(b * 4 + hd) * TP + pos) * 192 + 128 + 16 * half;
      *(u32x4*)(kd) = o1v[0];
      *(u32x4*)(kd + 8) = o1v[1];
      *(u32x4*)(kd + 32) = o2v[0];
      *(u32x4*)(kd + 40) = o2v[1];
    }
  }
  (void)rsq; (void)rskv; (void)wp; (void)wq; (void)l32; (void)hh;
}

DI void mla_q_item(CPARAMS p, int mt, int nt, unsigned char* smem) {
  const int tid = tidx_(), lane = tid & 63, w = tid >> 6, wp = w >> 1, wq = w & 1, l32 = lane & 31, hh = lane >> 5;
  float* rsq = (float*)(smem + 73728);
  float* rskv = rsq + 128;
  const int row0 = mt * 128;
  const int b = row0 / TP, pos0 = row0 - b * TP;
  const bool latent = pos0 >= TC;
  __syncthreads();
  {
    const int tok = tid >> 1, half = tid & 1;
    const bf16_t* zr = p.Z + (size_t)(row0 + tok) * ZW;
    float ss = 0.f;
#pragma unroll
    for (int i = 0; i < 16; ++i) {
      const uint4 u = *(const uint4*)(zr + ZQ + 128 * half + 8 * i);
      float a;
      a = bflo(u.x); ss += a * a; a = bfhi(u.x); ss += a * a; a = bflo(u.y); ss += a * a; a = bfhi(u.y); ss += a * a;
      a = bflo(u.z); ss += a * a; a = bfhi(u.z); ss += a * a; a = bflo(u.w); ss += a * a; a = bfhi(u.w); ss += a * a;
    }
    ss += __shfl_xor(ss, 1, 64);
    if (half == 0) rsq[tok] = rsqrtf(ss * (1.f / 256.f) + EPSF);
  }
  __syncthreads();
  {
    gemm128(p.Z + (size_t)row0 * ZW + ZQ, ZW, p.Wb_uq + (size_t)nt * 128 * 256, 256, 256, (bf16_t*)smem, [&](f32x16 (&acc)[2][2]) {
      {
        const int hd = nt < 4 ? nt : 2 * (nt - 4) + wq;
#pragma unroll
        for (int mi = 0; mi < 2; ++mi)
#pragma unroll
          for (int ni = 0; ni < 2; ++ni) {
            const int d = nt < 4 ? 64 * wq + 32 * ni + l32 : 128 + 32 * ni + l32;
#pragma unroll
            for (int i = 0; i < 16; ++i) {
              const int rl = 64 * wp + 32 * mi + crow(i, hh);
              p.Qb[((size_t)(b * 4 + hd) * TP + pos0 + rl) * 192 + d] = f2bf(acc[mi][ni][i] * rsq[rl] * QSCALE);
            }
          }
      }
    });
  }
  (void)latent; (void)rskv;
}

DI void mla_kv_item(CPARAMS p, int mt, int nt, unsigned char* smem) {
  const int tid = tidx_(), lane = tid & 63, w = tid >> 6, wp = w >> 1, wq = w & 1, l32 = lane & 31, hh = lane >> 5;
  float* rsq = (float*)(smem + 73728);
  float* rskv = rsq + 128;
  const int row0 = mt * 128;
  const int b = row0 / TP, pos0 = row0 - b * TP;
  const bool latent = pos0 >= TC;
  __syncthreads();
  {
    const int tok = tid >> 1, half = tid & 1;
    const bf16_t* zr = p.Z + (size_t)(row0 + tok) * ZW;
    float s2 = 0.f;
#pragma unroll
    for (int i = 0; i < 8; ++i) {
      const uint4 u = *(const uint4*)(zr + ZKV + 64 * half + 8 * i);
      float a;
      a = bflo(u.x); s2 += a * a; a = bfhi(u.x); s2 += a * a; a = bflo(u.y); s2 += a * a; a = bfhi(u.y); s2 += a * a;
      a = bflo(u.z); s2 += a * a; a = bfhi(u.z); s2 += a * a; a = bflo(u.w); s2 += a * a; a = bfhi(u.w); s2 += a * a;
    }
    s2 += __shfl_xor(s2, 1, 64);
    if (half == 0) rskv[tok] = rsqrtf(s2 * (1.f / 128.f) + EPSF);
  }
  __syncthreads();
  {
    gemm128(p.Z + (size_t)row0 * ZW + ZKV, ZW, p.Wb_ukv + (size_t)nt * 128 * 128, 128, 128, (bf16_t*)smem, [&](f32x16 (&acc)[2][2]) {
      if (nt < 4) {
#pragma unroll
        for (int mi = 0; mi < 2; ++mi)
#pragma unroll
          for (int ni = 0; ni < 2; ++ni) {
            const int d = 64 * wq + 32 * ni + l32;
#pragma unroll
            for (int i = 0; i < 16; ++i) {
              const int rl = 64 * wp + 32 * mi + crow(i, hh);
              p.Kb[((size_t)(b * 4 + nt) * TP + pos0 + rl) * 192 + d] = f2bf(acc[mi][ni][i] * rskv[rl]);
            }
          }
      } else {
        const int hd = nt - 4;
#pragma unroll
        for (int mi = 0; mi < 2; ++mi)
#pragma unroll
          for (int ni = 0; ni < 2; ++ni) {
            const int dv = 64 * wq + 32 * ni + l32;
            bf16_t* vd = p.Vt + ((size_t)(b * 4 + hd) * 128 + dv) * TP + pos0;
#pragma unroll
            for (int g = 0; g < 4; ++g) {
              const int rl = 64 * wp + 32 * mi + 8 * g + 4 * hh;
              const int ppos = 64 * wp + 32 * mi + 16 * (g >> 1) + 8 * hh + 4 * (g & 1);
              uint2 o;
              o.x = pack2(acc[mi][ni][4 * g] * rskv[rl], acc[mi][ni][4 * g + 1] * rskv[rl + 1]);
              o.y = pack2(acc[mi][ni][4 * g + 2] * rskv[rl + 2], acc[mi][ni][4 * g + 3] * rskv[rl + 3]);
              *(uint2*)(vd + ppos) = o;
            }
          }
      }
    });
  }
  (void)latent; (void)rsq;
}

DI void attn_item(CPARAMS p, int b, int hd, int q0, int nkt, unsigned char* smem) {
  const int tid = tidx_(), lane = tid & 63, w = tid >> 6, l32 = lane & 31, hh = lane >> 5;
  bf16_t* sK = (bf16_t*)smem;
  bf16_t* sV = sK + 2 * 64 * 200;
  const size_t bh = (size_t)(b * 4 + hd);
  bf16x8 qf[12];
  {
    const bf16_t* Qg = p.Qb + (bh * TP + q0 + 32 * w + l32) * 192 + 8 * hh;
#pragma unroll
    for (int ks = 0; ks < 12; ++ks) qf[ks] = ldfrag(Qg + 16 * ks);
    if (q0 >= TC) {
      const int t_lat = q0 - TC + 32 * w + l32;
#pragma unroll
      for (int kq = 0; kq < 2; ++kq) {
        const float coord = kq == 0 ? (float)(t_lat >> 6) : (float)(t_lat & 63);
        const u32x4 a1 = __builtin_bit_cast(u32x4, qf[8 + kq]), a2 = __builtin_bit_cast(u32x4, qf[10 + kq]);
        u32x4 n1, n2;
#pragma unroll
        for (int jj = 0; jj < 4; ++jj) {
          const int j = 8 * hh + 2 * jj;
          const float ang0 = coord * ex2(-(float)j * (13.287712379549449f / 16.f));
          const float ang1 = coord * ex2(-(float)(j + 1) * (13.287712379549449f / 16.f));
          const float cs0 = __cosf(ang0), sn0 = __sinf(ang0), cs1 = __cosf(ang1), sn1 = __sinf(ang1);
          const float p0 = bflo(a1[jj]), p1 = bfhi(a1[jj]), r0 = bflo(a2[jj]), r1 = bfhi(a2[jj]);
          n1[jj] = pack2(p0 * cs0 - r0 * sn0, p1 * cs1 - r1 * sn1);
          n2[jj] = pack2(p0 * sn0 + r0 * cs0, p1 * sn1 + r1 * cs1);
        }
        qf[8 + kq] = __builtin_bit_cast(bf16x8, n1);
        qf[10 + kq] = __builtin_bit_cast(bf16x8, n2);
      }
    }
  }
  const bf16_t* Kg = p.Kb + bh * TP * 192;
  const bf16_t* Vg = p.Vt + bh * 128 * TP;
  typedef __attribute__((address_space(3))) unsigned lds_u32;
  const int hoff = hidx_();
  const int w8 = __builtin_amdgcn_readfirstlane(w + 4 * hoff);
  lds_u32* sKl = (lds_u32*)sK;
  lds_u32* sVl = (lds_u32*)sV;
#define ATT_LOAD_K(T)                                                                             \
  _Pragma("unroll") for (int i = 0; i < 4; ++i) {                                                 \
    const int ch = w8 + 8 * i;                                                                    \
    if (ch < 25) {                                                                                \
      const int ob = ch * 1024 + lane * 16, row = ob / 400, cb = ob - row * 400;                  \
      const bf16_t* sp = Kg + (size_t)(T) * (64 * 192) + (cb < 384 ? row * 192 + (cb >> 1) : 0);  \
      __builtin_amdgcn_global_load_lds((const unsigned*)sp, sKl + ((T) & 1) * 6400 + ch * 256, 16, 0, 0); \
    }                                                                                             \
  }
#define ATT_LOAD_V(T)                                                                             \
  _Pragma("unroll") for (int i = 0; i < 3; ++i) {                                                 \
    const int ch = w8 + 8 * i;                                                                    \
    if (ch < 18) {                                                                                \
      const int ob = ch * 1024 + lane * 16, row = ob / 144, cb = ob - row * 144;                  \
      const bf16_t* sp = Vg + 64 * (T) + (cb < 128 ? (size_t)row * TP + (cb >> 1) : 0);          \
      __builtin_amdgcn_global_load_lds((const unsigned*)sp, sVl + ((T) & 1) * 4608 + ch * 256, 16, 0, 0); \
    }                                                                                             \
  }
#define ATT_RD1(D, A, OFF) asm volatile("ds_read_b128 %0, %1 offset:%2" : "=v"(D) : "v"(A), "n"(OFF))
#define ATT_RD4(F, A, O0, O1, O2, O3) do { ATT_RD1(F[0], A, O0); ATT_RD1(F[1], A, O1); ATT_RD1(F[2], A, O2); ATT_RD1(F[3], A, O3); } while (0)
#define ATT_RD2(F, A, O0, O1) do { ATT_RD1(F[0], A, O0); ATT_RD1(F[1], A, O1); } while (0)
#define ATT_WAIT2(F, N) asm volatile("s_waitcnt lgkmcnt(%2)" : "+v"(F[0]), "+v"(F[1]) : "n"(N))
#define ATT_WAIT4(F, N) asm volatile("s_waitcnt lgkmcnt(%4)" : "+v"(F[0]), "+v"(F[1]), "+v"(F[2]), "+v"(F[3]) : "n"(N))
  const unsigned kaddr0 = (unsigned)(size_t)(sK + l32 * 200 + 8 * hh);
  const unsigned vaddr0 = (unsigned)(size_t)(sV + l32 * LDT + 8 * hh);
  __syncthreads();
  ATT_LOAD_K(0);
  asm volatile("s_waitcnt vmcnt(0)" ::: "memory");
  for (int i = tfull_(); i < 2 * 18432 / 16; i += 512) ((u32x4*)sV)[i] = (u32x4){0u, 0u, 0u, 0u};
  f32x16 o[4];
#pragma unroll
  for (int i = 0; i < 4; ++i) o[i] = zero16();
  f32x16 sX = zero16(), sY = zero16();
  bf16x8 pX[2], pY[2];
  pX[0] = (bf16x8){0, 0, 0, 0, 0, 0, 0, 0}; pX[1] = pX[0]; pY[0] = pX[0]; pY[1] = pX[0];
  float m = -1e30f, lsum = 0.f;
  __syncthreads();
#define ATT_EXP2(SV, J0, J1) { SV[J0] = ex2(SV[J0] - m); SV[J1] = ex2(SV[J1] - m); ps += SV[J0] + SV[J1]; }
#define ATT_QK(F, G, SO_) { SO_ = mfma(F[0], qf[2 * (G)], SO_); SO_ = mfma(F[1], qf[2 * (G) + 1], SO_); }
#define ATT_PV(F, P_, PI_) { o[2 * ((P_) & 1)] = mfma(F[0], PI_[(P_) >> 1], o[2 * ((P_) & 1)]); o[2 * ((P_) & 1) + 1] = mfma(F[1], PI_[(P_) >> 1], o[2 * ((P_) & 1) + 1]); }
#define ATT_RDK(F, G, KB) ATT_RD2(F, kaddr, (KB) * 12800 + 64 * (G), (KB) * 12800 + 64 * (G) + 32)
#define ATT_RDV(F, P_, KB) ATT_RD2(F, vaddr, 2 * ((P_) & 1) * 4608 + (KB) * 64 + ((P_) >> 1) * 32, (2 * ((P_) & 1) + 1) * 4608 + (KB) * 64 + ((P_) >> 1) * 32)
#define ATT_STEP(J, KB, SI, SO, PI, PO)                                                                           \
  {                                                                                                               \
    const int jj = (J), T = jj >> 1;                                                                              \
    if ((KB) == 0) {                                                                                              \
      if (T + 1 < nkt) { ATT_LOAD_K(T + 1); }                                                                     \
      if (T < nkt) { ATT_LOAD_V(T); }                                                                             \
    }                                                                                                             \
    const unsigned kaddr = kaddr0 + (T & 1) * 25600, vaddr = vaddr0 + ((T + 1) & 1) * 18432;                      \
    const bool valid = jj >= 1 && jj <= 2 * nkt;                                                                  \
    float tmax = SI[0];                                                                                           \
    _Pragma("unroll") for (int q = 1; q < 16; ++q) tmax = fmaxf(tmax, SI[q]);                                     \
    tmax = fmaxf(tmax, xhalf(tmax));                                                                              \
    const bool need = valid && (tmax > m + 8.f);                                                                  \
    const float mn = need ? tmax : m;                                                                             \
    const float alpha = ex2(m - mn);                                                                              \
    m = mn;                                                                                                       \
    float ps = 0.f;                                                                                               \
    SO = zero16();                                                                                                \
    bf16x8 fa[2], fb[2], fc[2];                                                                                   \
    ATT_RDK(fa, 0, KB); ATT_RDK(fb, 1, KB);                                                                       \
    ATT_RDK(fc, 2, KB); ATT_WAIT2(fa, 4); ATT_QK(fa, 0, SO); ATT_EXP2(SI, 0, 1);                                      \
    ATT_RDK(fa, 3, KB); ATT_WAIT2(fb, 4); ATT_QK(fb, 1, SO); ATT_EXP2(SI, 2, 3);                                      \
    ATT_RDK(fb, 4, KB); ATT_WAIT2(fc, 4); ATT_QK(fc, 2, SO); ATT_EXP2(SI, 4, 5);                                      \
    ATT_RDK(fc, 5, KB); ATT_WAIT2(fa, 4); ATT_QK(fa, 3, SO); ATT_EXP2(SI, 6, 7);                                      \
    ATT_RDV(fa, 0, KB); ATT_WAIT2(fb, 4); ATT_QK(fb, 4, SO); ATT_EXP2(SI, 8, 9);                                      \
    ATT_RDV(fb, 1, KB); ATT_WAIT2(fc, 4); ATT_QK(fc, 5, SO); ATT_EXP2(SI, 10, 11);                                    \
    ATT_RDV(fc, 2, KB); ATT_WAIT2(fa, 4); ATT_PV(fa, 0, PI); ATT_EXP2(SI, 12, 13);                                    \
    ATT_RDV(fa, 3, KB); ATT_WAIT2(fb, 4); ATT_PV(fb, 1, PI); ATT_EXP2(SI, 14, 15);                                    \
    ATT_WAIT2(fc, 2); ATT_PV(fc, 2, PI);                                                                              \
    if (valid) {                                                                                                  \
      PO[0] = pack8(SI[0], SI[1], SI[2], SI[3], SI[4], SI[5], SI[6], SI[7]);                                      \
      PO[1] = pack8(SI[8], SI[9], SI[10], SI[11], SI[12], SI[13], SI[14], SI[15]);                                \
      lsum = lsum * alpha + ps;                                                                                   \
    }                                                                                                             \
    ATT_WAIT2(fa, 0); ATT_PV(fa, 3, PI);                                                                              \
    if (__builtin_amdgcn_ballot_w64(need) != 0ull) {                                                              \
      _Pragma("unroll") for (int dt = 0; dt < 4; ++dt)                                                            \
        _Pragma("unroll") for (int q = 0; q < 16; ++q) o[dt][q] *= alpha;                                         \
    }                                                                                                             \
    if ((KB) == 1) {                                                                                              \
      asm volatile("s_waitcnt vmcnt(0)" ::: "memory");                                                            \
      __syncthreads();                                                                                            \
    }                                                                                                             \
  }
#pragma unroll 1
  for (int j = 0; j <= 2 * nkt; j += 2) {
    ATT_STEP(j, 0, sX, sY, pX, pY);
    ATT_STEP(j + 1, 1, sY, sX, pY, pX);
  }
#undef ATT_STEP
#undef ATT_EXP2
#undef ATT_QK
#undef ATT_PV
#undef ATT_RDK
#undef ATT_RDV
#undef ATT_LOAD_K
#undef ATT_LOAD_V
#undef ATT_RD1
#undef ATT_RD4
#undef ATT_RD2
#undef ATT_WAIT2
#undef ATT_WAIT4
  lsum += xhalf(lsum);
  const float inv = 1.f / lsum;
  bf16_t* od = p.U + ((size_t)b * TP + q0 + 32 * w + l32) * DM + hd * 128 + 4 * hh;
#pragma unroll
  for (int dt = 0; dt < 4; ++dt)
#pragma unroll
    for (int g = 0; g < 4; ++g) {
      uint2 u;
      u.x = pack2(o[dt][4 * g] * inv, o[dt][4 * g + 1] * inv);
      u.y = pack2(o[dt][4 * g + 2] * inv, o[dt][4 * g + 3] * inv);
      *(uint2*)(od + 32 * dt + 8 * g) = u;
    }
}

DI float masked_sum128(const float* v, int lo, int hi, float& total) {
  float acc = 0.f, tot = 0.f;
#pragma unroll 8
  for (int u4 = 0; u4 < 32; ++u4) {
    const float4 x = *(const float4*)(v + 4 * u4);
    const int u = 4 * u4;
    tot += (x.x + x.y) + (x.z + x.w);
    acc += ((u >= lo && u <= hi) ? x.x : 0.f) + ((u + 1 >= lo && u + 1 <= hi) ? x.y : 0.f)
         + ((u + 2 >= lo && u + 2 <= hi) ? x.z : 0.f) + ((u + 3 >= lo && u + 3 <= hi) ? x.w : 0.f);
  }
  total = tot;
  return acc;
}
DI float masked_max128(const float* v, int lo, int hi) {
  float acc = -1e30f;
#pragma unroll 8
  for (int u4 = 0; u4 < 32; ++u4) {
    const float4 x = *(const float4*)(v + 4 * u4);
    const int u = 4 * u4;
    acc = fmaxf(acc, fmaxf(fmaxf((u >= lo && u <= hi) ? x.x : -1e30f, (u + 1 >= lo && u + 1 <= hi) ? x.y : -1e30f),
                           fmaxf((u + 2 >= lo && u + 2 <= hi) ? x.z : -1e30f, (u + 3 >= lo && u + 3 <= hi) ? x.w : -1e30f)));
  }
  return acc;
}
DI float log_sigmoid_(float x) { return fminf(x, 0.f) - log1pf(fexp(-fabsf(x))); }

DI void mlstm_local_item(CPARAMS p, int bh, int ck, unsigned char* smem) {
  const int tid = tidx_(), lane = tid & 63, w = tid >> 6, l32 = lane & 31, hh = lane >> 5;
  const int b = bh >> 2, hd = bh & 3;
  bf16_t* sKt = (bf16_t*)smem;
  bf16_t* sVf = sKt + 64 * 136;
  bf16_t* sVb = sVf + 64 * 136;
  float* slf = (float*)(sVb + 64 * 136);
  float* sg = slf + 256;
  float* sw = sg + 256;
  float* snp = sw + 256;
  const int row0 = b * TP + ck * 128;
  const int dir = tid >> 7, tok = tid & 127;
  __syncthreads();
  const float* zg = p.ZGt + (size_t)(row0 + tok) * 16;
  const float ipre = zg[dir * 8 + hd];
  slf[dir * 128 + tok] = log_sigmoid_(zg[dir * 8 + 4 + hd]);
  __syncthreads();
  const int plo = dir == 0 ? 0 : tok, phi = dir == 0 ? tok : 127;
  float tot;
  const float bc = masked_sum128(slf + dir * 128, plo, phi, tot);
  const float g = tot - bc + ipre;
  sg[dir * 128 + tok] = g;
  __syncthreads();
  const float mloc = masked_max128(sg + dir * 128, 0, 127);
  sw[dir * 128 + tok] = fexp(g - mloc);
  __syncthreads();
#pragma unroll
  for (int i = 0; i < 4; ++i) {
    const int c = tid + 256 * i, tk = c >> 3, f8 = (c & 7) * 8;
    const bf16_t* zr = p.Z + (size_t)(row0 + tk) * ZW + 64 * hd + f8;
    const uint4 ku = *(const uint4*)(zr + ZMK);
    const uint4 vu = *(const uint4*)(zr + ZMV);
    const unsigned kk[4] = {ku.x, ku.y, ku.z, ku.w}, vv[4] = {vu.x, vu.y, vu.z, vu.w};
    const float wf = sw[tk], wb = sw[128 + tk];
#pragma unroll
    for (int e = 0; e < 4; ++e) {
      sKt[(f8 + 2 * e) * 136 + tk] = (bf16_t)(kk[e] & 0xffffu);
      sKt[(f8 + 2 * e + 1) * 136 + tk] = (bf16_t)(kk[e] >> 16);
      const float v0 = bflo(vv[e]), v1 = bfhi(vv[e]);
      sVf[(f8 + 2 * e) * 136 + tk] = f2bf(v0 * wf);
      sVf[(f8 + 2 * e + 1) * 136 + tk] = f2bf(v1 * wf);
      sVb[(f8 + 2 * e) * 136 + tk] = f2bf(v0 * wb);
      sVb[(f8 + 2 * e + 1) * 136 + tk] = f2bf(v1 * wb);
    }
  }
  __syncthreads();
  const int mi = w >> 1, ni = w & 1;
#pragma unroll
  for (int d = 0; d < 2; ++d) {
    const bf16_t* sV = d ? sVb : sVf;
    f32x16 acc = zero16();
#pragma unroll
    for (int ks = 0; ks < 8; ++ks)
      acc = mfma(ldfrag(sV + (32 * mi + l32) * 136 + 16 * ks + 8 * hh), ldfrag(sKt + (32 * ni + l32) * 136 + 16 * ks + 8 * hh), acc);
    float* rec = p.CST + ((size_t)(bh * 34 + ck) * 2 + d) * CREC;
#pragma unroll
    for (int i = 0; i < 16; ++i) rec[(32 * mi + crow(i, hh)) * 64 + 32 * ni + l32] = acc[i];
  }
  {
    const int dk = tid & 63, part = tid >> 6;
    float nf = 0.f, nb = 0.f;
    for (int s = part * 32; s < part * 32 + 32; ++s) {
      const float kv = bf2f(sKt[dk * 136 + s]);
      nf += sw[s] * kv; nb += sw[128 + s] * kv;
    }
    snp[(part * 2 + 0) * 64 + dk] = nf;
    snp[(part * 2 + 1) * 64 + dk] = nb;
  }
  __syncthreads();
  if (tid < 128) {
    const int d = tid >> 6, dk = tid & 63;
    float* rec = p.CST + ((size_t)(bh * 34 + ck) * 2 + d) * CREC;
    rec[4096 + dk] = snp[(0 * 2 + d) * 64 + dk] + snp[(1 * 2 + d) * 64 + dk] + snp[(2 * 2 + d) * 64 + dk] + snp[(3 * 2 + d) * 64 + dk];
  }
  if (tok == 0) {
    float* rec = p.CST + ((size_t)(bh * 34 + ck) * 2 + dir) * CREC;
    rec[4160] = mloc;
    rec[4161] = tot;
  }
}

DI void phase_mlstm_scan(CPARAMS p) {
  const int total = 32 * 4096;
  for (int idx = bidx_() * 256 + tidx_(); idx < total; idx += VGRID * 256) {
    const int combo = idx >> 12, e = idx & 4095;
    const int bh = combo >> 1, d = combo & 1;
    const bool has2 = e < 64;
    const int e2 = has2 ? 4096 + e : e;
    float* base = p.CST + ((size_t)(bh * 34) * 2 + d) * CREC;
    float loc[34], loc2[34], mloc[34], tot[34];
#pragma unroll
    for (int ck = 0; ck < 34; ++ck) {
      const float* rec = base + (size_t)ck * 2 * CREC;
      loc[ck] = rec[e]; loc2[ck] = rec[e2]; mloc[ck] = rec[4160]; tot[ck] = rec[4161];
    }
    float st = 0.f, st2 = 0.f, m = 0.f;
#pragma unroll
    for (int step = 0; step < 34; ++step) {
      const int ck = d == 0 ? step : (step < 2 ? 1 - step : 35 - step);
      float* rec = base + (size_t)ck * 2 * CREC;
      rec[e] = st;
      if (has2) rec[e2] = st2;
      if (e == 0) rec[4162] = m;
      const float mn = fmaxf(tot[ck] + m, mloc[ck]);
      const float wo = fexp(tot[ck] + m - mn), wl = fexp(mloc[ck] - mn);
      st = wo * st + wl * loc[ck];
      st2 = wo * st2 + wl * loc2[ck];
      m = mn;
    }
  }
}

DI void mlstm_out_item(CPARAMS p, int bh, int ck, unsigned char* smem) {
  const int tid = tidx_(), lane = tid & 63, w = tid >> 6, l32 = lane & 31, hh = lane >> 5;
  const int b = bh >> 2, hd = bh & 3;
  bf16_t* sK = (bf16_t*)smem;
  bf16_t* sVt = sK + 128 * LDT;
  bf16_t* sC = sVt + 64 * 136;
  float* slf = (float*)(sC + 2 * 64 * LDT);
  float* sb = slf + 256;
  float* se = sb + 256;
  float* sM = se + 256;
  float* sn = sM + 256;
  const int row0 = b * TP + ck * 128;
  const float* rec0 = p.CST + ((size_t)(bh * 34 + ck) * 2) * CREC;
  __syncthreads();
  {
    const int dir = tid >> 7, tok = tid & 127;
    const float* zg = p.ZGt + (size_t)(row0 + tok) * 16;
    const float ipre = zg[dir * 8 + hd];
    slf[dir * 128 + tok] = log_sigmoid_(zg[dir * 8 + 4 + hd]);
#pragma unroll
    for (int i = 0; i < 4; ++i) {
      const int c = tid + 256 * i, tk = c >> 3, f8 = (c & 7) * 8;
      const bf16_t* zr = p.Z + (size_t)(row0 + tk) * ZW + 64 * hd + f8;
      *(uint4*)(sK + tk * LDT + f8) = *(const uint4*)(zr + ZMK);
      const uint4 vu = *(const uint4*)(zr + ZMV);
      const unsigned vv[4] = {vu.x, vu.y, vu.z, vu.w};
      const int pk = permk(tk);
#pragma unroll
      for (int e = 0; e < 4; ++e) {
        sVt[(f8 + 2 * e) * 136 + pk] = (bf16_t)(vv[e] & 0xffffu);
        sVt[(f8 + 2 * e + 1) * 136 + pk] = (bf16_t)(vv[e] >> 16);
      }
    }
#pragma unroll
    for (int d = 0; d < 2; ++d) {
      const int dv = tid >> 2, dk0 = (tid & 3) * 16;
      const float* src = rec0 + (size_t)d * CREC + dv * 64 + dk0;
      const float4 f0 = *(const float4*)(src), f1 = *(const float4*)(src + 4), f2 = *(const float4*)(src + 8), f3 = *(const float4*)(src + 12);
      bf16_t* dd = sC + d * 64 * LDT + dv * LDT + dk0;
      *(uint4*)dd = make_uint4(pack2(f0.x, f0.y), pack2(f0.z, f0.w), pack2(f1.x, f1.y), pack2(f1.z, f1.w));
      *(uint4*)(dd + 8) = make_uint4(pack2(f2.x, f2.y), pack2(f2.z, f2.w), pack2(f3.x, f3.y), pack2(f3.z, f3.w));
    }
    if (tid < 128) sn[tid] = rec0[(size_t)(tid >> 6) * CREC + 4096 + (tid & 63)];
    __syncthreads();
    const int plo = dir == 0 ? 0 : tok, phi = dir == 0 ? tok : 127;
    float tot_unused;
    const float bc = masked_sum128(slf + dir * 128, plo, phi, tot_unused);
    sb[dir * 128 + tok] = bc;
    se[dir * 128 + tok] = ipre - bc;
    __syncthreads();
    const float cm = masked_max128(se + dir * 128, plo, phi);
    const float mprev = rec0[(size_t)dir * CREC + 4162];
    sM[dir * 128 + tok] = fmaxf(mprev, cm);
    __syncthreads();
  }
  const int tq = 32 * w + l32;
  bf16x8 qf[4];
  {
    const bf16_t* qg = p.Z + (size_t)(row0 + tq) * ZW + ZMQ + 64 * hd + 8 * hh;
#pragma unroll
    for (int ks = 0; ks < 4; ++ks) qf[ks] = ldfrag(qg + 16 * ks);
  }
  f32x16 hs[2];
  hs[0] = zero16(); hs[1] = zero16();
#pragma unroll
  for (int d = 0; d < 2; ++d) {
    const float mprev = rec0[(size_t)d * CREC + 4162];
    const float Mt = sM[d * 128 + tq], bt = sb[d * 128 + tq];
    const float winter = fexp(mprev - Mt) * 0.125f;
    float qn = 0.f;
#pragma unroll
    for (int ks = 0; ks < 4; ++ks) {
      const uint4 qu = __builtin_bit_cast(uint4, qf[ks]);
      const float* nn = sn + d * 64 + 16 * ks + 8 * hh;
      qn += bflo(qu.x) * nn[0] + bfhi(qu.x) * nn[1] + bflo(qu.y) * nn[2] + bfhi(qu.y) * nn[3]
          + bflo(qu.z) * nn[4] + bfhi(qu.z) * nn[5] + bflo(qu.w) * nn[6] + bfhi(qu.w) * nn[7];
    }
    qn += xhalf(qn);
    f32x16 num[2];
#pragma unroll
    for (int dt = 0; dt < 2; ++dt) {
      f32x16 a = zero16();
#pragma unroll
      for (int ks = 0; ks < 4; ++ks) a = mfma(ldfrag(sC + d * 64 * LDT + (32 * dt + l32) * LDT + 16 * ks + 8 * hh), qf[ks], a);
#pragma unroll
      for (int i = 0; i < 16; ++i) a[i] *= winter;
      num[dt] = a;
    }
    float den = 0.f;
#pragma unroll
    for (int kb = 0; kb < 4; ++kb) {
      const bool active = d == 0 ? (kb <= w) : (kb >= w);
      if (active) {
        f32x16 s = zero16();
#pragma unroll
        for (int ks = 0; ks < 4; ++ks) s = mfma(ldfrag(sK + (32 * kb + l32) * LDT + 16 * ks + 8 * hh), qf[ks], s);
#pragma unroll
        for (int g = 0; g < 4; ++g) {
          const float4 e4 = *(const float4*)(se + d * 128 + 32 * kb + 8 * g + 4 * hh);
          const float ee[4] = {e4.x, e4.y, e4.z, e4.w};
#pragma unroll
          for (int j = 0; j < 4; ++j) {
            const int sidx = 32 * kb + 8 * g + 4 * hh + j;
            const bool ok = d == 0 ? (sidx <= tq) : (sidx >= tq);
            const float arg = ok ? (ee[j] - Mt) : -1e30f;
            const float pv = s[4 * g + j] * (0.125f * fexp(arg));
            s[4 * g + j] = pv;
            den += pv;
          }
        }
#pragma unroll
        for (int s2 = 0; s2 < 2; ++s2) {
          const bf16x8 pb = pack8(s[8 * s2], s[8 * s2 + 1], s[8 * s2 + 2], s[8 * s2 + 3], s[8 * s2 + 4], s[8 * s2 + 5], s[8 * s2 + 6], s[8 * s2 + 7]);
#pragma unroll
          for (int dt = 0; dt < 2; ++dt) num[dt] = mfma(ldfrag(sVt + (32 * dt + l32) * 136 + 32 * kb + 16 * s2 + 8 * hh), pb, num[dt]);
        }
      }
    }
    den += xhalf(den);
    den += winter * qn;
    const float dn = fmaxf(fabsf(den), fexp(-(bt + Mt)));
    const float inv = 1.f / dn;
#pragma unroll
    for (int dt = 0; dt < 2; ++dt)
#pragma unroll
      for (int i = 0; i < 16; ++i) hs[dt][i] += num[dt][i] * inv;
  }
  float ss = 0.f;
#pragma unroll
  for (int dt = 0; dt < 2; ++dt)
#pragma unroll
    for (int i = 0; i < 16; ++i) ss += hs[dt][i] * hs[dt][i];
  ss += xhalf(ss);
  const float rs = rsqrtf(ss * (1.f / 64.f) + EPSF);
  const bf16_t* og = p.Z + (size_t)(row0 + tq) * ZW + ZMO + 64 * hd + 4 * hh;
  bf16_t* od = p.U + (size_t)(row0 + tq) * DM + 512 + 64 * hd + 4 * hh;
#pragma unroll
  for (int dt = 0; dt < 2; ++dt)
#pragma unroll
    for (int g = 0; g < 4; ++g) {
      const uint2 ou = *(const uint2*)(og + 32 * dt + 8 * g);
      uint2 r;
      r.x = pack2(sigmoidf_(bflo(ou.x)) * hs[dt][4 * g] * rs, sigmoidf_(bfhi(ou.x)) * hs[dt][4 * g + 1] * rs);
      r.y = pack2(sigmoidf_(bflo(ou.y)) * hs[dt][4 * g + 2] * rs, sigmoidf_(bfhi(ou.y)) * hs[dt][4 * g + 3] * rs);
      *(uint2*)(od + 32 * dt + 8 * g) = r;
    }
}

DI void lru_local_item(CPARAMS p, int l, int mt, int gd0, unsigned char* smem) {
  const int tid = tidx_(), lane = tid & 63, w = tid >> 6, l32 = lane & 31, hh = lane >> 5;
  bf16_t* sX = (bf16_t*)smem;
  bf16_t* sW = sX + 128 * LDT;
  float* sAa = (float*)smem;
  float* sUu = sAa + 128 * 64;
  const int row0 = mt * 128;
  const int b = row0 / TP, pos0 = row0 - b * TP;
  const int seg_lo = pos0 < TC ? 0 : TC, seg_hi = pos0 < TC ? TC : TP;
  {
    const int gd = gd0;
    const int g = gd >> 1, d = gd & 1;
    __syncthreads();
    {
      const int c8 = (tid & 7) * 8, ch0 = 64 * g + c8;
      float cw[4][8], cb[8];
#pragma unroll
      for (int e = 0; e < 8; ++e) {
        cb[e] = p.conv_b[l * 256 + ch0 + e];
#pragma unroll
        for (int j = 0; j < 4; ++j) cw[j][e] = p.conv_w[(l * 4 + j) * 256 + ch0 + e];
      }
#pragma unroll
      for (int i = 0; i < 4; ++i) {
        const int tk = (tid >> 3) + 32 * i;
        float a[8];
#pragma unroll
        for (int e = 0; e < 8; ++e) a[e] = cb[e];
#pragma unroll
        for (int j = 0; j < 4; ++j) {
          const int ps = pos0 + tk + j - 2;
          const bool inr = ps >= seg_lo && ps < seg_hi;
          const int psc = inr ? ps : pos0 + tk;
          u32x4 u = *(const u32x4*)(p.Z + (size_t)(b * TP + psc) * ZW + ZLX + ch0);
          u[0] = inr ? u[0] : 0u; u[1] = inr ? u[1] : 0u; u[2] = inr ? u[2] : 0u; u[3] = inr ? u[3] : 0u;
          a[0] += bflo(u[0]) * cw[j][0]; a[1] += bfhi(u[0]) * cw[j][1]; a[2] += bflo(u[1]) * cw[j][2]; a[3] += bfhi(u[1]) * cw[j][3];
          a[4] += bflo(u[2]) * cw[j][4]; a[5] += bfhi(u[2]) * cw[j][5]; a[6] += bflo(u[3]) * cw[j][6]; a[7] += bfhi(u[3]) * cw[j][7];
        }
        u32x4 o;
        o[0] = pack2(a[0], a[1]); o[1] = pack2(a[2], a[3]); o[2] = pack2(a[4], a[5]); o[3] = pack2(a[6], a[7]);
        *(u32x4*)(sX + tk * LDT + c8) = o;
        {
          float* xg = p.XS + (size_t)(row0 + tk) * 256 + ch0;
          *(float4*)xg = make_float4(a[0], a[1], a[2], a[3]);
          *(float4*)(xg + 4) = make_float4(a[4], a[5], a[6], a[7]);
        }
      }
#pragma unroll
      for (int i = 0; i < 4; ++i) {
        const int c = tid + 256 * i, r = c >> 3, k8 = (c & 7) * 8;
        *(u32x4*)(sW + r * LDT + k8) = *(const u32x4*)(p.Wb_lru + (size_t)(g * 256 + d * 128 + r) * 64 + k8);
      }
    }
    __syncthreads();
    f32x16 acc[4];
#pragma unroll
    for (int nt = 0; nt < 4; ++nt) acc[nt] = zero16();
#pragma unroll
    for (int ks = 0; ks < 4; ++ks) {
      const bf16x8 a = ldfrag(sX + (32 * w + l32) * LDT + 16 * ks + 8 * hh);
#pragma unroll
      for (int nt = 0; nt < 4; ++nt) acc[nt] = mfma(a, ldfrag(sW + (32 * nt + l32) * LDT + 16 * ks + 8 * hh), acc[nt]);
    }
    __syncthreads();
#pragma unroll
    for (int pt = 0; pt < 2; ++pt) {
      const int chl = 32 * pt + l32, ch = 64 * g + chl;
      const float ba = p.b_a[(l * 2 + d) * 256 + ch], bx = p.b_x[(l * 2 + d) * 256 + ch];
      const float lm = p.lam[(l * 2 + d) * 256 + ch];
      const float spl = fmaxf(-lm, 0.f) + log1pf(fexp(-fabsf(lm)));
#pragma unroll
      for (int i = 0; i < 16; ++i) {
        const int tk = 32 * w + crow(i, hh);
        const float r = sigmoidf_(acc[pt][i] + ba), ig = sigmoidf_(acc[2 + pt][i] + bx);
        const float la = -8.f * r * spl;
        const float a = fexp(la);
        const float u = sqrtf(-expm1f(2.f * la)) * ig * p.XS[(size_t)(row0 + tk) * 256 + ch];
        sAa[tk * 64 + chl] = a;
        sUu[tk * 64 + chl] = u;
      }
    }
    __syncthreads();
    const int chl = tid & 63, sg = tid >> 6;
    {
      float P = 1.f, hv = 0.f;
      float av[32], uv[32];
#pragma unroll
      for (int s = 0; s < 32; ++s) {
        const int tk = d == 0 ? 32 * sg + s : 32 * sg + 31 - s;
        av[s] = sAa[tk * 64 + chl]; uv[s] = sUu[tk * 64 + chl];
      }
#pragma unroll
      for (int s = 0; s < 32; ++s) {
        hv = av[s] * hv + uv[s]; P *= av[s];
        av[s] = P; uv[s] = hv;
      }
#pragma unroll
      for (int s = 0; s < 32; ++s) {
        const int tk = d == 0 ? 32 * sg + s : 32 * sg + 31 - s;
        sAa[tk * 64 + chl] = av[s]; sUu[tk * 64 + chl] = uv[s];
      }
    }
    __syncthreads();
    {
      float cP = 1.f, cH = 0.f;
#pragma unroll
      for (int q = 0; q < 4; ++q) {
        const int sq = d == 0 ? q : 3 - q;
        const bool before = d == 0 ? (sq < sg) : (sq > sg);
        const int tl = d == 0 ? 32 * sq + 31 : 32 * sq;
        const float Pr = sAa[tl * 64 + chl], Hr = sUu[tl * 64 + chl];
        const float Pq = before ? Pr : 1.f, Hq = before ? Hr : 0.f;
        cH = Pq * cH + Hq; cP *= Pq;
      }
      bf16_t* auH = p.AU + ((size_t)(d * 2 + 0) * NTOK + row0) * 256 + 64 * g + chl;
      bf16_t* auP = p.AU + ((size_t)(d * 2 + 1) * NTOK + row0) * 256 + 64 * g + chl;
      float Pl = 1.f, Hl = 0.f;
#pragma unroll
      for (int s = 0; s < 32; ++s) {
        const int tk = d == 0 ? 32 * sg + s : 32 * sg + 31 - s;
        const float pa = sAa[tk * 64 + chl], hu = sUu[tk * 64 + chl];
        Pl = pa * cP;
        Hl = hu + pa * cH;
        auH[(size_t)tk * 256] = f2bf(Hl);
        auP[(size_t)tk * 256] = f2bf(Pl);
      }
      const bool lastseg = d == 0 ? (sg == 3) : (sg == 0);
      if (lastseg) {
        float* ag = p.AGG + ((size_t)(mt * 2 + d) * 2) * 256 + 64 * g + chl;
        ag[0] = Pl; ag[256] = Hl;
      }
    }
  }
}

DI float gelu_tanh_(float x) {
  const float y = 0.7978845608028654f * (x + 0.044715f * x * x * x);
  const float t = 1.f - 2.f / (fexp(2.f * y) + 1.f);
  return 0.5f * x * (1.f + t);
}

DI void lru_out_item(CPARAMS p, int mt, unsigned char* smem) {
  const int tid = tidx_();
  float* scf = (float*)smem;
  float* scb = scf + 256;
  const int row0 = mt * 128;
  const int b = row0 / TP;
  const int tl = mt - b * 34;
  __syncthreads();
  {
    const int ch = tid;
    float cf = 0.f, cb = 0.f;
    {
      float av[34], hv[34];
#pragma unroll
      for (int j = 0; j < 34; ++j) {
        const float* ag = p.AGG + ((size_t)((b * 34 + j) * 2 + 0) * 2) * 256 + ch;
        av[j] = ag[0]; hv[j] = ag[256];
      }
#pragma unroll
      for (int j = 0; j < 34; ++j) asm volatile("" : "+v"(av[j]), "+v"(hv[j]));
#pragma unroll
      for (int j = 0; j < 34; ++j) {
        const float ae = j < tl ? av[j] : 1.f, he = j < tl ? hv[j] : 0.f;
        cf = ae * cf + he;
      }
    }
    {
      float av[34], hv[34];
#pragma unroll
      for (int j = 0; j < 34; ++j) {
        const float* ag = p.AGG + ((size_t)((b * 34 + j) * 2 + 1) * 2) * 256 + ch;
        av[j] = ag[0]; hv[j] = ag[256];
      }
#pragma unroll
      for (int j = 0; j < 34; ++j) asm volatile("" : "+v"(av[j]), "+v"(hv[j]));
#pragma unroll
      for (int step = 0; step < 34; ++step) {
        const int j = step < 2 ? 1 - step : 35 - step;
        const bool before = tl < 2 ? (j < 2 && j > tl) : (j < 2 || j > tl);
        const float ae = before ? av[j] : 1.f, he = before ? hv[j] : 0.f;
        cb = ae * cb + he;
      }
    }
    scf[ch] = cf; scb[ch] = cb;
  }
  __syncthreads();
  const int c8 = (tid & 31) * 8;
  float cf[8], cb[8];
#pragma unroll
  for (int e = 0; e < 8; ++e) { cf[e] = scf[c8 + e]; cb[e] = scb[c8 + e]; }
#pragma unroll 4
  for (int i = 0; i < 16; ++i) {
    const int t = (tid >> 5) + 8 * i;
    const size_t ro = (size_t)(row0 + t) * 256 + c8;
    const u32x4 hf = *(const u32x4*)(p.AU + (size_t)0 * NTOK * 256 + ro);
    const u32x4 pf = *(const u32x4*)(p.AU + (size_t)1 * NTOK * 256 + ro);
    const u32x4 hb = *(const u32x4*)(p.AU + (size_t)2 * NTOK * 256 + ro);
    const u32x4 pb = *(const u32x4*)(p.AU + (size_t)3 * NTOK * 256 + ro);
    const u32x4 gz = *(const u32x4*)(p.Z + (size_t)(row0 + t) * ZW + ZLG + c8);
    u32x4 o;
#pragma unroll
    for (int q = 0; q < 4; ++q) {
      const float h0 = bflo(hf[q]) + bflo(pf[q]) * cf[2 * q] + bflo(hb[q]) + bflo(pb[q]) * cb[2 * q];
      const float h1 = bfhi(hf[q]) + bfhi(pf[q]) * cf[2 * q + 1] + bfhi(hb[q]) + bfhi(pb[q]) * cb[2 * q + 1];
      o[q] = pack2(gelu_tanh_(bflo(gz[q])) * h0, gelu_tanh_(bfhi(gz[q])) * h1);
    }
    *(u32x4*)(p.U + (size_t)(row0 + t) * DM + 768 + c8) = o;
  }
}

DI int next_item(unsigned* ctr, unsigned char* smem_full) {
  int* slot = (int*)(smem_full + 163808);
  __syncthreads();
  if (tfull_() == 0) *slot = (int)atomicAdd(ctr, 2u);
  __syncthreads();
  return *slot + hidx_();
}
DI void phase_prep(CPARAMS p, int l, unsigned char* smem, unsigned char* smem_full) {
  unsigned* ctr = p.CTR + 2 * l;
  for (;;) {
    int it = next_item(ctr, smem_full);
    if (it >= 1088 + 544 + 816 + 1088 + 136) break;
    if (it < 1088) { lru_local_item(p, l, it >> 3, it & 7, smem); continue; }
    it -= 1088;
    if (it < 544) { mlstm_local_item(p, it / 34, it % 34, smem); continue; }
    it -= 544;
    if (it < 816) { const int qmt = it / 6; if (l < NLAYER - 1 || (qmt % 34) >= 2) mla_q_item(p, qmt, it % 6, smem); continue; }
    it -= 816;
    if (it < 1088) { mla_kv_item(p, it >> 3, it & 7, smem); continue; }
    it -= 1088;
    mla_krope_item(p, it, smem);
  }
}
DI void phase_mix(CPARAMS p, int l, unsigned char* smem, unsigned char* smem_full) {
  for (int a = bidx_(); a < 512; a += VGRID) {
    const int rb = a >> 1, x = rb & 7, j = ((rb >> 3) << 1) | (a & 1);
    const int bh = 2 * x + (j >> 5), qt = j & 31;
    attn_item(p, bh >> 2, bh & 3, TC + 128 * qt, 68, smem_full);
  }
  unsigned* ctr = p.CTR + 2 * l + 1;
  if (l == NLAYER - 1) {
    for (;;) {
      const int it = next_item(ctr, smem_full);
      if (it >= 512 + 128) break;
      if (it < 512) mlstm_out_item(p, it >> 5, 2 + (it & 31), smem);
      else { const int t = it - 512; lru_out_item(p, (t >> 5) * 34 + 2 + (t & 31), smem); }
    }
    return;
  }
  for (;;) {
    const int it = next_item(ctr, smem_full);
    if (it >= 32 + 544 + 136) break;
    if (it < 32) { const int bh = it >> 1, qt = it & 1; attn_item(p, bh >> 2, bh & 3, 128 * qt, 4, smem_full); }
    else if (it < 576) { const int j = it - 32; mlstm_out_item(p, j / 34, j % 34, smem); }
    else lru_out_item(p, it - 576, smem);
  }
}
DI void phase_final(CPARAMS p) {
  const int lane = tidx_() & 63, w = tidx_() >> 6;
  for (int it = bidx_(); it < NB * TL / 4; it += VGRID) {
    const int r = it * 4 + w;
    const int b = r >> 12, t = r & 4095;
    const float* src = p.X + ((size_t)b * TP + TC + t) * DM;
    float4 v[4];
    float ss = 0.f;
#pragma unroll
    for (int i = 0; i < 4; ++i) {
      v[i] = *(const float4*)(src + lane * 4 + 256 * i);
      ss += v[i].x * v[i].x + v[i].y * v[i].y + v[i].z * v[i].z + v[i].w * v[i].w;
    }
#pragma unroll
    for (int o = 32; o > 0; o >>= 1) ss += __shfl_xor(ss, o, 64);
    const float rs = rsqrtf(ss * (1.f / DM) + EPSF);
#pragma unroll
    for (int i = 0; i < 4; ++i) {
      const int cidx = lane * 4 + 256 * i;
      const float4 g = *(const float4*)(p.final_g + cidx);
      float4 o4;
      o4.x = v[i].x * rs * g.x; o4.y = v[i].y * rs * g.y; o4.z = v[i].z * rs * g.z; o4.w = v[i].w * rs * g.w;
      *(float4*)(p.out + (size_t)r * DM + cidx) = o4;
    }
  }
}

__global__ void __launch_bounds__(512, 2) mega_kernel(Params p_unused) {
  __shared__ __attribute__((aligned(16))) unsigned char smem[163840];
  cg::grid_group grid = cg::this_grid();
  unsigned char* hs = smem + hidx_() * 81920;
  if (threadIdx.x < 4) ((unsigned*)(smem + 163824))[threadIdx.x] = 0u;
  __syncthreads();
  phase_mod(*kparams(), hs);
  grid.sync();
  XcdBarrier xb = xcd_barrier_post(kparams()->BAR, (volatile LAS unsigned*)(smem + 163824));
#pragma unroll 1
  for (int l = 0; l < NLAYER; ++l) {
    phase_norm1(*kparams(), l, hs);
    xcd_barrier(xb);
    phase_gemm_in(*kparams(), l, smem, hs);
    xcd_barrier(xb);
    phase_prep(*kparams(), l, hs, smem);
    xcd_barrier(xb);
    phase_mlstm_scan(*kparams());
    xcd_barrier(xb);
    phase_mix(*kparams(), l, hs, smem);
    xcd_barrier(xb);
    phase_gemm_resid(*kparams(), l, kparams()->U, DM, kparams()->Wb_out, 2, l == NLAYER - 1, smem);
    xcd_barrier(xb);
    phase_norm2(*kparams(), l);
    xcd_barrier(xb);
    phase_gemm_ff1(*kparams(), l == NLAYER - 1, smem);
    xcd_barrier(xb);
    phase_gemm_resid(*kparams(), l, kparams()->H, DFF, kparams()->Wb_ff2, 5, l == NLAYER - 1, smem);
    xcd_barrier(xb);
  }
  phase_final(*kparams());
}

extern "C" void kernel_launch(void* const* d_in, const int* in_sizes, int n_in, void* d_out, int out_size, void* d_ws, size_t ws_size,
                              hipStream_t stream) {
  static int grid_blocks = 0;
  if (!grid_blocks) {
    int dev = 0, cus = 0, per_cu = 0;
    hipGetDevice(&dev);
    hipDeviceGetAttribute(&cus, hipDeviceAttributeMultiprocessorCount, dev);
    hipOccupancyMaxActiveBlocksPerMultiprocessor(&per_cu, mega_kernel, 512, 0);
    if (per_cu > 1) per_cu = 1;
    if (per_cu < 1) per_cu = 1;
    grid_blocks = cus * per_cu;
  }
  Params p{};
  const float* const* in = (const float* const*)d_in;
  p.x = in[0]; p.c = in[1]; p.ctx = in[2]; p.c_ctx = in[3]; p.w_mod = in[4]; p.b_mod = in[5]; p.w_in = in[6];
  p.g_q = in[7]; p.w_uq = in[8]; p.g_kv = in[9]; p.w_ukv = in[10]; p.gate_bias = in[11];
  p.conv_w = in[12]; p.conv_b = in[13]; p.w_a = in[14]; p.b_a = in[15]; p.w_x = in[16]; p.b_x = in[17]; p.lam = in[18];
  p.w_out = in[19]; p.w_ff1 = in[20]; p.w_ff2 = in[21]; p.final_g = in[22];
  p.out = (float*)d_out;
  unsigned char* ws = (unsigned char*)d_ws;
  size_t off = 0;
  auto take = [&](size_t bytes) { unsigned char* r = ws + off; off += (bytes + 255) & ~(size_t)255; return r; };
  p.Wb_in = (bf16_t*)take((size_t)2048 * 1024 * 2);
  p.Wb_uq = (bf16_t*)take((size_t)768 * 256 * 2);
  p.Wb_ukv = (bf16_t*)take((size_t)1024 * 128 * 2);
  p.Wb_out = (bf16_t*)take((size_t)1024 * 1024 * 2);
  p.Wb_ff1 = (bf16_t*)take((size_t)4096 * 1024 * 2);
  p.Wb_ff2 = (bf16_t*)take((size_t)4096 * 1024 * 2);
  p.Wb_lru = (bf16_t*)take((size_t)4 * 256 * 64 * 2);
  p.MOD = (float*)take((size_t)4 * 5 * 6144 * 4);
  p.X = (float*)take((size_t)NTOK * DM * 4);
  p.U = (bf16_t*)take((size_t)NTOK * DM * 2);
  p.H = (bf16_t*)take((size_t)NTOK * DFF * 2);
  p.Z = p.H;
  p.Qb = p.Z + (size_t)NTOK * ZW;
  p.Kb = p.Qb + (size_t)16 * TP * 192;
  p.Vt = p.Kb + (size_t)16 * TP * 192;
  p.ZGt = (float*)take((size_t)NTOK * 16 * 4);
  p.AU = (bf16_t*)take((size_t)4 * NTOK * 256 * 2);
  p.AGG = (float*)take((size_t)136 * 2 * 2 * 256 * 4);
  p.CST = (float*)take((size_t)16 * 34 * 2 * CREC * 4);
  p.XS = (float*)take((size_t)NTOK * 256 * 4);
  p.CTR = (unsigned*)take(256);
  p.BAR = (unsigned*)take((size_t)XCD_BAR_WORDS * 4);
  if (off > ws_size) fprintf(stderr, "workspace too small: need %zu have %zu\n", off, ws_size);
  void* args[] = {&p};
  hipError_t e = hipLaunchCooperativeKernel((void*)mega_kernel, dim3(grid_blocks), dim3(512), args, 0, stream);
  if (e != hipSuccess) fprintf(stderr, "cooperative launch failed: %s (grid %d)\n", hipGetErrorString(e), grid_blocks);
}
```
